# Optimizing an MI355X kernel written in HIP

```python
import math
import jax, jax.numpy as jnp
from jax import lax
import numpy as np

D_MODEL = 1024
BATCH = 8
SEQ = 2048
DEPTH = 1
DEC_BATCH = 1
DEC_SEQ = 16384
PAST_LEN = 128

HEAD_DIM = 64
N_HEADS = 8
N_KV_HEADS = 2
WINDOW = 128
BLOCK = 128
N_BUCKETS = 32
MAX_DISTANCE = 128
SGU_WIDTH = 512
SGU_GROUPS = 4
SGU_CHUNK = 128
MEM_LEN = 256
MEM_HEADS = 4
MEM_HEAD_DIM = 128
MEM_WIDTH = MEM_HEADS * MEM_HEAD_DIM
N_BRANCHES = 3
D_FF = 2816
CONV_WIDTH = 3
EPS = 1e-6

Q_W = N_HEADS * HEAD_DIM
KV_W = N_KV_HEADS * HEAD_DIM
IN_COLS = Q_W + 2 * KV_W + 2 * SGU_WIDTH + MEM_WIDTH + N_BRANCHES * D_MODEL
SPLITS = [int(s) for s in np.cumsum([Q_W, KV_W, KV_W, 2 * SGU_WIDTH, MEM_WIDTH])]
NEG = -1e30

kernel_name = "hybrid_gated_window_gmlp_memory_encoder"


def rmsnorm(x, g):
    xf = x.astype(jnp.float32)
    y = xf * lax.rsqrt(jnp.mean(xf * xf, axis=-1, keepdims=True) + EPS)
    return (y * g.astype(jnp.float32)).astype(x.dtype)


def t5_bucket(rel):
    nb = N_BUCKETS // 2
    max_exact = nb // 2
    ret = (rel > 0).astype(jnp.int32) * nb
    n = jnp.abs(rel)
    nf = jnp.maximum(n, 1).astype(jnp.float32)
    large = max_exact + (jnp.log(nf / max_exact) / math.log(MAX_DISTANCE / max_exact)
                         * (nb - max_exact)).astype(jnp.int32)
    large = jnp.minimum(large, nb - 1)
    return ret + jnp.where(n < max_exact, n, large)


def windowed_gqa(q, k, v, sink, rel_bias):
    B, S = q.shape[0], q.shape[1]
    nb = S // BLOCK
    G = N_HEADS // N_KV_HEADS
    qb = q.reshape(B, nb, BLOCK, N_KV_HEADS, G, HEAD_DIM)
    pad = ((0, 0), (BLOCK, BLOCK), (0, 0), (0, 0))
    kp = jnp.pad(k, pad)
    vp = jnp.pad(v, pad)

    def bands(t):
        return jnp.concatenate(
            [t[:, i * BLOCK:i * BLOCK + S].reshape(B, nb, BLOCK, N_KV_HEADS, HEAD_DIM) for i in range(3)],
            axis=2)

    kb = bands(kp)
    vb = bands(vp)
    s = jnp.einsum('bnqkgd,bnjkd->bnkgqj', qb, kb).astype(jnp.float32) * (HEAD_DIM ** -0.5)
    qi = jnp.arange(BLOCK)[:, None]
    kj = jnp.arange(3 * BLOCK)[None, :]
    rel = (kj - BLOCK) - qi
    bias = rel_bias[t5_bucket(rel)].astype(jnp.float32)
    bias = bias.transpose(2, 0, 1).reshape(N_KV_HEADS, G, BLOCK, 3 * BLOCK)
    kpos = (jnp.arange(nb)[:, None] - 1) * BLOCK + jnp.arange(3 * BLOCK)[None, :]
    valid = (jnp.abs(rel) <= WINDOW)[None] & ((kpos >= 0) & (kpos < S))[:, None, :]
    s = jnp.where(valid[None, :, None, None], s + bias[None, None], NEG)
    snk = sink.astype(jnp.float32).reshape(N_KV_HEADS, G)[None, None, :, :, None, None]
    m = jnp.maximum(jnp.max(s, axis=-1, keepdims=True), snk)
    p = jnp.exp(s - m)
    den = jnp.sum(p, axis=-1, keepdims=True) + jnp.exp(snk - m)
    p = (p / den).astype(v.dtype)
    o = jnp.einsum('bnkgqj,bnjkd->bnqkgd', p, vb)
    return o.reshape(B, S, Q_W)


def spatial_gating(z, w_s, b_s, ln_g, ln_b):
    B, S = z.shape[0], z.shape[1]
    u, v = jnp.split(z, 2, axis=-1)
    vf = v.astype(jnp.float32)
    mu = jnp.mean(vf, axis=-1, keepdims=True)
    var = jnp.mean(jnp.square(vf - mu), axis=-1, keepdims=True)
    v = ((vf - mu) * lax.rsqrt(var + EPS) * ln_g.astype(jnp.float32)
         + ln_b.astype(jnp.float32)).astype(z.dtype)
    nc = S // SGU_CHUNK
    cg = SGU_WIDTH // SGU_GROUPS
    vc = v.reshape(B, nc, SGU_CHUNK, SGU_GROUPS, cg)
    sv = jnp.einsum('gij,bnjgc->bnigc', w_s, vc) + b_s.T[None, None, :, :, None]
    return u * sv.reshape(B, S, SGU_WIDTH)


def memory_attention(qm, mem_n, w_mem_kv):
    B, S = qm.shape[0], qm.shape[1]
    M = mem_n.shape[1]
    q = qm.reshape(B, S, MEM_HEADS, MEM_HEAD_DIM)
    kv = mem_n @ w_mem_kv
    k, v = jnp.split(kv, 2, axis=-1)
    k = k.reshape(B, M, MEM_HEADS, MEM_HEAD_DIM)
    v = v.reshape(B, M, MEM_HEADS, MEM_HEAD_DIM)
    s = jnp.einsum('bshd,bmhd->bhsm', q, k).astype(jnp.float32) * (MEM_HEAD_DIM ** -0.5)
    p = jax.nn.softmax(s, axis=-1).astype(v.dtype)
    o = jnp.einsum('bhsm,bmhd->bshd', p, v)
    return o.reshape(B, S, MEM_WIDTH)


def conv_ffn(h, w_up, conv_w, conv_b, w_down):
    S = h.shape[1]
    a = h @ w_up
    ap = jnp.pad(a, ((0, 0), (1, 1), (0, 0)))
    a = ap[:, :S] * conv_w[0] + ap[:, 1:S + 1] * conv_w[1] + ap[:, 2:] * conv_w[2] + conv_b
    gate, up = jnp.split(a, 2, axis=-1)
    return (jax.nn.gelu(gate) * up) @ w_down


def encoder(x, mem, rel_bias, g_mix, w_in, attn_sink, sgu_w, sgu_b, sgu_ln_g, sgu_ln_b,
            g_mem, w_mem_kv, w_br_attn, w_br_sgu, w_br_mem, w_out, g_ffn, w_up, conv_w,
            conv_b, w_down, g_final):
    B, S = x.shape[0], x.shape[1]
    for l in range(DEPTH):
        h = rmsnorm(x, g_mix[l])
        proj = h @ w_in[l]
        q, k, v, z, qm, gl = jnp.split(proj, SPLITS, axis=-1)
        attn = windowed_gqa(q.reshape(B, S, N_HEADS, HEAD_DIM),
                            k.reshape(B, S, N_KV_HEADS, HEAD_DIM),
                            v.reshape(B, S, N_KV_HEADS, HEAD_DIM),
                            attn_sink[l], rel_bias)
        sgu = spatial_gating(jax.nn.gelu(z), sgu_w[l], sgu_b[l], sgu_ln_g[l], sgu_ln_b[l])
        mo = memory_attention(qm, rmsnorm(mem, g_mem[l]), w_mem_kv[l])
        g = jax.nn.sigmoid(gl.astype(jnp.float32)).astype(x.dtype).reshape(B, S, N_BRANCHES, D_MODEL)
        merged = (g[:, :, 0] * (attn @ w_br_attn[l]) + g[:, :, 1] * (sgu @ w_br_sgu[l])
                  + g[:, :, 2] * (mo @ w_br_mem[l]))
        x = x + merged @ w_out[l]
        x = x + conv_ffn(rmsnorm(x, g_ffn[l]), w_up[l], conv_w[l], conv_b[l], w_down[l])
    return rmsnorm(x, g_final)


def setup_inputs(seed: int = 0) -> dict:
    key = jax.random.key(seed)
    ks = jax.random.split(key, 32)
    f32 = jnp.float32

    def nrm(k, shape, scale):
        return jax.random.normal(k, shape, f32) * scale

    def gain(k, shape):
        return 1.0 + 0.02 * jax.random.normal(k, shape, f32)

    L = DEPTH
    return {
        "x_prompt": nrm(ks[0], (BATCH, SEQ, D_MODEL), 1.0),
        "x_sample": nrm(ks[1], (DEC_BATCH, DEC_SEQ, D_MODEL), 1.0),
        "mem_prompt": nrm(ks[2], (BATCH, MEM_LEN, D_MODEL), 1.0),
        "mem_sample": nrm(ks[3], (DEC_BATCH, MEM_LEN, D_MODEL), 1.0),
        "rel_bias": nrm(ks[4], (N_BUCKETS, N_HEADS), 0.5),
        "g_mix": gain(ks[5], (L, D_MODEL)),
        "w_in": nrm(ks[6], (L, D_MODEL, IN_COLS), D_MODEL ** -0.5),
        "attn_sink": nrm(ks[7], (L, N_HEADS), 0.5),
        "sgu_w": nrm(ks[8], (L, SGU_GROUPS, SGU_CHUNK, SGU_CHUNK), SGU_CHUNK ** -0.5),
        "sgu_b": gain(ks[9], (L, SGU_GROUPS, SGU_CHUNK)),
        "sgu_ln_g": gain(ks[10], (L, SGU_WIDTH)),
        "sgu_ln_b": nrm(ks[11], (L, SGU_WIDTH), 0.02),
        "g_mem": gain(ks[12], (L, D_MODEL)),
        "w_mem_kv": nrm(ks[13], (L, D_MODEL, 2 * MEM_WIDTH), D_MODEL ** -0.5),
        "w_br_attn": nrm(ks[14], (L, Q_W, D_MODEL), Q_W ** -0.5),
        "w_br_sgu": nrm(ks[15], (L, SGU_WIDTH, D_MODEL), SGU_WIDTH ** -0.5),
        "w_br_mem": nrm(ks[16], (L, MEM_WIDTH, D_MODEL), MEM_WIDTH ** -0.5),
        "w_out": nrm(ks[17], (L, D_MODEL, D_MODEL), D_MODEL ** -0.5),
        "g_ffn": gain(ks[18], (L, D_MODEL)),
        "w_up": nrm(ks[19], (L, D_MODEL, 2 * D_FF), D_MODEL ** -0.5),
        "conv_w": nrm(ks[20], (L, CONV_WIDTH, 2 * D_FF), CONV_WIDTH ** -0.5),
        "conv_b": nrm(ks[21], (L, 2 * D_FF), 0.02),
        "w_down": nrm(ks[22], (L, D_FF, D_MODEL), D_FF ** -0.5),
        "g_final": gain(ks[23], (D_MODEL,)),
    }


def reference(x_prompt, x_sample, mem_prompt, mem_sample, rel_bias, g_mix, w_in, attn_sink,
              sgu_w, sgu_b, sgu_ln_g, sgu_ln_b, g_mem, w_mem_kv, w_br_attn, w_br_sgu, w_br_mem,
              w_out, g_ffn, w_up, conv_w, conv_b, w_down, g_final):
    y_prompt = encoder(x_prompt, mem_prompt, rel_bias, g_mix, w_in, attn_sink, sgu_w, sgu_b,
                       sgu_ln_g, sgu_ln_b, g_mem, w_mem_kv, w_br_attn, w_br_sgu, w_br_mem,
                       w_out, g_ffn, w_up, conv_w, conv_b, w_down, g_final)
    y_sample = encoder(x_sample, mem_sample, rel_bias, g_mix, w_in, attn_sink, sgu_w, sgu_b,
                       sgu_ln_g, sgu_ln_b, g_mem, w_mem_kv, w_br_attn, w_br_sgu, w_br_mem,
                       w_out, g_ffn, w_up, conv_w, conv_b, w_down, g_final)
    return (y_prompt, y_sample)
```

```cpp
#include <hip/hip_runtime.h>
#include <cstdio>
#include <cstdint>

typedef unsigned short bf16_t;
typedef short bf16x8 __attribute__((ext_vector_type(8)));
typedef float f32x4 __attribute__((ext_vector_type(4)));
typedef unsigned u32x4 __attribute__((ext_vector_type(4)));
#define LAS __attribute__((address_space(3)))

constexpr int D = 1024, TP = 16384, T = 32768, SEQP = 2048;
constexpr int NPROJ = 5376, DFF = 2816, NUP = 5632, MEMROWS = 2304;
constexpr int C_Q = 0, C_K = 512, C_V = 640, C_U = 768, C_SV = 1280, C_QM = 1792, C_G = 2304;
constexpr float EPS = 1e-6f, LOG2E = 1.4426950408889634f;
constexpr float QSCALE = 0.125f * LOG2E, MSCALE = 0.08838834764831845f * LOG2E;
constexpr int NTHREADS = 512, NWAVES = 8;

constexpr size_t MiB = 1u << 20;
constexpr size_t WS_CTL = 0;
constexpr size_t WS_WIN = 2 * MiB;
constexpr size_t WS_WMKV = 13 * MiB;
constexpr size_t WS_WBR = 15 * MiB;
constexpr size_t WS_WOUT = 18 * MiB;
constexpr size_t WS_WUP = 20 * MiB;
constexpr size_t WS_WDN = 31 * MiB;
constexpr size_t WS_SGUW = 37 * MiB;
constexpr size_t WS_MEMN = 38 * MiB;
constexpr size_t WS_MKV = 43 * MiB;
constexpr size_t WS_SSQ1 = 48 * MiB;
constexpr size_t WS_STAT = 50 * MiB;
constexpr size_t WS_H = 52 * MiB;
constexpr size_t WS_PROJ = 116 * MiB;
constexpr size_t WS_AUP = 52 * MiB;
constexpr size_t WS_G = 228 * MiB;
constexpr size_t WS_H2 = 448 * MiB;
constexpr size_t WS_END = 512 * MiB;

constexpr int LDS_BYTES = 147456;

__device__ __forceinline__ float bf2f(bf16_t v) { return __uint_as_float((unsigned)v << 16); }
__device__ __forceinline__ unsigned f2bf(float f) { unsigned u = __float_as_uint(f); return (u + 0x7fffu + ((u >> 16) & 1u)) >> 16; }
__device__ __forceinline__ unsigned pk2(float lo, float hi) { return f2bf(lo) | (f2bf(hi) << 16); }
__device__ __forceinline__ float gelu_tanh(float x) {
    const float u = x * (1.0f + 0.044715f * x * x) * (2.0f * 0.7978845608028654f * LOG2E);
    return x * __builtin_amdgcn_rcpf(1.0f + __builtin_amdgcn_exp2f(-u));
}
__device__ __forceinline__ float sigmoid_f(float x) { return __builtin_amdgcn_rcpf(1.0f + __builtin_amdgcn_exp2f(-x * LOG2E)); }
__device__ __forceinline__ float wave_sum(float v) {
#pragma unroll
    for (int o = 1; o < 64; o <<= 1) v += __shfl_xor(v, o);
    return v;
}
__device__ __forceinline__ int t5_bucket(int rel) {
    const int n = rel < 0 ? -rel : rel; const int ret = rel > 0 ? 16 : 0;
    if (n < 8) return ret + n;
    int l = (31 - __builtin_clz((unsigned)(n * n))) + 2; if (l > 15) l = 15;
    return ret + l;
}

struct Args {
    const float* in[24];
    float* out; unsigned char* ws;
    int ph_lo, ph_hi;
};

struct Ctx { int tid, lane, wave, gw, ngw, gtid, ngt; };

__device__ __forceinline__ const float* xrow(const Args& a, int r) { return r < TP ? a.in[0] + (size_t)r * D : a.in[1] + (size_t)(r - TP) * D; }
__device__ __forceinline__ const float* memrow(const Args& a, int r) { return r < 2048 ? a.in[2] + (size_t)r * D : a.in[3] + (size_t)(r - 2048) * D; }

__device__ __forceinline__ void tr_item(const float* W, int K, int N, bf16_t* WT, const float* ks, int upmap, LAS float* scr, int item, int lane) {
    const int nblk = N / 32, kb = item / nblk, nb = item % nblk, k0 = 64 * kb, n0 = 32 * nb;
#pragma unroll 8
    for (int i = 0; i < 32; ++i) { const int kk = 2 * i + (lane >> 5); float v = W[(size_t)(k0 + kk) * N + n0 + (lane & 31)]; if (ks) v *= ks[k0 + kk]; scr[kk * 33 + (lane & 31)] = v; }
    asm volatile("s_waitcnt lgkmcnt(0)" ::: "memory");
    int r0 = n0;
    if (upmap) { if (n0 < DFF) r0 = 256 * (n0 / 128) + (n0 % 128); else { const int m = n0 - DFF; r0 = 256 * (m / 128) + 128 + (m % 128); } }
    const int c = lane & 7;
#pragma unroll
    for (int j = 0; j < 4; ++j) { const int n = (lane >> 3) + 8 * j; const LAS float* s = scr + (8 * c) * 33 + n;
        u32x4 o; o.x = pk2(s[0 * 33], s[1 * 33]); o.y = pk2(s[2 * 33], s[3 * 33]); o.z = pk2(s[4 * 33], s[5 * 33]); o.w = pk2(s[6 * 33], s[7 * 33]);
        *(u32x4*)(WT + (size_t)(r0 + n) * K + k0 + 8 * c) = o; }
    asm volatile("s_waitcnt lgkmcnt(0)" ::: "memory");
}
__device__ __forceinline__ void rms_row_to_bf16(const float* xr, const float* g, bf16_t* orow, int lane) {
    f32x4 v[4]; float s = 0.f;
#pragma unroll
    for (int j = 0; j < 4; ++j) { v[j] = ((const f32x4*)xr)[lane + 64 * j]; s += (v[j].x * v[j].x + v[j].y * v[j].y) + (v[j].z * v[j].z + v[j].w * v[j].w); }
    const float rstd = 1.0f / sqrtf(wave_sum(s) * (1.0f / D) + EPS);
#pragma unroll
    for (int j = 0; j < 4; ++j) { const f32x4 gg = ((const f32x4*)g)[lane + 64 * j];
        const unsigned lo = pk2(v[j].x * rstd * gg.x, v[j].y * rstd * gg.y), hi = pk2(v[j].z * rstd * gg.z, v[j].w * rstd * gg.w);
        ((unsigned long long*)orow)[lane + 64 * j] = (unsigned long long)lo | ((unsigned long long)hi << 32); }
}
__device__ __forceinline__ void p0_prologue(const Args& a, const Ctx& c, LAS unsigned char* lds) {
    LAS float* scr = (LAS float*)(lds + c.wave * 16384);
    unsigned char* ws = a.ws;
    constexpr int I_IN = 16 * (NPROJ / 32), I_MKV = 16 * 32, I_BR = 8 * 32, I_OUT = 16 * 32, I_UP = 16 * (NUP / 32), I_DN = (DFF / 64) * 32;
    constexpr int NITEMS = I_IN + I_MKV + 3 * I_BR + I_OUT + I_UP + I_DN;
    for (int it = c.gw; it < NITEMS; it += c.ngw) {
        int r = it;
        if (r < I_IN) { tr_item(a.in[6], D, NPROJ, (bf16_t*)(ws + WS_WIN), nullptr, 0, scr, r, c.lane); continue; } r -= I_IN;
        if (r < I_MKV) { tr_item(a.in[13], D, 1024, (bf16_t*)(ws + WS_WMKV), nullptr, 0, scr, r, c.lane); continue; } r -= I_MKV;
        if (r < I_BR) { tr_item(a.in[14], 512, 1024, (bf16_t*)(ws + WS_WBR), nullptr, 0, scr, r, c.lane); continue; } r -= I_BR;
        if (r < I_BR) { tr_item(a.in[15], 512, 1024, (bf16_t*)(ws + WS_WBR + 1 * MiB), nullptr, 0, scr, r, c.lane); continue; } r -= I_BR;
        if (r < I_BR) { tr_item(a.in[16], 512, 1024, (bf16_t*)(ws + WS_WBR + 2 * MiB), nullptr, 0, scr, r, c.lane); continue; } r -= I_BR;
        if (r < I_OUT) { tr_item(a.in[17], D, 1024, (bf16_t*)(ws + WS_WOUT), nullptr, 0, scr, r, c.lane); continue; } r -= I_OUT;
        if (r < I_UP) { tr_item(a.in[19], D, NUP, (bf16_t*)(ws + WS_WUP), a.in[18], 1, scr, r, c.lane); continue; } r -= I_UP;
        tr_item(a.in[22], DFF, 1024, (bf16_t*)(ws + WS_WDN), nullptr, 0, scr, r, c.lane);
    }
    { bf16_t* o = (bf16_t*)(ws + WS_SGUW); const float* w = a.in[8];
      for (int i = c.gtid; i < 4 * 128 * 128 / 2; i += c.ngt) ((unsigned*)o)[i] = pk2(w[2 * i], w[2 * i + 1]); }
    for (int m = c.gw; m < T; m += c.ngw) rms_row_to_bf16(xrow(a, m), a.in[5], (bf16_t*)(ws + WS_H) + (size_t)m * D, c.lane);
    for (int m = c.gw; m < MEMROWS; m += c.ngw) rms_row_to_bf16(memrow(a, m), a.in[12], (bf16_t*)(ws + WS_MEMN) + (size_t)m * D, c.lane);
}

__device__ __forceinline__ void wt_mma(f32x4 (&acc)[4][4], const bf16_t* A, int lda, const bf16_t* B, int ldb, int K, int lane) {
    const bf16_t* a0 = A + (size_t)(lane & 15) * lda + 8 * (lane >> 4);
    const bf16_t* b0 = B + (size_t)(lane & 15) * ldb + 8 * (lane >> 4);
    for (int k = 0; k < K; k += 32) {
        bf16x8 af[4], bfr[4];
#pragma unroll
        for (int i = 0; i < 4; ++i) { af[i] = *(const bf16x8*)(a0 + (size_t)i * 16 * lda + k); bfr[i] = *(const bf16x8*)(b0 + (size_t)i * 16 * ldb + k); }
#pragma unroll
        for (int i = 0; i < 4; ++i)
#pragma unroll
            for (int j = 0; j < 4; ++j) acc[i][j] = __builtin_amdgcn_mfma_f32_16x16x32_bf16(af[i], bfr[j], acc[i][j], 0, 0, 0);
    }
}
__device__ __forceinline__ void zero_acc(f32x4 (&acc)[4][4]) {
#pragma unroll
    for (int i = 0; i < 4; ++i)
#pragma unroll
        for (int j = 0; j < 4; ++j) acc[i][j] = (f32x4){0.f, 0.f, 0.f, 0.f};
}
template <class Epi>
__device__ __forceinline__ void sgemm_phase(const bf16_t* A, int lda, const bf16_t* Bt, int ldb, int M, int N, int K, const Epi& epi, const Ctx& c) {
    const int nN = N / 64, ntask = (M / 64) * nN;
    for (int t = c.gw; t < ntask; t += c.ngw) {
        const int tm = t / nN, tn = t % nN;
        f32x4 acc[4][4]; zero_acc(acc);
        wt_mma(acc, A + (size_t)tm * 64 * lda, lda, Bt + (size_t)tn * 64 * ldb, ldb, K, c.lane);
#pragma unroll
        for (int i = 0; i < 4; ++i)
#pragma unroll
            for (int r = 0; r < 4; ++r) { const int row = tm * 64 + 16 * i + 4 * (c.lane >> 4) + r; const float rs = epi.rowpre(row);
#pragma unroll
                for (int j = 0; j < 4; ++j) epi(row, tn * 64 + 16 * j + (c.lane & 15), acc[i][j][r] * rs); }
    }
}

struct EpiProjN { bf16_t* P;
    __device__ __forceinline__ float rowpre(int) const { return 1.0f; }
    __device__ __forceinline__ void operator()(int r, int col, float v) const {
        float o;
        if (col < C_K) o = v * QSCALE; else if (col < C_U) o = v; else if (col < C_QM) o = gelu_tanh(v); else if (col < C_G) o = v * MSCALE; else o = sigmoid_f(v);
        P[(size_t)r * NPROJ + col] = (bf16_t)f2bf(o); } };
struct EpiBf16N { bf16_t* P; int ldc;
    __device__ __forceinline__ float rowpre(int) const { return 1.0f; }
    __device__ __forceinline__ void operator()(int r, int col, float v) const { P[(size_t)r * ldc + col] = (bf16_t)f2bf(v); } };
struct EpiOutN { const Args* a; bf16_t* H2;
    __device__ __forceinline__ float rowpre(int) const { return 1.0f; }
    __device__ __forceinline__ void operator()(int r, int col, float v) const { const float x1 = xrow(*a, r)[col] + v; a->out[(size_t)r * D + col] = x1; H2[(size_t)r * D + col] = (bf16_t)f2bf(x1); } };
struct EpiUpN { bf16_t* AUP; const float* ssq;
    __device__ __forceinline__ float rowpre(int r) const {
        float s = 0.f;
#pragma unroll
        for (int i = 0; i < 16; ++i) s += ssq[(size_t)r * 16 + i];
        return 1.0f / sqrtf(s * (1.0f / D) + EPS); }
    __device__ __forceinline__ void operator()(int r, int col, float v) const { AUP[(size_t)r * DFF + col] = (bf16_t)f2bf(v); } };
struct EpiDownN { float* out;
    __device__ __forceinline__ float rowpre(int) const { return 1.0f; }
    __device__ __forceinline__ void operator()(int r, int col, float v) const { out[(size_t)r * D + col] += v; } };

__device__ __forceinline__ float dot8(bf16x8 a, bf16x8 b) {
    float s = 0.f;
#pragma unroll
    for (int i = 0; i < 8; ++i) s += bf2f((bf16_t)a[i]) * bf2f((bf16_t)b[i]);
    return s;
}
__device__ __forceinline__ void naive_wattn(const Args& a, const Ctx& c) {
    bf16_t* proj = (bf16_t*)(a.ws + WS_PROJ);
    const float* relb = a.in[4]; const float* sink = a.in[7];
    for (int idx = c.gtid; idx < T * 8; idx += c.ngt) {
        const int h = idx & 7, row = idx >> 3, kvh = h >> 2;
        const int s0 = row < TP ? (row & ~(SEQP - 1)) : TP, S = row < TP ? SEQP : TP, pos = row - s0;
        bf16x8 q[8]; float o[64];
        bf16_t* qp = proj + (size_t)row * NPROJ + C_Q + h * 64;
#pragma unroll
        for (int d = 0; d < 8; ++d) q[d] = ((const bf16x8*)qp)[d];
#pragma unroll
        for (int d = 0; d < 64; ++d) o[d] = 0.f;
        float m = sink[h] * LOG2E, l = 1.0f;
        const int j0 = pos - 128 < 0 ? 0 : pos - 128, j1 = pos + 128 > S - 1 ? S - 1 : pos + 128;
        for (int j = j0; j <= j1; ++j) {
            const bf16x8* kp = (const bf16x8*)(proj + (size_t)(s0 + j) * NPROJ + C_K + kvh * 64);
            const bf16x8* vp = (const bf16x8*)(proj + (size_t)(s0 + j) * NPROJ + C_V + kvh * 64);
            float s = 0.f;
#pragma unroll
            for (int d = 0; d < 8; ++d) s += dot8(q[d], kp[d]);
            s += relb[t5_bucket(j - pos) * 8 + h] * LOG2E;
            if (s > m) { const float f = __builtin_amdgcn_exp2f(m - s); l *= f;
#pragma unroll
                for (int d = 0; d < 64; ++d) o[d] *= f;
                m = s; }
            const float p = __builtin_amdgcn_exp2f(s - m); l += p;
#pragma unroll
            for (int d = 0; d < 8; ++d) { const bf16x8 v = vp[d];
#pragma unroll
                for (int e = 0; e < 8; ++e) o[8 * d + e] += p * bf2f((bf16_t)v[e]); }
        }
        const float il = 1.0f / l;
#pragma unroll
        for (int d = 0; d < 64; ++d) qp[d] = (bf16_t)f2bf(o[d] * il);
    }
}
__device__ __forceinline__ void naive_mattn(const Args& a, const Ctx& c) {
    bf16_t* proj = (bf16_t*)(a.ws + WS_PROJ); const bf16_t* mkv = (const bf16_t*)(a.ws + WS_MKV);
    for (int idx = c.gtid; idx < T * 8; idx += c.ngt) {
        const int half = idx & 1, h = (idx >> 1) & 3, row = idx >> 3;
        const int b = row < TP ? row / SEQP : 8;
        bf16_t* qp = proj + (size_t)row * NPROJ + C_QM + h * 128;
        bf16x8 q[16]; float o[64];
#pragma unroll
        for (int d = 0; d < 16; ++d) q[d] = ((const bf16x8*)qp)[d];
#pragma unroll
        for (int d = 0; d < 64; ++d) o[d] = 0.f;
        float m = -3.0e38f, l = 0.f;
        for (int j = 0; j < 256; ++j) {
            const bf16x8* kp = (const bf16x8*)(mkv + (size_t)(b * 256 + j) * 1024 + h * 128);
            const bf16x8* vp = (const bf16x8*)(mkv + (size_t)(b * 256 + j) * 1024 + 512 + h * 128 + half * 64);
            float s = 0.f;
#pragma unroll
            for (int d = 0; d < 16; ++d) s += dot8(q[d], kp[d]);
            if (s > m) { const float f = __builtin_amdgcn_exp2f(m - s); l *= f;
#pragma unroll
                for (int d = 0; d < 64; ++d) o[d] *= f;
                m = s; }
            const float p = __builtin_amdgcn_exp2f(s - m); l += p;
#pragma unroll
            for (int d = 0; d < 8; ++d) { const bf16x8 v = vp[d];
#pragma unroll
                for (int e = 0; e < 8; ++e) o[8 * d + e] += p * bf2f((bf16_t)v[e]); }
        }
        const float il = 1.0f / l;
        asm volatile("" ::: "memory");
#pragma unroll
        for (int d = 0; d < 64; ++d) qp[half * 64 + d] = (bf16_t)f2bf(o[d] * il);
    }
}
__device__ __forceinline__ void naive_sgu_stats(const Args& a, const Ctx& c) {
    const bf16_t* proj = (const bf16_t*)(a.ws + WS_PROJ); float* stat = (float*)(a.ws + WS_STAT);
    for (int row = c.gw; row < T; row += c.ngw) {
        const bf16_t* vp = proj + (size_t)row * NPROJ + C_SV;
        float v[8]; float s = 0.f;
#pragma unroll
        for (int i = 0; i < 8; ++i) { v[i] = bf2f(vp[c.lane * 8 + i]); s += v[i]; }
        const float mu = wave_sum(s) * (1.0f / 512.0f); float q = 0.f;
#pragma unroll
        for (int i = 0; i < 8; ++i) { const float d = v[i] - mu; q += d * d; }
        const float rstd = 1.0f / sqrtf(wave_sum(q) * (1.0f / 512.0f) + EPS);
        if (c.lane == 0) { stat[2 * row] = mu; stat[2 * row + 1] = rstd; }
    }
}
__device__ __forceinline__ void naive_sgu(const Args& a, const Ctx& c) {
    bf16_t* proj = (bf16_t*)(a.ws + WS_PROJ); const float* stat = (const float*)(a.ws + WS_STAT);
    const float* w_s = a.in[8]; const float* b_s = a.in[9]; const float* lng = a.in[10]; const float* lnb = a.in[11];
    for (int idx = c.gtid; idx < T * 512; idx += c.ngt) {
        const int ch = idx & 511, row = idx >> 9, g = ch >> 7, i = row & 127, r0 = row & ~127;
        const float gg = lng[ch], bb = lnb[ch];
        float acc = 0.f;
        for (int j = 0; j < 128; ++j) {
            const float v = bf2f(proj[(size_t)(r0 + j) * NPROJ + C_SV + ch]);
            const float vn = (v - stat[2 * (r0 + j)]) * stat[2 * (r0 + j) + 1] * gg + bb;
            acc += w_s[(g * 128 + i) * 128 + j] * vn;
        }
        acc += b_s[g * 128 + i];
        bf16_t* up = proj + (size_t)row * NPROJ + C_U + ch;
        *up = (bf16_t)f2bf(bf2f(*up) * acc);
    }
}
__device__ __forceinline__ void naive_branch(const Args& a, const Ctx& c) {
    const bf16_t* proj = (const bf16_t*)(a.ws + WS_PROJ); bf16_t* merged = (bf16_t*)(a.ws + WS_H);
    const int nN = 1024 / 64, ntask = (T / 64) * nN;
    for (int t = c.gw; t < ntask; t += c.ngw) {
        const int tm = t / nN, tn = t % nN;
        f32x4 m[4][4]; zero_acc(m);
#pragma unroll 1
        for (int br = 0; br < 3; ++br) {
            const int acol = br == 0 ? C_Q : (br == 1 ? C_U : C_QM);
            f32x4 acc[4][4]; zero_acc(acc);
            wt_mma(acc, proj + (size_t)tm * 64 * NPROJ + acol, NPROJ, (const bf16_t*)(a.ws + WS_WBR + br * MiB) + (size_t)tn * 64 * 512, 512, 512, c.lane);
#pragma unroll
            for (int i = 0; i < 4; ++i)
#pragma unroll
                for (int j = 0; j < 4; ++j)
#pragma unroll
                    for (int r = 0; r < 4; ++r) { const int row = tm * 64 + 16 * i + 4 * (c.lane >> 4) + r, col = tn * 64 + 16 * j + (c.lane & 15);
                        m[i][j][r] += bf2f(proj[(size_t)row * NPROJ + C_G + br * 1024 + col]) * acc[i][j][r]; }
        }
#pragma unroll
        for (int i = 0; i < 4; ++i)
#pragma unroll
            for (int j = 0; j < 4; ++j)
#pragma unroll
                for (int r = 0; r < 4; ++r) { const int row = tm * 64 + 16 * i + 4 * (c.lane >> 4) + r, col = tn * 64 + 16 * j + (c.lane & 15);
                    merged[(size_t)row * D + col] = (bf16_t)f2bf(m[i][j][r]); }
    }
}
__device__ __forceinline__ void naive_ssq(const Args& a, const Ctx& c) {
    float* ssq = (float*)(a.ws + WS_SSQ1);
    for (int row = c.gw; row < T; row += c.ngw) {
        const f32x4* xr = (const f32x4*)(a.out + (size_t)row * D); float s = 0.f;
#pragma unroll
        for (int j = 0; j < 4; ++j) { const f32x4 v = xr[c.lane + 64 * j]; s += (v.x * v.x + v.y * v.y) + (v.z * v.z + v.w * v.w); }
        s = wave_sum(s);
        if (c.lane < 16) ssq[(size_t)row * 16 + c.lane] = c.lane == 0 ? s : 0.f;
    }
}
__device__ __forceinline__ void naive_conv(const Args& a, const Ctx& c, int half) {
    const bf16_t* aup = (const bf16_t*)(a.ws + WS_AUP); bf16_t* g = (bf16_t*)(a.ws + WS_G);
    const float* cw = a.in[20]; const float* cb = a.in[21];
    for (int idx = c.gtid; idx < T * 1408; idx += c.ngt) {
        const int row = idx / 1408, lc = idx % 1408, jj = lc >> 7, ii = lc & 127, ch = half * 1408 + lc;
        const int s0 = row < TP ? (row & ~(SEQP - 1)) : TP, S = row < TP ? SEQP : TP, pos = row - s0;
        const size_t o = (size_t)row * DFF + 256 * jj + ii;
        const float g1 = bf2f(aup[o]), u1 = bf2f(aup[o + 128]);
        const float g0 = pos > 0 ? bf2f(aup[o - DFF]) : 0.f, u0 = pos > 0 ? bf2f(aup[o - DFF + 128]) : 0.f;
        const float g2 = pos < S - 1 ? bf2f(aup[o + DFF]) : 0.f, u2 = pos < S - 1 ? bf2f(aup[o + DFF + 128]) : 0.f;
        const float ga = g0 * cw[ch] + g1 * cw[NUP + ch] + g2 * cw[2 * NUP + ch] + cb[ch];
        const float ua = u0 * cw[DFF + ch] + u1 * cw[NUP + DFF + ch] + u2 * cw[2 * NUP + DFF + ch] + cb[DFF + ch];
        g[(size_t)row * DFF + ch] = (bf16_t)f2bf(gelu_tanh(ga) * ua);
    }
}
__device__ __forceinline__ void final_norm(const Args& a, const Ctx& c) {
    const float* gf = a.in[23];
    for (int row = c.gw; row < T; row += c.ngw) {
        f32x4* xr = (f32x4*)(a.out + (size_t)row * D); f32x4 v[4]; float s = 0.f;
#pragma unroll
        for (int j = 0; j < 4; ++j) { v[j] = xr[c.lane + 64 * j]; s += (v[j].x * v[j].x + v[j].y * v[j].y) + (v[j].z * v[j].z + v[j].w * v[j].w); }
        const float rstd = 1.0f / sqrtf(wave_sum(s) * (1.0f / D) + EPS);
#pragma unroll
        for (int j = 0; j < 4; ++j) { const f32x4 gg = ((const f32x4*)gf)[c.lane + 64 * j]; xr[c.lane + 64 * j] = (f32x4){v[j].x * rstd * gg.x, v[j].y * rstd * gg.y, v[j].z * rstd * gg.z, v[j].w * rstd * gg.w}; }
    }
}

enum { PH_PRO = 0, PH_PROJ, PH_MIX, PH_MIX2, PH_SGU, PH_BR, PH_OUTP, PH_SSQ, PH_UP0, PH_CONV0, PH_UP1, PH_CONV1, PH_DOWN, PH_FINAL, PH_N };

template <int PH> __global__ void __launch_bounds__(NTHREADS, 2) fwd(Args a) {
    extern __shared__ __attribute__((aligned(16))) unsigned char lds_raw[];
    LAS unsigned char* lds = (LAS unsigned char*)lds_raw;
    Ctx c; c.tid = threadIdx.x; c.lane = c.tid & 63; c.wave = __builtin_amdgcn_readfirstlane(c.tid >> 6);
    c.gw = blockIdx.x * NWAVES + c.wave; c.ngw = gridDim.x * NWAVES; c.gtid = blockIdx.x * NTHREADS + c.tid; c.ngt = gridDim.x * NTHREADS;
    unsigned char* ws = a.ws;
    constexpr int ph = PH;
    {
        if constexpr (ph == PH_PRO) p0_prologue(a, c, lds);
        if constexpr (ph == PH_PROJ) {
            EpiProjN e{(bf16_t*)(ws + WS_PROJ)};
            sgemm_phase((const bf16_t*)(ws + WS_H), D, (const bf16_t*)(ws + WS_WIN), D, T, NPROJ, D, e, c);
            EpiBf16N e2{(bf16_t*)(ws + WS_MKV), 1024};
            sgemm_phase((const bf16_t*)(ws + WS_MEMN), D, (const bf16_t*)(ws + WS_WMKV), D, MEMROWS, 1024, D, e2, c);
        }
        if constexpr (ph == PH_MIX) { naive_wattn(a, c); naive_sgu_stats(a, c); }
        if constexpr (ph == PH_MIX2) naive_mattn(a, c);
        if constexpr (ph == PH_SGU) naive_sgu(a, c);
        if constexpr (ph == PH_BR) naive_branch(a, c);
        if constexpr (ph == PH_OUTP) { EpiOutN e{&a, (bf16_t*)(ws + WS_H2)};
            sgemm_phase((const bf16_t*)(ws + WS_H), D, (const bf16_t*)(ws + WS_WOUT), D, T, D, D, e, c); }
        if constexpr (ph == PH_SSQ) naive_ssq(a, c);
        if constexpr (ph == PH_UP0 || ph == PH_UP1) { const int half = ph == PH_UP1;
            EpiUpN e{(bf16_t*)(ws + WS_AUP), (const float*)(ws + WS_SSQ1)};
            sgemm_phase((const bf16_t*)(ws + WS_H2), D, (const bf16_t*)(ws + WS_WUP) + (size_t)half * DFF * D, D, T, DFF, D, e, c); }
        if constexpr (ph == PH_CONV0 || ph == PH_CONV1) naive_conv(a, c, ph == PH_CONV1);
        if constexpr (ph == PH_DOWN) { EpiDownN e{a.out};
            sgemm_phase((const bf16_t*)(ws + WS_G), DFF, (const bf16_t*)(ws + WS_WDN), DFF, T, D, DFF, e, c); }
        if constexpr (ph == PH_FINAL) final_norm(a, c);
    }
}
template <int PH> static void launch_ph(const Args& a, int grid, hipStream_t stream) {
    static bool init = false;
    if (!init) { (void)hipFuncSetAttribute((const void*)fwd<PH>, hipFuncAttributeMaxDynamicSharedMemorySize, LDS_BYTES); init = true; }
    hipLaunchKernelGGL(fwd<PH>, dim3(grid), dim3(NTHREADS), LDS_BYTES, stream, a);
}

extern "C" void kernel_launch(void* const* d_in, const int* in_sizes, int n_in, void* d_out, int out_size, void* d_ws, size_t ws_size, hipStream_t stream) {
    static int grid = 0;
    if (grid == 0) {
        if (n_in != 24 || out_size != T * D || ws_size < WS_END) { fprintf(stderr, "kernel_launch: unexpected shapes (n_in %d, out %d, ws %zu)\n", n_in, out_size, ws_size); grid = -1; return; }
        int dev = 0, cus = 0;
        (void)hipGetDevice(&dev); (void)hipDeviceGetAttribute(&cus, hipDeviceAttributeMultiprocessorCount, dev);
        grid = cus > 0 ? cus : 256;
    }
    if (grid < 0) return;
    Args a{};
    for (int i = 0; i < 24; ++i) a.in[i] = (const float*)d_in[i];
    a.out = (float*)d_out; a.ws = (unsigned char*)d_ws;
    launch_ph<PH_PRO>(a, grid, stream); launch_ph<PH_PROJ>(a, grid, stream); launch_ph<PH_MIX>(a, grid, stream); launch_ph<PH_MIX2>(a, grid, stream);
    launch_ph<PH_SGU>(a, grid, stream); launch_ph<PH_BR>(a, grid, stream); launch_ph<PH_OUTP>(a, grid, stream); launch_ph<PH_SSQ>(a, grid, stream);
    launch_ph<PH_UP0>(a, grid, stream); launch_ph<PH_CONV0>(a, grid, stream); launch_ph<PH_UP1>(a, grid, stream); launch_ph<PH_CONV1>(a, grid, stream);
    launch_ph<PH_DOWN>(a, grid, stream); launch_ph<PH_FINAL>(a, grid, stream);
}
```

```cpp
#include <hip/hip_runtime.h>
#include <hip/hip_cooperative_groups.h>
namespace cg = cooperative_groups;
#include <cstdio>
#include <cstdint>

typedef unsigned short bf16_t;
typedef short bf16x8 __attribute__((ext_vector_type(8)));
typedef float f32x4 __attribute__((ext_vector_type(4)));
typedef unsigned u32x4 __attribute__((ext_vector_type(4)));
#define LAS __attribute__((address_space(3)))

constexpr int D = 1024, TP = 16384, T = 32768, SEQP = 2048;
constexpr int NPROJ = 5376, DFF = 2816, NUP = 5632, MEMROWS = 2304;
constexpr int C_Q = 0, C_K = 512, C_V = 640, C_U = 768, C_SV = 1280, C_QM = 1792, C_G = 2304;
constexpr float EPS = 1e-6f, LOG2E = 1.4426950408889634f;
constexpr float QSCALE = 0.125f * LOG2E, MSCALE = 0.08838834764831845f * LOG2E;
constexpr int NTHREADS = 512, NWAVES = 8;

constexpr size_t MiB = 1u << 20;
constexpr size_t WS_CTL = 0;
constexpr size_t WS_WIN = 2 * MiB;
constexpr size_t WS_WMKV = 13 * MiB;
constexpr size_t WS_WBR = 15 * MiB;
constexpr size_t WS_WOUT = 18 * MiB;
constexpr size_t WS_WUP = 20 * MiB;
constexpr size_t WS_WDN = 31 * MiB;
constexpr size_t WS_SGUW = 37 * MiB;
constexpr size_t WS_MEMN = 38 * MiB;
constexpr size_t WS_MKV = 43 * MiB;
constexpr size_t WS_SSQ1 = 48 * MiB;
constexpr size_t WS_STAT = 50 * MiB;
constexpr size_t WS_H = 52 * MiB;
constexpr size_t WS_PROJ = 116 * MiB;
constexpr size_t WS_AUP = 52 * MiB;
constexpr size_t WS_G = 228 * MiB;
constexpr size_t WS_H2 = 448 * MiB;
constexpr size_t WS_END = 512 * MiB;

constexpr int LDS_BYTES = 147456;

__device__ __forceinline__ float bf2f(bf16_t v) { return __uint_as_float((unsigned)v << 16); }
__device__ __forceinline__ unsigned f2bf(float f) { unsigned u = __float_as_uint(f); return (u + 0x7fffu + ((u >> 16) & 1u)) >> 16; }
__device__ __forceinline__ unsigned pk2(float lo, float hi) { return f2bf(lo) | (f2bf(hi) << 16); }
__device__ __forceinline__ float gelu_tanh(float x) {
    const float u = x * (1.0f + 0.044715f * x * x) * (2.0f * 0.7978845608028654f * LOG2E);
    return x * __builtin_amdgcn_rcpf(1.0f + __builtin_amdgcn_exp2f(-u));
}
__device__ __forceinline__ float sigmoid_f(float x) { return __builtin_amdgcn_rcpf(1.0f + __builtin_amdgcn_exp2f(-x * LOG2E)); }
__device__ __forceinline__ float wave_sum(float v) {
#pragma unroll
    for (int o = 1; o < 64; o <<= 1) v += __shfl_xor(v, o);
    return v;
}
__device__ __forceinline__ int t5_bucket(int rel) {
    const int n = rel < 0 ? -rel : rel; const int ret = rel > 0 ? 16 : 0;
    if (n < 8) return ret + n;
    int l = (31 - __builtin_clz((unsigned)(n * n))) + 2; if (l > 15) l = 15;
    return ret + l;
}

struct Args {
    const float* in[24];
    float* out; unsigned char* ws;
    int ph_lo, ph_hi;
};

struct Ctx { int tid, lane, wave, gw, ngw, gtid, ngt; };

__device__ __forceinline__ const float* xrow(const Args& a, int r) { return r < TP ? a.in[0] + (size_t)r * D : a.in[1] + (size_t)(r - TP) * D; }
__device__ __forceinline__ const float* memrow(const Args& a, int r) { return r < 2048 ? a.in[2] + (size_t)r * D : a.in[3] + (size_t)(r - 2048) * D; }

__device__ __forceinline__ void tr_item(const float* W, int K, int N, bf16_t* WT, const float* ks, int upmap, LAS float* scr, int item, int lane) {
    const int nblk = N / 32, kb = item / nblk, nb = item % nblk, k0 = 64 * kb, n0 = 32 * nb;
#pragma unroll 8
    for (int i = 0; i < 32; ++i) { const int kk = 2 * i + (lane >> 5); float v = W[(size_t)(k0 + kk) * N + n0 + (lane & 31)]; if (ks) v *= ks[k0 + kk]; scr[kk * 33 + (lane & 31)] = v; }
    asm volatile("s_waitcnt lgkmcnt(0)" ::: "memory");
    int r0 = n0;
    if (upmap) { if (n0 < DFF) r0 = 256 * (n0 / 128) + (n0 % 128); else { const int m = n0 - DFF; r0 = 256 * (m / 128) + 128 + (m % 128); } }
    const int c = lane & 7;
#pragma unroll
    for (int j = 0; j < 4; ++j) { const int n = (lane >> 3) + 8 * j; const LAS float* s = scr + (8 * c) * 33 + n;
        u32x4 o; o.x = pk2(s[0 * 33], s[1 * 33]); o.y = pk2(s[2 * 33], s[3 * 33]); o.z = pk2(s[4 * 33], s[5 * 33]); o.w = pk2(s[6 * 33], s[7 * 33]);
        *(u32x4*)(WT + (size_t)(r0 + n) * K + k0 + 8 * c) = o; }
    asm volatile("s_waitcnt lgkmcnt(0)" ::: "memory");
}
__device__ __forceinline__ void rms_row_to_bf16(const float* xr, const float* g, bf16_t* orow, int lane) {
    f32x4 v[4]; float s = 0.f;
#pragma unroll
    for (int j = 0; j < 4; ++j) { v[j] = ((const f32x4*)xr)[lane + 64 * j]; s += (v[j].x * v[j].x + v[j].y * v[j].y) + (v[j].z * v[j].z + v[j].w * v[j].w); }
    const float rstd = 1.0f / sqrtf(wave_sum(s) * (1.0f / D) + EPS);
#pragma unroll
    for (int j = 0; j < 4; ++j) { const f32x4 gg = ((const f32x4*)g)[lane + 64 * j];
        const unsigned lo = pk2(v[j].x * rstd * gg.x, v[j].y * rstd * gg.y), hi = pk2(v[j].z * rstd * gg.z, v[j].w * rstd * gg.w);
        ((unsigned long long*)orow)[lane + 64 * j] = (unsigned long long)lo | ((unsigned long long)hi << 32); }
}
__device__ __forceinline__ void p0_prologue(const Args& a, const Ctx& c, LAS unsigned char* lds) {
    LAS float* scr = (LAS float*)(lds + c.wave * 16384);
    unsigned char* ws = a.ws;
    constexpr int I_IN = 16 * (NPROJ / 32), I_MKV = 16 * 32, I_BR = 8 * 32, I_OUT = 16 * 32, I_UP = 16 * (NUP / 32), I_DN = (DFF / 64) * 32;
    constexpr int NITEMS = I_IN + I_MKV + 3 * I_BR + I_OUT + I_UP + I_DN;
    for (int it = c.gw; it < NITEMS; it += c.ngw) {
        int r = it;
        if (r < I_IN) { tr_item(a.in[6], D, NPROJ, (bf16_t*)(ws + WS_WIN), nullptr, 0, scr, r, c.lane); continue; } r -= I_IN;
        if (r < I_MKV) { tr_item(a.in[13], D, 1024, (bf16_t*)(ws + WS_WMKV), nullptr, 0, scr, r, c.lane); continue; } r -= I_MKV;
        if (r < I_BR) { tr_item(a.in[14], 512, 1024, (bf16_t*)(ws + WS_WBR), nullptr, 0, scr, r, c.lane); continue; } r -= I_BR;
        if (r < I_BR) { tr_item(a.in[15], 512, 1024, (bf16_t*)(ws + WS_WBR + 1 * MiB), nullptr, 0, scr, r, c.lane); continue; } r -= I_BR;
        if (r < I_BR) { tr_item(a.in[16], 512, 1024, (bf16_t*)(ws + WS_WBR + 2 * MiB), nullptr, 0, scr, r, c.lane); continue; } r -= I_BR;
        if (r < I_OUT) { tr_item(a.in[17], D, 1024, (bf16_t*)(ws + WS_WOUT), nullptr, 0, scr, r, c.lane); continue; } r -= I_OUT;
        if (r < I_UP) { tr_item(a.in[19], D, NUP, (bf16_t*)(ws + WS_WUP), a.in[18], 1, scr, r, c.lane); continue; } r -= I_UP;
        tr_item(a.in[22], DFF, 1024, (bf16_t*)(ws + WS_WDN), nullptr, 0, scr, r, c.lane);
    }
    { bf16_t* o = (bf16_t*)(ws + WS_SGUW); const float* w = a.in[8];
      for (int i = c.gtid; i < 4 * 128 * 128 / 2; i += c.ngt) ((unsigned*)o)[i] = pk2(w[2 * i], w[2 * i + 1]); }
    for (int m = c.gw; m < T; m += c.ngw) rms_row_to_bf16(xrow(a, m), a.in[5], (bf16_t*)(ws + WS_H) + (size_t)m * D, c.lane);
    for (int m = c.gw; m < MEMROWS; m += c.ngw) rms_row_to_bf16(memrow(a, m), a.in[12], (bf16_t*)(ws + WS_MEMN) + (size_t)m * D, c.lane);
}

__device__ __forceinline__ void wt_mma(f32x4 (&acc)[4][4], const bf16_t* A, int lda, const bf16_t* B, int ldb, int K, int lane) {
    const bf16_t* a0 = A + (size_t)(lane & 15) * lda + 8 * (lane >> 4);
    const bf16_t* b0 = B + (size_t)(lane & 15) * ldb + 8 * (lane >> 4);
    for (int k = 0; k < K; k += 32) {
        bf16x8 af[4], bfr[4];
#pragma unroll
        for (int i = 0; i < 4; ++i) { af[i] = *(const bf16x8*)(a0 + (size_t)i * 16 * lda + k); bfr[i] = *(const bf16x8*)(b0 + (size_t)i * 16 * ldb + k); }
#pragma unroll
        for (int i = 0; i < 4; ++i)
#pragma unroll
            for (int j = 0; j < 4; ++j) acc[i][j] = __builtin_amdgcn_mfma_f32_16x16x32_bf16(af[i], bfr[j], acc[i][j], 0, 0, 0);
    }
}
__device__ __forceinline__ void zero_acc(f32x4 (&acc)[4][4]) {
#pragma unroll
    for (int i = 0; i < 4; ++i)
#pragma unroll
        for (int j = 0; j < 4; ++j) acc[i][j] = (f32x4){0.f, 0.f, 0.f, 0.f};
}
template <class Epi>
__device__ __forceinline__ void sgemm_phase(const bf16_t* A, int lda, const bf16_t* Bt, int ldb, int M, int N, int K, const Epi& epi, const Ctx& c) {
    const int nN = N / 64, ntask = (M / 64) * nN;
    for (int t = c.gw; t < ntask; t += c.ngw) {
        const int tm = t / nN, tn = t % nN;
        f32x4 acc[4][4]; zero_acc(acc);
        wt_mma(acc, A + (size_t)tm * 64 * lda, lda, Bt + (size_t)tn * 64 * ldb, ldb, K, c.lane);
#pragma unroll
        for (int i = 0; i < 4; ++i)
#pragma unroll
            for (int r = 0; r < 4; ++r) { const int row = tm * 64 + 16 * i + 4 * (c.lane >> 4) + r; const float rs = epi.rowpre(row);
#pragma unroll
                for (int j = 0; j < 4; ++j) epi(row, tn * 64 + 16 * j + (c.lane & 15), acc[i][j][r] * rs); }
    }
}

struct EpiProjN { bf16_t* P;
    __device__ __forceinline__ float rowpre(int) const { return 1.0f; }
    __device__ __forceinline__ void operator()(int r, int col, float v) const {
        float o;
        if (col < C_K) o = v * QSCALE; else if (col < C_U) o = v; else if (col < C_QM) o = gelu_tanh(v); else if (col < C_G) o = v * MSCALE; else o = sigmoid_f(v);
        P[(size_t)r * NPROJ + col] = (bf16_t)f2bf(o); } };
struct EpiBf16N { bf16_t* P; int ldc;
    __device__ __forceinline__ float rowpre(int) const { return 1.0f; }
    __device__ __forceinline__ void operator()(int r, int col, float v) const { P[(size_t)r * ldc + col] = (bf16_t)f2bf(v); } };
struct EpiOutN { const Args* a; bf16_t* H2;
    __device__ __forceinline__ float rowpre(int) const { return 1.0f; }
    __device__ __forceinline__ void operator()(int r, int col, float v) const { const float x1 = xrow(*a, r)[col] + v; a->out[(size_t)r * D + col] = x1; H2[(size_t)r * D + col] = (bf16_t)f2bf(x1); } };
struct EpiUpN { bf16_t* AUP; const float* ssq;
    __device__ __forceinline__ float rowpre(int r) const {
        float s = 0.f;
#pragma unroll
        for (int i = 0; i < 16; ++i) s += ssq[(size_t)r * 16 + i];
        return 1.0f / sqrtf(s * (1.0f / D) + EPS); }
    __device__ __forceinline__ void operator()(int r, int col, float v) const { AUP[(size_t)r * DFF + col] = (bf16_t)f2bf(v); } };
struct EpiDownN { float* out;
    __device__ __forceinline__ float rowpre(int) const { return 1.0f; }
    __device__ __forceinline__ void operator()(int r, int col, float v) const { out[(size_t)r * D + col] += v; } };

__device__ __forceinline__ float dot8(bf16x8 a, bf16x8 b) {
    float s = 0.f;
#pragma unroll
    for (int i = 0; i < 8; ++i) s += bf2f((bf16_t)a[i]) * bf2f((bf16_t)b[i]);
    return s;
}
__device__ __forceinline__ void naive_wattn(const Args& a, const Ctx& c) {
    bf16_t* proj = (bf16_t*)(a.ws + WS_PROJ);
    const float* relb = a.in[4]; const float* sink = a.in[7];
    for (int idx = c.gtid; idx < T * 8; idx += c.ngt) {
        const int h = idx & 7, row = idx >> 3, kvh = h >> 2;
        const int s0 = row < TP ? (row & ~(SEQP - 1)) : TP, S = row < TP ? SEQP : TP, pos = row - s0;
        bf16x8 q[8]; float o[64];
        bf16_t* qp = proj + (size_t)row * NPROJ + C_Q + h * 64;
#pragma unroll
        for (int d = 0; d < 8; ++d) q[d] = ((const bf16x8*)qp)[d];
#pragma unroll
        for (int d = 0; d < 64; ++d) o[d] = 0.f;
        float m = sink[h] * LOG2E, l = 1.0f;
        const int j0 = pos - 128 < 0 ? 0 : pos - 128, j1 = pos + 128 > S - 1 ? S - 1 : pos + 128;
        for (int j = j0; j <= j1; ++j) {
            const bf16x8* kp = (const bf16x8*)(proj + (size_t)(s0 + j) * NPROJ + C_K + kvh * 64);
            const bf16x8* vp = (const bf16x8*)(proj + (size_t)(s0 + j) * NPROJ + C_V + kvh * 64);
            float s = 0.f;
#pragma unroll
            for (int d = 0; d < 8; ++d) s += dot8(q[d], kp[d]);
            s += relb[t5_bucket(j - pos) * 8 + h] * LOG2E;
            if (s > m) { const float f = __builtin_amdgcn_exp2f(m - s); l *= f;
#pragma unroll
                for (int d = 0; d < 64; ++d) o[d] *= f;
                m = s; }
            const float p = __builtin_amdgcn_exp2f(s - m); l += p;
#pragma unroll
            for (int d = 0; d < 8; ++d) { const bf16x8 v = vp[d];
#pragma unroll
                for (int e = 0; e < 8; ++e) o[8 * d + e] += p * bf2f((bf16_t)v[e]); }
        }
        const float il = 1.0f / l;
#pragma unroll
        for (int d = 0; d < 64; ++d) qp[d] = (bf16_t)f2bf(o[d] * il);
    }
}
__device__ __forceinline__ void naive_mattn(const Args& a, const Ctx& c) {
    bf16_t* proj = (bf16_t*)(a.ws + WS_PROJ); const bf16_t* mkv = (const bf16_t*)(a.ws + WS_MKV);
    for (int idx = c.gtid; idx < T * 8; idx += c.ngt) {
        const int half = idx & 1, h = (idx >> 1) & 3, row = idx >> 3;
        const int b = row < TP ? row / SEQP : 8;
        bf16_t* qp = proj + (size_t)row * NPROJ + C_QM + h * 128;
        bf16x8 q[16]; float o[64];
#pragma unroll
        for (int d = 0; d < 16; ++d) q[d] = ((const bf16x8*)qp)[d];
#pragma unroll
        for (int d = 0; d < 64; ++d) o[d] = 0.f;
        float m = -3.0e38f, l = 0.f;
        for (int j = 0; j < 256; ++j) {
            const bf16x8* kp = (const bf16x8*)(mkv + (size_t)(b * 256 + j) * 1024 + h * 128);
            const bf16x8* vp = (const bf16x8*)(mkv + (size_t)(b * 256 + j) * 1024 + 512 + h * 128 + half * 64);
            float s = 0.f;
#pragma unroll
            for (int d = 0; d < 16; ++d) s += dot8(q[d], kp[d]);
            if (s > m) { const float f = __builtin_amdgcn_exp2f(m - s); l *= f;
#pragma unroll
                for (int d = 0; d < 64; ++d) o[d] *= f;
                m = s; }
            const float p = __builtin_amdgcn_exp2f(s - m); l += p;
#pragma unroll
            for (int d = 0; d < 8; ++d) { const bf16x8 v = vp[d];
#pragma unroll
                for (int e = 0; e < 8; ++e) o[8 * d + e] += p * bf2f((bf16_t)v[e]); }
        }
        const float il = 1.0f / l;
        asm volatile("" ::: "memory");
#pragma unroll
        for (int d = 0; d < 64; ++d) qp[half * 64 + d] = (bf16_t)f2bf(o[d] * il);
    }
}
__device__ __forceinline__ void naive_sgu_stats(const Args& a, const Ctx& c) {
    const bf16_t* proj = (const bf16_t*)(a.ws + WS_PROJ); float* stat = (float*)(a.ws + WS_STAT);
    for (int row = c.gw; row < T; row += c.ngw) {
        const bf16_t* vp = proj + (size_t)row * NPROJ + C_SV;
        float v[8]; float s = 0.f;
#pragma unroll
        for (int i = 0; i < 8; ++i) { v[i] = bf2f(vp[c.lane * 8 + i]); s += v[i]; }
        const float mu = wave_sum(s) * (1.0f / 512.0f); float q = 0.f;
#pragma unroll
        for (int i = 0; i < 8; ++i) { const float d = v[i] - mu; q += d * d; }
        const float rstd = 1.0f / sqrtf(wave_sum(q) * (1.0f / 512.0f) + EPS);
        if (c.lane == 0) { stat[2 * row] = mu; stat[2 * row + 1] = rstd; }
    }
}
__device__ __forceinline__ void naive_sgu(const Args& a, const Ctx& c) {
    bf16_t* proj = (bf16_t*)(a.ws + WS_PROJ); const float* stat = (const float*)(a.ws + WS_STAT);
    const float* w_s = a.in[8]; const float* b_s = a.in[9]; const float* lng = a.in[10]; const float* lnb = a.in[11];
    for (int idx = c.gtid; idx < T * 512; idx += c.ngt) {
        const int ch = idx & 511, row = idx >> 9, g = ch >> 7, i = row & 127, r0 = row & ~127;
        const float gg = lng[ch], bb = lnb[ch];
        float acc = 0.f;
        for (int j = 0; j < 128; ++j) {
            const float v = bf2f(proj[(size_t)(r0 + j) * NPROJ + C_SV + ch]);
            const float vn = (v - stat[2 * (r0 + j)]) * stat[2 * (r0 + j) + 1] * gg + bb;
            acc += w_s[(g * 128 + i) * 128 + j] * vn;
        }
        acc += b_s[g * 128 + i];
        bf16_t* up = proj + (size_t)row * NPROJ + C_U + ch;
        *up = (bf16_t)f2bf(bf2f(*up) * acc);
    }
}
__device__ __forceinline__ void naive_branch(const Args& a, const Ctx& c) {
    const bf16_t* proj = (const bf16_t*)(a.ws + WS_PROJ); bf16_t* merged = (bf16_t*)(a.ws + WS_H);
    const int nN = 1024 / 64, ntask = (T / 64) * nN;
    for (int t = c.gw; t < ntask; t += c.ngw) {
        const int tm = t / nN, tn = t % nN;
        f32x4 m[4][4]; zero_acc(m);
#pragma unroll 1
        for (int br = 0; br < 3; ++br) {
            const int acol = br == 0 ? C_Q : (br == 1 ? C_U : C_QM);
            f32x4 acc[4][4]; zero_acc(acc);
            wt_mma(acc, proj + (size_t)tm * 64 * NPROJ + acol, NPROJ, (const bf16_t*)(a.ws + WS_WBR + br * MiB) + (size_t)tn * 64 * 512, 512, 512, c.lane);
#pragma unroll
            for (int i = 0; i < 4; ++i)
#pragma unroll
                for (int j = 0; j < 4; ++j)
#pragma unroll
                    for (int r = 0; r < 4; ++r) { const int row = tm * 64 + 16 * i + 4 * (c.lane >> 4) + r, col = tn * 64 + 16 * j + (c.lane & 15);
                        m[i][j][r] += bf2f(proj[(size_t)row * NPROJ + C_G + br * 1024 + col]) * acc[i][j][r]; }
        }
#pragma unroll
        for (int i = 0; i < 4; ++i)
#pragma unroll
            for (int j = 0; j < 4; ++j)
#pragma unroll
                for (int r = 0; r < 4; ++r) { const int row = tm * 64 + 16 * i + 4 * (c.lane >> 4) + r, col = tn * 64 + 16 * j + (c.lane & 15);
                    merged[(size_t)row * D + col] = (bf16_t)f2bf(m[i][j][r]); }
    }
}
__device__ __forceinline__ void naive_ssq(const Args& a, const Ctx& c) {
    float* ssq = (float*)(a.ws + WS_SSQ1);
    for (int row = c.gw; row < T; row += c.ngw) {
        const f32x4* xr = (const f32x4*)(a.out + (size_t)row * D); float s = 0.f;
#pragma unroll
        for (int j = 0; j < 4; ++j) { const f32x4 v = xr[c.lane + 64 * j]; s += (v.x * v.x + v.y * v.y) + (v.z * v.z + v.w * v.w); }
        s = wave_sum(s);
        if (c.lane < 16) ssq[(size_t)row * 16 + c.lane] = c.lane == 0 ? s : 0.f;
    }
}
__device__ __forceinline__ void naive_conv(const Args& a, const Ctx& c, int half) {
    const bf16_t* aup = (const bf16_t*)(a.ws + WS_AUP); bf16_t* g = (bf16_t*)(a.ws + WS_G);
    const float* cw = a.in[20]; const float* cb = a.in[21];
    for (int idx = c.gtid; idx < T * 1408; idx += c.ngt) {
        const int row = idx / 1408, lc = idx % 1408, jj = lc >> 7, ii = lc & 127, ch = half * 1408 + lc;
        const int s0 = row < TP ? (row & ~(SEQP - 1)) : TP, S = row < TP ? SEQP : TP, pos = row - s0;
        const size_t o = (size_t)row * DFF + 256 * jj + ii;
        const float g1 = bf2f(aup[o]), u1 = bf2f(aup[o + 128]);
        const float g0 = pos > 0 ? bf2f(aup[o - DFF]) : 0.f, u0 = pos > 0 ? bf2f(aup[o - DFF + 128]) : 0.f;
        const float g2 = pos < S - 1 ? bf2f(aup[o + DFF]) : 0.f, u2 = pos < S - 1 ? bf2f(aup[o + DFF + 128]) : 0.f;
        const float ga = g0 * cw[ch] + g1 * cw[NUP + ch] + g2 * cw[2 * NUP + ch] + cb[ch];
        const float ua = u0 * cw[DFF + ch] + u1 * cw[NUP + DFF + ch] + u2 * cw[2 * NUP + DFF + ch] + cb[DFF + ch];
        g[(size_t)row * DFF + ch] = (bf16_t)f2bf(gelu_tanh(ga) * ua);
    }
}
__device__ __forceinline__ void final_norm(const Args& a, const Ctx& c) {
    const float* gf = a.in[23];
    for (int row = c.gw; row < T; row += c.ngw) {
        f32x4* xr = (f32x4*)(a.out + (size_t)row * D); f32x4 v[4]; float s = 0.f;
#pragma unroll
        for (int j = 0; j < 4; ++j) { v[j] = xr[c.lane + 64 * j]; s += (v[j].x * v[j].x + v[j].y * v[j].y) + (v[j].z * v[j].z + v[j].w * v[j].w); }
        const float rstd = 1.0f / sqrtf(wave_sum(s) * (1.0f / D) + EPS);
#pragma unroll
        for (int j = 0; j < 4; ++j) { const f32x4 gg = ((const f32x4*)gf)[c.lane + 64 * j]; xr[c.lane + 64 * j] = (f32x4){v[j].x * rstd * gg.x, v[j].y * rstd * gg.y, v[j].z * rstd * gg.z, v[j].w * rstd * gg.w}; }
    }
}

enum { PH_PRO = 0, PH_PROJ, PH_MIX, PH_MIX2, PH_SGU, PH_BR, PH_OUTP, PH_SSQ, PH_UP0, PH_CONV0, PH_UP1, PH_CONV1, PH_DOWN, PH_FINAL, PH_N };

__global__ void __launch_bounds__(NTHREADS, 2) fwd(Args a) {
    extern __shared__ __attribute__((aligned(16))) unsigned char lds_raw[];
    LAS unsigned char* lds = (LAS unsigned char*)lds_raw;
    cg::grid_group grid = cg::this_grid();
    Ctx c; c.tid = threadIdx.x; c.lane = c.tid & 63; c.wave = __builtin_amdgcn_readfirstlane(c.tid >> 6);
    c.gw = blockIdx.x * NWAVES + c.wave; c.ngw = gridDim.x * NWAVES; c.gtid = blockIdx.x * NTHREADS + c.tid; c.ngt = gridDim.x * NTHREADS;
    unsigned char* ws = a.ws;
    p0_prologue(a, c, lds);
    grid.sync();
    {
        EpiProjN e{(bf16_t*)(ws + WS_PROJ)};
        sgemm_phase((const bf16_t*)(ws + WS_H), D, (const bf16_t*)(ws + WS_WIN), D, T, NPROJ, D, e, c);
        EpiBf16N e2{(bf16_t*)(ws + WS_MKV), 1024};
        sgemm_phase((const bf16_t*)(ws + WS_MEMN), D, (const bf16_t*)(ws + WS_WMKV), D, MEMROWS, 1024, D, e2, c);
    }
    grid.sync();
    naive_wattn(a, c); naive_sgu_stats(a, c); naive_mattn(a, c);
    grid.sync();
    naive_sgu(a, c);
    grid.sync();
    naive_branch(a, c);
    grid.sync();
    { EpiOutN e{&a, (bf16_t*)(ws + WS_H2)};
      sgemm_phase((const bf16_t*)(ws + WS_H), D, (const bf16_t*)(ws + WS_WOUT), D, T, D, D, e, c); }
    grid.sync();
    naive_ssq(a, c);
    grid.sync();
#pragma unroll 1
    for (int half = 0; half < 2; ++half) {
        EpiUpN e{(bf16_t*)(ws + WS_AUP), (const float*)(ws + WS_SSQ1)};
        sgemm_phase((const bf16_t*)(ws + WS_H2), D, (const bf16_t*)(ws + WS_WUP) + (size_t)half * DFF * D, D, T, DFF, D, e, c);
        grid.sync();
        naive_conv(a, c, half);
        grid.sync();
    }
    { EpiDownN e{a.out};
      sgemm_phase((const bf16_t*)(ws + WS_G), DFF, (const bf16_t*)(ws + WS_WDN), DFF, T, D, DFF, e, c); }
    grid.sync();
    final_norm(a, c);
}

extern "C" void kernel_launch(void* const* d_in, const int* in_sizes, int n_in, void* d_out, int out_size, void* d_ws, size_t ws_size, hipStream_t stream) {
    static int grid = 0;
    if (grid == 0) {
        if (n_in != 24 || out_size != T * D || ws_size < WS_END) { fprintf(stderr, "kernel_launch: unexpected shapes (n_in %d, out %d, ws %zu)\n", n_in, out_size, ws_size); grid = -1; return; }
        int dev = 0, cus = 0, per_cu = 0;
        (void)hipGetDevice(&dev); (void)hipDeviceGetAttribute(&cus, hipDeviceAttributeMultiprocessorCount, dev);
        (void)hipFuncSetAttribute((const void*)fwd, hipFuncAttributeMaxDynamicSharedMemorySize, LDS_BYTES);
        if (hipOccupancyMaxActiveBlocksPerMultiprocessor(&per_cu, (const void*)fwd, NTHREADS, LDS_BYTES) != hipSuccess || per_cu < 1) { fprintf(stderr, "kernel_launch: occupancy query says %d blocks/CU\n", per_cu); (void)hipGetLastError(); grid = -1; return; }
        grid = cus * 1;
    }
    if (grid < 0) return;
    Args a{};
    for (int i = 0; i < 24; ++i) a.in[i] = (const float*)d_in[i];
    a.out = (float*)d_out; a.ws = (unsigned char*)d_ws;
    void* kargs[] = {&a};
    hipError_t e = hipLaunchCooperativeKernel((const void*)fwd, dim3(grid), dim3(NTHREADS), kargs, LDS_BYTES, stream);
    if (e != hipSuccess) fprintf(stderr, "cooperative launch failed: %s (grid %d)\n", hipGetErrorString(e), grid);
}
```

```cpp
#include <hip/hip_runtime.h>
#include <hip/hip_cooperative_groups.h>
namespace cg = cooperative_groups;
#include <cstdio>
#include <cstdint>

typedef unsigned short bf16_t;
typedef short bf16x8 __attribute__((ext_vector_type(8)));
typedef float f32x4 __attribute__((ext_vector_type(4)));
typedef unsigned u32x4 __attribute__((ext_vector_type(4)));
#define LAS __attribute__((address_space(3)))

constexpr int D = 1024, TP = 16384, T = 32768, SEQP = 2048;
constexpr int NPROJ = 5376, DFF = 2816, NUP = 5632, MEMROWS = 2304;
constexpr int C_Q = 0, C_K = 512, C_V = 640, C_U = 768, C_SV = 1280, C_QM = 1792, C_G = 2304;
constexpr float EPS = 1e-6f, LOG2E = 1.4426950408889634f;
constexpr float QSCALE = 0.125f * LOG2E, MSCALE = 0.08838834764831845f * LOG2E;
constexpr int NTHREADS = 512, NWAVES = 8;

constexpr size_t MiB = 1u << 20;
constexpr size_t WS_CTL = 0;
constexpr size_t WS_WIN = 2 * MiB;
constexpr size_t WS_WMKV = 13 * MiB;
constexpr size_t WS_WBR = 15 * MiB;
constexpr size_t WS_WOUT = 18 * MiB;
constexpr size_t WS_WUP = 20 * MiB;
constexpr size_t WS_WDN = 31 * MiB;
constexpr size_t WS_SGUW = 37 * MiB;
constexpr size_t WS_MEMN = 38 * MiB;
constexpr size_t WS_MKV = 43 * MiB;
constexpr size_t WS_SSQ1 = 48 * MiB;
constexpr size_t WS_STAT = 50 * MiB;
constexpr size_t WS_H = 52 * MiB;
constexpr size_t WS_PROJ = 116 * MiB;
constexpr size_t WS_AUP = 52 * MiB;
constexpr size_t WS_G = 228 * MiB;
constexpr size_t WS_H2 = 448 * MiB;
constexpr size_t WS_END = 512 * MiB;

constexpr int LDS_BYTES = 147456;

__device__ __forceinline__ float bf2f(bf16_t v) { return __uint_as_float((unsigned)v << 16); }
__device__ __forceinline__ unsigned f2bf(float f) { unsigned u = __float_as_uint(f); return (u + 0x7fffu + ((u >> 16) & 1u)) >> 16; }
__device__ __forceinline__ unsigned pk2(float lo, float hi) { return f2bf(lo) | (f2bf(hi) << 16); }
__device__ __forceinline__ float gelu_tanh(float x) {
    const float u = x * (1.0f + 0.044715f * x * x) * (2.0f * 0.7978845608028654f * LOG2E);
    return x * __builtin_amdgcn_rcpf(1.0f + __builtin_amdgcn_exp2f(-u));
}
__device__ __forceinline__ float sigmoid_f(float x) { return __builtin_amdgcn_rcpf(1.0f + __builtin_amdgcn_exp2f(-x * LOG2E)); }
__device__ __forceinline__ float wave_sum(float v) {
#pragma unroll
    for (int o = 1; o < 64; o <<= 1) v += __shfl_xor(v, o);
    return v;
}
__device__ __forceinline__ int t5_bucket(int rel) {
    const int n = rel < 0 ? -rel : rel; const int ret = rel > 0 ? 16 : 0;
    if (n < 8) return ret + n;
    int l = (31 - __builtin_clz((unsigned)(n * n))) + 2; if (l > 15) l = 15;
    return ret + l;
}

struct Args {
    const float* in[24];
    float* out; unsigned char* ws;
    int ph_lo, ph_hi;
};

struct Ctx { int tid, lane, wave, gw, ngw, gtid, ngt; };

__device__ __forceinline__ const float* xrow(const Args& a, int r) { return r < TP ? a.in[0] + (size_t)r * D : a.in[1] + (size_t)(r - TP) * D; }
__device__ __forceinline__ const float* memrow(const Args& a, int r) { return r < 2048 ? a.in[2] + (size_t)r * D : a.in[3] + (size_t)(r - 2048) * D; }

__device__ __forceinline__ void tr_item(const float* W, int K, int N, bf16_t* WT, const float* ks, int upmap, LAS float* scr, int item, int lane) {
    const int nblk = N / 32, kb = item / nblk, nb = item % nblk, k0 = 64 * kb, n0 = 32 * nb;
#pragma unroll 8
    for (int i = 0; i < 32; ++i) { const int kk = 2 * i + (lane >> 5); float v = W[(size_t)(k0 + kk) * N + n0 + (lane & 31)]; if (ks) v *= ks[k0 + kk]; scr[kk * 33 + (lane & 31)] = v; }
    asm volatile("s_waitcnt lgkmcnt(0)" ::: "memory");
    int r0 = n0;
    if (upmap) { if (n0 < DFF) r0 = 256 * (n0 / 128) + (n0 % 128); else { const int m = n0 - DFF; r0 = 256 * (m / 128) + 128 + (m % 128); } }
    const int c = lane & 7;
#pragma unroll
    for (int j = 0; j < 4; ++j) { const int n = (lane >> 3) + 8 * j; const LAS float* s = scr + (8 * c) * 33 + n;
        u32x4 o; o.x = pk2(s[0 * 33], s[1 * 33]); o.y = pk2(s[2 * 33], s[3 * 33]); o.z = pk2(s[4 * 33], s[5 * 33]); o.w = pk2(s[6 * 33], s[7 * 33]);
        *(u32x4*)(WT + (size_t)(r0 + n) * K + k0 + 8 * c) = o; }
    asm volatile("s_waitcnt lgkmcnt(0)" ::: "memory");
}
__device__ __forceinline__ void rms_row_to_bf16(const float* xr, const float* g, bf16_t* orow, int lane) {
    f32x4 v[4]; float s = 0.f;
#pragma unroll
    for (int j = 0; j < 4; ++j) { v[j] = ((const f32x4*)xr)[lane + 64 * j]; s += (v[j].x * v[j].x + v[j].y * v[j].y) + (v[j].z * v[j].z + v[j].w * v[j].w); }
    const float rstd = 1.0f / sqrtf(wave_sum(s) * (1.0f / D) + EPS);
#pragma unroll
    for (int j = 0; j < 4; ++j) { const f32x4 gg = ((const f32x4*)g)[lane + 64 * j];
        const unsigned lo = pk2(v[j].x * rstd * gg.x, v[j].y * rstd * gg.y), hi = pk2(v[j].z * rstd * gg.z, v[j].w * rstd * gg.w);
        ((unsigned long long*)orow)[lane + 64 * j] = (unsigned long long)lo | ((unsigned long long)hi << 32); }
}
__device__ __forceinline__ void p0_prologue(const Args& a, const Ctx& c, LAS unsigned char* lds) {
    LAS float* scr = (LAS float*)(lds + c.wave * 16384);
    unsigned char* ws = a.ws;
    constexpr int I_IN = 16 * (NPROJ / 32), I_MKV = 16 * 32, I_BR = 8 * 32, I_OUT = 16 * 32, I_UP = 16 * (NUP / 32), I_DN = (DFF / 64) * 32;
    constexpr int NITEMS = I_IN + I_MKV + 3 * I_BR + I_OUT + I_UP + I_DN;
    for (int it = c.gw; it < NITEMS; it += c.ngw) {
        int r = it;
        if (r < I_IN) { tr_item(a.in[6], D, NPROJ, (bf16_t*)(ws + WS_WIN), nullptr, 0, scr, r, c.lane); continue; } r -= I_IN;
        if (r < I_MKV) { tr_item(a.in[13], D, 1024, (bf16_t*)(ws + WS_WMKV), nullptr, 0, scr, r, c.lane); continue; } r -= I_MKV;
        if (r < I_BR) { tr_item(a.in[14], 512, 1024, (bf16_t*)(ws + WS_WBR), nullptr, 0, scr, r, c.lane); continue; } r -= I_BR;
        if (r < I_BR) { tr_item(a.in[15], 512, 1024, (bf16_t*)(ws + WS_WBR + 1 * MiB), nullptr, 0, scr, r, c.lane); continue; } r -= I_BR;
        if (r < I_BR) { tr_item(a.in[16], 512, 1024, (bf16_t*)(ws + WS_WBR + 2 * MiB), nullptr, 0, scr, r, c.lane); continue; } r -= I_BR;
        if (r < I_OUT) { tr_item(a.in[17], D, 1024, (bf16_t*)(ws + WS_WOUT), nullptr, 0, scr, r, c.lane); continue; } r -= I_OUT;
        if (r < I_UP) { tr_item(a.in[19], D, NUP, (bf16_t*)(ws + WS_WUP), a.in[18], 1, scr, r, c.lane); continue; } r -= I_UP;
        tr_item(a.in[22], DFF, 1024, (bf16_t*)(ws + WS_WDN), nullptr, 0, scr, r, c.lane);
    }
    { bf16_t* o = (bf16_t*)(ws + WS_SGUW); const float* w = a.in[8];
      for (int i = c.gtid; i < 4 * 128 * 128 / 2; i += c.ngt) ((unsigned*)o)[i] = pk2(w[2 * i], w[2 * i + 1]); }
    for (int m = c.gw; m < T; m += c.ngw) rms_row_to_bf16(xrow(a, m), a.in[5], (bf16_t*)(ws + WS_H) + (size_t)m * D, c.lane);
    for (int m = c.gw; m < MEMROWS; m += c.ngw) rms_row_to_bf16(memrow(a, m), a.in[12], (bf16_t*)(ws + WS_MEMN) + (size_t)m * D, c.lane);
}

__device__ __forceinline__ void wt_mma(f32x4 (&acc)[4][4], const bf16_t* A, int lda, const bf16_t* B, int ldb, int K, int lane) {
    const bf16_t* a0 = A + (size_t)(lane & 15) * lda + 8 * (lane >> 4);
    const bf16_t* b0 = B + (size_t)(lane & 15) * ldb + 8 * (lane >> 4);
    for (int k = 0; k < K; k += 32) {
        bf16x8 af[4], bfr[4];
#pragma unroll
        for (int i = 0; i < 4; ++i) { af[i] = *(const bf16x8*)(a0 + (size_t)i * 16 * lda + k); bfr[i] = *(const bf16x8*)(b0 + (size_t)i * 16 * ldb + k); }
#pragma unroll
        for (int i = 0; i < 4; ++i)
#pragma unroll
            for (int j = 0; j < 4; ++j) acc[i][j] = __builtin_amdgcn_mfma_f32_16x16x32_bf16(af[i], bfr[j], acc[i][j], 0, 0, 0);
    }
}
__device__ __forceinline__ void zero_acc(f32x4 (&acc)[4][4]) {
#pragma unroll
    for (int i = 0; i < 4; ++i)
#pragma unroll
        for (int j = 0; j < 4; ++j) acc[i][j] = (f32x4){0.f, 0.f, 0.f, 0.f};
}
template <class Epi>
__device__ __forceinline__ void sgemm_phase(const bf16_t* A, int lda, const bf16_t* Bt, int ldb, int M, int N, int K, const Epi& epi, const Ctx& c) {
    const int nN = N / 64, ntask = (M / 64) * nN;
    for (int t = c.gw; t < ntask; t += c.ngw) {
        const int tm = t / nN, tn = t % nN;
        f32x4 acc[4][4]; zero_acc(acc);
        wt_mma(acc, A + (size_t)tm * 64 * lda, lda, Bt + (size_t)tn * 64 * ldb, ldb, K, c.lane);
#pragma unroll
        for (int i = 0; i < 4; ++i)
#pragma unroll
            for (int r = 0; r < 4; ++r) { const int row = tm * 64 + 16 * i + 4 * (c.lane >> 4) + r; const float rs = epi.rowpre(row);
#pragma unroll
                for (int j = 0; j < 4; ++j) epi(row, tn * 64 + 16 * j + (c.lane & 15), acc[i][j][r] * rs); }
    }
}

struct EpiProjN { bf16_t* P;
    __device__ __forceinline__ float rowpre(int) const { return 1.0f; }
    __device__ __forceinline__ void operator()(int r, int col, float v) const {
        float o;
        if (col < C_K) o = v * QSCALE; else if (col < C_U) o = v; else if (col < C_QM) o = gelu_tanh(v); else if (col < C_G) o = v * MSCALE; else o = sigmoid_f(v);
        P[(size_t)r * NPROJ + col] = (bf16_t)f2bf(o); } };
struct EpiBf16N { bf16_t* P; int ldc;
    __device__ __forceinline__ float rowpre(int) const { return 1.0f; }
    __device__ __forceinline__ void operator()(int r, int col, float v) const { P[(size_t)r * ldc + col] = (bf16_t)f2bf(v); } };
struct EpiOutN { const Args* a; bf16_t* H2;
    __device__ __forceinline__ float rowpre(int) const { return 1.0f; }
    __device__ __forceinline__ void operator()(int r, int col, float v) const { const float x1 = xrow(*a, r)[col] + v; a->out[(size_t)r * D + col] = x1; H2[(size_t)r * D + col] = (bf16_t)f2bf(x1); } };
struct EpiUpN { bf16_t* AUP; const float* ssq;
    __device__ __forceinline__ float rowpre(int r) const {
        float s = 0.f;
#pragma unroll
        for (int i = 0; i < 16; ++i) s += ssq[(size_t)r * 16 + i];
        return 1.0f / sqrtf(s * (1.0f / D) + EPS); }
    __device__ __forceinline__ void operator()(int r, int col, float v) const { AUP[(size_t)r * DFF + col] = (bf16_t)f2bf(v); } };
struct EpiDownN { float* out;
    __device__ __forceinline__ float rowpre(int) const { return 1.0f; }
    __device__ __forceinline__ void operator()(int r, int col, float v) const { out[(size_t)r * D + col] += v; } };

__device__ __forceinline__ float dot8(bf16x8 a, bf16x8 b) {
    float s = 0.f;
#pragma unroll
    for (int i = 0; i < 8; ++i) s += bf2f((bf16_t)a[i]) * bf2f((bf16_t)b[i]);
    return s;
}
__device__ __forceinline__ void naive_wattn(const Args& a, const Ctx& c) {
    bf16_t* proj = (bf16_t*)(a.ws + WS_PROJ);
    const float* relb = a.in[4]; const float* sink = a.in[7];
    for (int idx = c.gtid; idx < T * 8; idx += c.ngt) {
        const int h = idx & 7, row = idx >> 3, kvh = h >> 2;
        const int s0 = row < TP ? (row & ~(SEQP - 1)) : TP, S = row < TP ? SEQP : TP, pos = row - s0;
        bf16x8 q[8]; float o[64];
        bf16_t* qp = proj + (size_t)row * NPROJ + C_Q + h * 64;
#pragma unroll
        for (int d = 0; d < 8; ++d) q[d] = ((const bf16x8*)qp)[d];
#pragma unroll
        for (int d = 0; d < 64; ++d) o[d] = 0.f;
        float m = sink[h] * LOG2E, l = 1.0f;
        const int j0 = pos - 128 < 0 ? 0 : pos - 128, j1 = pos + 128 > S - 1 ? S - 1 : pos + 128;
        for (int j = j0; j <= j1; ++j) {
            const bf16x8* kp = (const bf16x8*)(proj + (size_t)(s0 + j) * NPROJ + C_K + kvh * 64);
            const bf16x8* vp = (const bf16x8*)(proj + (size_t)(s0 + j) * NPROJ + C_V + kvh * 64);
            float s = 0.f;
#pragma unroll
            for (int d = 0; d < 8; ++d) s += dot8(q[d], kp[d]);
            s += relb[t5_bucket(j - pos) * 8 + h] * LOG2E;
            if (s > m) { const float f = __builtin_amdgcn_exp2f(m - s); l *= f;
#pragma unroll
                for (int d = 0; d < 64; ++d) o[d] *= f;
                m = s; }
            const float p = __builtin_amdgcn_exp2f(s - m); l += p;
#pragma unroll
            for (int d = 0; d < 8; ++d) { const bf16x8 v = vp[d];
#pragma unroll
                for (int e = 0; e < 8; ++e) o[8 * d + e] += p * bf2f((bf16_t)v[e]); }
        }
        const float il = 1.0f / l;
#pragma unroll
        for (int d = 0; d < 64; ++d) qp[d] = (bf16_t)f2bf(o[d] * il);
    }
}
__device__ __forceinline__ void naive_mattn(const Args& a, const Ctx& c) {
    bf16_t* proj = (bf16_t*)(a.ws + WS_PROJ); const bf16_t* mkv = (const bf16_t*)(a.ws + WS_MKV);
    for (int idx = c.gtid; idx < T * 8; idx += c.ngt) {
        const int half = idx & 1, h = (idx >> 1) & 3, row = idx >> 3;
        const int b = row < TP ? row / SEQP : 8;
        bf16_t* qp = proj + (size_t)row * NPROJ + C_QM + h * 128;
        bf16x8 q[16]; float o[64];
#pragma unroll
        for (int d = 0; d < 16; ++d) q[d] = ((const bf16x8*)qp)[d];
#pragma unroll
        for (int d = 0; d < 64; ++d) o[d] = 0.f;
        float m = -3.0e38f, l = 0.f;
        for (int j = 0; j < 256; ++j) {
            const bf16x8* kp = (const bf16x8*)(mkv + (size_t)(b * 256 + j) * 1024 + h * 128);
            const bf16x8* vp = (const bf16x8*)(mkv + (size_t)(b * 256 + j) * 1024 + 512 + h * 128 + half * 64);
            float s = 0.f;
#pragma unroll
            for (int d = 0; d < 16; ++d) s += dot8(q[d], kp[d]);
            if (s > m) { const float f = __builtin_amdgcn_exp2f(m - s); l *= f;
#pragma unroll
                for (int d = 0; d < 64; ++d) o[d] *= f;
                m = s; }
            const float p = __builtin_amdgcn_exp2f(s - m); l += p;
#pragma unroll
            for (int d = 0; d < 8; ++d) { const bf16x8 v = vp[d];
#pragma unroll
                for (int e = 0; e < 8; ++e) o[8 * d + e] += p * bf2f((bf16_t)v[e]); }
        }
        const float il = 1.0f / l;
        asm volatile("" ::: "memory");
#pragma unroll
        for (int d = 0; d < 64; ++d) qp[half * 64 + d] = (bf16_t)f2bf(o[d] * il);
    }
}
__device__ __forceinline__ void naive_sgu_stats(const Args& a, const Ctx& c) {
    const bf16_t* proj = (const bf16_t*)(a.ws + WS_PROJ); float* stat = (float*)(a.ws + WS_STAT);
    for (int row = c.gw; row < T; row += c.ngw) {
        const bf16_t* vp = proj + (size_t)row * NPROJ + C_SV;
        float v[8]; float s = 0.f;
#pragma unroll
        for (int i = 0; i < 8; ++i) { v[i] = bf2f(vp[c.lane * 8 + i]); s += v[i]; }
        const float mu = wave_sum(s) * (1.0f / 512.0f); float q = 0.f;
#pragma unroll
        for (int i = 0; i < 8; ++i) { const float d = v[i] - mu; q += d * d; }
        const float rstd = 1.0f / sqrtf(wave_sum(q) * (1.0f / 512.0f) + EPS);
        if (c.lane == 0) { stat[2 * row] = mu; stat[2 * row + 1] = rstd; }
    }
}
__device__ __forceinline__ void naive_sgu(const Args& a, const Ctx& c) {
    bf16_t* proj = (bf16_t*)(a.ws + WS_PROJ); const float* stat = (const float*)(a.ws + WS_STAT);
    const float* w_s = a.in[8]; const float* b_s = a.in[9]; const float* lng = a.in[10]; const float* lnb = a.in[11];
    for (int idx = c.gtid; idx < T * 512; idx += c.ngt) {
        const int ch = idx & 511, row = idx >> 9, g = ch >> 7, i = row & 127, r0 = row & ~127;
        const float gg = lng[ch], bb = lnb[ch];
        float acc = 0.f;
        for (int j = 0; j < 128; ++j) {
            const float v = bf2f(proj[(size_t)(r0 + j) * NPROJ + C_SV + ch]);
            const float vn = (v - stat[2 * (r0 + j)]) * stat[2 * (r0 + j) + 1] * gg + bb;
            acc += w_s[(g * 128 + i) * 128 + j] * vn;
        }
        acc += b_s[g * 128 + i];
        bf16_t* up = proj + (size_t)row * NPROJ + C_U + ch;
        *up = (bf16_t)f2bf(bf2f(*up) * acc);
    }
}
__device__ __forceinline__ void naive_branch(const Args& a, const Ctx& c) {
    const bf16_t* proj = (const bf16_t*)(a.ws + WS_PROJ); bf16_t* merged = (bf16_t*)(a.ws + WS_H);
    const int nN = 1024 / 64, ntask = (T / 64) * nN;
    for (int t = c.gw; t < ntask; t += c.ngw) {
        const int tm = t / nN, tn = t % nN;
        f32x4 m[4][4]; zero_acc(m);
#pragma unroll 1
        for (int br = 0; br < 3; ++br) {
            const int acol = br == 0 ? C_Q : (br == 1 ? C_U : C_QM);
            f32x4 acc[4][4]; zero_acc(acc);
            wt_mma(acc, proj + (size_t)tm * 64 * NPROJ + acol, NPROJ, (const bf16_t*)(a.ws + WS_WBR + br * MiB) + (size_t)tn * 64 * 512, 512, 512, c.lane);
#pragma unroll
            for (int i = 0; i < 4; ++i)
#pragma unroll
                for (int j = 0; j < 4; ++j)
#pragma unroll
                    for (int r = 0; r < 4; ++r) { const int row = tm * 64 + 16 * i + 4 * (c.lane >> 4) + r, col = tn * 64 + 16 * j + (c.lane & 15);
                        m[i][j][r] += bf2f(proj[(size_t)row * NPROJ + C_G + br * 1024 + col]) * acc[i][j][r]; }
        }
#pragma unroll
        for (int i = 0; i < 4; ++i)
#pragma unroll
            for (int j = 0; j < 4; ++j)
#pragma unroll
                for (int r = 0; r < 4; ++r) { const int row = tm * 64 + 16 * i + 4 * (c.lane >> 4) + r, col = tn * 64 + 16 * j + (c.lane & 15);
                    merged[(size_t)row * D + col] = (bf16_t)f2bf(m[i][j][r]); }
    }
}
__device__ __forceinline__ void naive_ssq(const Args& a, const Ctx& c) {
    float* ssq = (float*)(a.ws + WS_SSQ1);
    for (int row = c.gw; row < T; row += c.ngw) {
        const f32x4* xr = (const f32x4*)(a.out + (size_t)row * D); float s = 0.f;
#pragma unroll
        for (int j = 0; j < 4; ++j) { const f32x4 v = xr[c.lane + 64 * j]; s += (v.x * v.x + v.y * v.y) + (v.z * v.z + v.w * v.w); }
        s = wave_sum(s);
        if (c.lane < 16) ssq[(size_t)row * 16 + c.lane] = c.lane == 0 ? s : 0.f;
    }
}
__device__ __forceinline__ void naive_conv(const Args& a, const Ctx& c, int half) {
    const bf16_t* aup = (const bf16_t*)(a.ws + WS_AUP); bf16_t* g = (bf16_t*)(a.ws + WS_G);
    const float* cw = a.in[20]; const float* cb = a.in[21];
    for (int idx = c.gtid; idx < T * 1408; idx += c.ngt) {
        const int row = idx / 1408, lc = idx % 1408, jj = lc >> 7, ii = lc & 127, ch = half * 1408 + lc;
        const int s0 = row < TP ? (row & ~(SEQP - 1)) : TP, S = row < TP ? SEQP : TP, pos = row - s0;
        const size_t o = (size_t)row * DFF + 256 * jj + ii;
        const float g1 = bf2f(aup[o]), u1 = bf2f(aup[o + 128]);
        const float g0 = pos > 0 ? bf2f(aup[o - DFF]) : 0.f, u0 = pos > 0 ? bf2f(aup[o - DFF + 128]) : 0.f;
        const float g2 = pos < S - 1 ? bf2f(aup[o + DFF]) : 0.f, u2 = pos < S - 1 ? bf2f(aup[o + DFF + 128]) : 0.f;
        const float ga = g0 * cw[ch] + g1 * cw[NUP + ch] + g2 * cw[2 * NUP + ch] + cb[ch];
        const float ua = u0 * cw[DFF + ch] + u1 * cw[NUP + DFF + ch] + u2 * cw[2 * NUP + DFF + ch] + cb[DFF + ch];
        g[(size_t)row * DFF + ch] = (bf16_t)f2bf(gelu_tanh(ga) * ua);
    }
}
__device__ __forceinline__ void final_norm(const Args& a, const Ctx& c) {
    const float* gf = a.in[23];
    for (int row = c.gw; row < T; row += c.ngw) {
        f32x4* xr = (f32x4*)(a.out + (size_t)row * D); f32x4 v[4]; float s = 0.f;
#pragma unroll
        for (int j = 0; j < 4; ++j) { v[j] = xr[c.lane + 64 * j]; s += (v[j].x * v[j].x + v[j].y * v[j].y) + (v[j].z * v[j].z + v[j].w * v[j].w); }
        const float rstd = 1.0f / sqrtf(wave_sum(s) * (1.0f / D) + EPS);
#pragma unroll
        for (int j = 0; j < 4; ++j) { const f32x4 gg = ((const f32x4*)gf)[c.lane + 64 * j]; xr[c.lane + 64 * j] = (f32x4){v[j].x * rstd * gg.x, v[j].y * rstd * gg.y, v[j].z * rstd * gg.z, v[j].w * rstd * gg.w}; }
    }
}

namespace pg8 {
constexpr int BM = 256, BK = 64, HALF = 128, HTB = HALF * BK * 2, STAGE_BYTES = 8 * HTB, NXCD = 8, WGM = 8;
__host__ __device__ __forceinline__ int lds_byte(int r, int c) { const int st = (r >> 4) * 2 + (c >> 5), rr = r & 15, cc = c & 31, ob = rr * 64 + cc * 2; return st * 1024 + (ob ^ (((ob >> 9) & 1) << 5)); }
__host__ __device__ __forceinline__ void stage_rc(int b, int& R, int& C) { const int st = b / 1024, sb = b % 1024, swz = sb ^ (((sb >> 9) & 1) << 5); R = (st >> 1) * 16 + swz / 64; C = (st & 1) * 32 + (swz % 64) / 2; }
__host__ __device__ __forceinline__ int perm32(int rho) { const int n = rho >> 4, i = rho & 15; return 8 * (i >> 2) + 4 * n + (i & 3); }

struct Unit { const char* A; const char* B; int pm, pn, aux; };

struct TileOrder {
    int nM, nN, nwg, G, c, rep;
    __device__ __forceinline__ void init(int nM_, int nN_, int G_, int c_, int rep_ = 1) { nM = nM_; nN = nN_; nwg = nM * nN; G = G_; c = c_; rep = rep_; }
    __device__ __forceinline__ bool tile(int i, int& pm, int& pn, int& aux) const {
        const int ti = i / rep; aux = i - ti * rep;
        const long L = (long)ti * G + c; if (L >= nwg) return false;
        int wgid = (int)L; { const int q = nwg / NXCD, r = nwg % NXCD, xcd = wgid % NXCD, off = wgid / NXCD; wgid = (xcd < r ? xcd * (q + 1) : r * (q + 1) + (xcd - r) * q) + off; }
        const int nig = WGM * nN, gid = wgid / nig, fm = gid * WGM, gsz = (nM - fm) < WGM ? (nM - fm) : WGM;
        pm = fm + ((wgid % nig) % gsz); pn = (wgid % nig) / gsz; return true;
    }
};
__device__ __forceinline__ unsigned cvt_pk_bf16(float lo, float hi) { unsigned r; asm volatile("v_cvt_pk_bf16_f32 %0, %1, %2" : "=v"(r) : "v"(lo), "v"(hi)); return r; }

template <class Epi, class Sched, bool ALIGN_EPI = true, bool SP2 = true>
__device__ __forceinline__ void gemm_phase(LAS unsigned char* lds, const int K, const int lda, const Sched& S, const Epi& E) {
    const int tid = threadIdx.x, wid = __builtin_amdgcn_readfirstlane(tid >> 6), lane = tid & 63, wr = wid >> 2, wc = wid & 3, fr = lane & 15, fq = lane >> 4;
    const int nt = K / BK;
    unsigned voffA[2], voffB[2];
#pragma unroll
    for (int i = 0; i < 2; ++i) { int R, C; stage_rc(tid * 16 + i * 8192, R, C); const int Rb = Epi::PERM ? ((R & ~31) + perm32(R & 31)) : R;
        voffA[i] = (unsigned)(R * lda + C) * 2u; voffB[i] = (unsigned)(Rb * K + C) * 2u; }
    const size_t kstep = (size_t)(BK * 2);
    const size_t hstepA = (size_t)HALF * lda * 2, hstepB = (size_t)HALF * K * 2;
    const unsigned ldsw = (unsigned)wid * 1024u;
    const int aoff = lds_byte(wr * 64 + fr, fq * 8), boff = lds_byte(wc * 32 + fr, fq * 8);
#define PG8_SA(b, h) (((b) * 2 + (h)) * HTB)
#define PG8_SB(b, h) ((4 + (b) * 2 + (h)) * HTB)
#define PG8_STAGE(bufoff, gbase, voff) do { _Pragma("unroll") for (int _i = 0; _i < 2; ++_i) \
        __builtin_amdgcn_global_load_lds((const unsigned*)((const char*)(gbase) + (voff)[_i]), (LAS unsigned*)(lds + (bufoff) + ldsw + _i * 8192), 16, 0, 0); } while (0)
#define PG8_LDA(dst, b, h) do { _Pragma("unroll") for (int m = 0; m < 4; ++m) _Pragma("unroll") for (int k = 0; k < 2; ++k) dst[m][k] = *(const LAS bf16x8*)(lds + PG8_SA(b, h) + aoff + m * 2048 + k * 1024); } while (0)
#define PG8_LDB(dst, b, h) do { _Pragma("unroll") for (int n = 0; n < 2; ++n) _Pragma("unroll") for (int k = 0; k < 2; ++k) dst[n][k] = *(const LAS bf16x8*)(lds + PG8_SB(b, h) + boff + n * 2048 + k * 1024); } while (0)
#define PG8_MMA(ai, bj, At, Bt) do { __builtin_amdgcn_s_setprio(1); _Pragma("unroll") for (int m = 0; m < 4; ++m) _Pragma("unroll") for (int n = 0; n < 2; ++n) _Pragma("unroll") for (int k = 0; k < 2; ++k) \
        acc[ai][bj][m][n] = __builtin_amdgcn_mfma_f32_16x16x32_bf16(Bt[n][k], At[m][k], acc[ai][bj][m][n], 0, 0, 0); __builtin_amdgcn_s_setprio(0); } while (0)
#define PG8_WAIT_V(n) asm volatile("s_waitcnt vmcnt(" #n ")" ::: "memory")
#define PG8_WAIT_L(n) asm volatile("s_waitcnt lgkmcnt(" #n ")" ::: "memory")
#define PG8_BAR __builtin_amdgcn_s_barrier()
#define PG8_SCHED __builtin_amdgcn_sched_barrier(0)
    Unit cur, nxt; int ui = 0;
    if (!S.next(0, cur)) return;
    f32x4 acc[2][2][4][2];
#pragma unroll
    for (int a = 0; a < 2; ++a)
#pragma unroll
        for (int b = 0; b < 2; ++b)
#pragma unroll
            for (int m = 0; m < 4; ++m)
#pragma unroll
                for (int n = 0; n < 2; ++n) acc[a][b][m][n] = (f32x4){0.f, 0.f, 0.f, 0.f};
    bf16x8 At[4][2], B0[2][2], B1[2][2];
    const char* cA = cur.A; const char* cB = cur.B;
    if constexpr (SP2) {
        PG8_STAGE(PG8_SB(0, 0), cB, voffB); PG8_STAGE(PG8_SB(0, 1), cB + hstepB, voffB); PG8_STAGE(PG8_SA(0, 0), cA, voffA); PG8_STAGE(PG8_SA(0, 1), cA + hstepA, voffA);
        if (wr == 1) PG8_BAR;
        PG8_WAIT_V(2); PG8_BAR;
        PG8_STAGE(PG8_SB(1, 0), cB + kstep, voffB); PG8_STAGE(PG8_SA(1, 0), cA + kstep, voffA); PG8_STAGE(PG8_SB(1, 1), cB + hstepB + kstep, voffB);
        PG8_WAIT_V(6); PG8_BAR;
    } else {
        PG8_STAGE(PG8_SB(0, 0), cB, voffB); PG8_STAGE(PG8_SA(0, 0), cA, voffA); PG8_STAGE(PG8_SB(0, 1), cB + hstepB, voffB); PG8_STAGE(PG8_SA(0, 1), cA + hstepA, voffA);
        if (wr == 1) PG8_BAR;
        PG8_WAIT_V(4); PG8_BAR;
        PG8_STAGE(PG8_SB(1, 0), cB + kstep, voffB); PG8_STAGE(PG8_SA(1, 0), cA + kstep, voffA); PG8_STAGE(PG8_SB(1, 1), cB + hstepB + kstep, voffB);
        PG8_WAIT_V(6); PG8_BAR;
    }
    for (;;) {
        const bool has_next = S.next(ui + 1, nxt);
        const char* nA = has_next ? nxt.A : cA; const char* nB = has_next ? nxt.B : cB;
        for (int t = 0; t < nt; t += 2) {
            const bool last = (t == nt - 2);
            const char* a1 = cA + (size_t)(t + 1) * kstep;
            const char* a2 = last ? nA : cA + (size_t)(t + 2) * kstep; const char* b2 = last ? nB : cB + (size_t)(t + 2) * kstep;
            const char* a3 = a2 + kstep; const char* b3 = b2 + kstep;
            if constexpr (SP2) {
            PG8_LDB(B0, 0, 0); PG8_LDB(B1, 0, 1); PG8_SCHED; PG8_LDA(At, 0, 0); PG8_STAGE(PG8_SA(1, 1), a1 + hstepA, voffA);
            PG8_WAIT_V(8); PG8_WAIT_L(0); PG8_BAR; PG8_MMA(0, 0, At, B0); PG8_MMA(0, 1, At, B1); PG8_BAR; PG8_SCHED;
            PG8_LDA(At, 0, 1); PG8_STAGE(PG8_SB(0, 0), b2, voffB); PG8_STAGE(PG8_SB(0, 1), b2 + hstepB, voffB); PG8_STAGE(PG8_SA(0, 0), a2, voffA);
            PG8_WAIT_V(8); PG8_WAIT_L(0); PG8_BAR; PG8_MMA(1, 0, At, B0); PG8_MMA(1, 1, At, B1); PG8_BAR; PG8_SCHED;
            PG8_LDB(B0, 1, 0); PG8_LDB(B1, 1, 1); PG8_SCHED; PG8_LDA(At, 1, 0); PG8_STAGE(PG8_SA(0, 1), a2 + hstepA, voffA);
            PG8_WAIT_V(8); PG8_WAIT_L(0); PG8_BAR; PG8_MMA(0, 0, At, B0); PG8_MMA(0, 1, At, B1); PG8_BAR; PG8_SCHED;
            PG8_LDA(At, 1, 1); PG8_STAGE(PG8_SB(1, 0), b3, voffB); PG8_STAGE(PG8_SB(1, 1), b3 + hstepB, voffB); PG8_STAGE(PG8_SA(1, 0), a3, voffA);
            PG8_WAIT_V(8); PG8_WAIT_L(0); PG8_BAR; PG8_MMA(1, 0, At, B0); PG8_MMA(1, 1, At, B1); PG8_BAR; PG8_SCHED;
            } else {
            PG8_LDB(B0, 0, 0); PG8_SCHED; PG8_LDA(At, 0, 0); PG8_STAGE(PG8_SA(1, 1), a1 + hstepA, voffA);
            PG8_WAIT_L(8); PG8_BAR; PG8_WAIT_L(0); PG8_MMA(0, 0, At, B0); PG8_BAR; PG8_SCHED;
            PG8_LDB(B1, 0, 1); PG8_STAGE(PG8_SB(0, 0), b2, voffB);
            PG8_BAR; PG8_WAIT_L(0); PG8_MMA(0, 1, At, B1); PG8_BAR;
            PG8_LDA(At, 0, 1); PG8_STAGE(PG8_SA(0, 0), a2, voffA);
            PG8_BAR; PG8_WAIT_L(0); PG8_MMA(1, 0, At, B0); PG8_BAR; PG8_SCHED;
            PG8_STAGE(PG8_SB(0, 1), b2 + hstepB, voffB);
            PG8_WAIT_V(6); PG8_BAR; PG8_MMA(1, 1, At, B1); PG8_BAR;
            PG8_LDB(B0, 1, 0); PG8_SCHED; PG8_LDA(At, 1, 0); PG8_STAGE(PG8_SA(0, 1), a2 + hstepA, voffA);
            PG8_WAIT_L(8); PG8_BAR; PG8_WAIT_L(0); PG8_MMA(0, 0, At, B0); PG8_BAR; PG8_SCHED;
            PG8_LDB(B1, 1, 1); PG8_STAGE(PG8_SB(1, 0), b3, voffB);
            PG8_BAR; PG8_WAIT_L(0); PG8_MMA(0, 1, At, B1); PG8_BAR;
            PG8_LDA(At, 1, 1); PG8_STAGE(PG8_SA(1, 0), a3, voffA);
            PG8_BAR; PG8_WAIT_L(0); PG8_MMA(1, 0, At, B0); PG8_BAR; PG8_SCHED;
            PG8_STAGE(PG8_SB(1, 1), b3 + hstepB, voffB);
            PG8_WAIT_V(6); PG8_BAR; PG8_MMA(1, 1, At, B1); PG8_BAR;
            }
        }
        if constexpr (ALIGN_EPI) { if (wr == 0) PG8_BAR; }
        E(acc, cur, wr, wc, fr, fq);
        if (!has_next) break;
#pragma unroll
        for (int a = 0; a < 2; ++a)
#pragma unroll
            for (int b = 0; b < 2; ++b)
#pragma unroll
                for (int m = 0; m < 4; ++m)
#pragma unroll
                    for (int n = 0; n < 2; ++n) acc[a][b][m][n] = (f32x4){0.f, 0.f, 0.f, 0.f};
        cur = nxt; cA = nA; cB = nB; ++ui;
        if constexpr (ALIGN_EPI) { if (wr == 1) PG8_BAR; }
    }
    PG8_WAIT_V(0);
    if constexpr (!ALIGN_EPI) { if (wr == 0) PG8_BAR; }
    PG8_BAR;
#undef PG8_SA
#undef PG8_SB
#undef PG8_STAGE
#undef PG8_LDA
#undef PG8_LDB
#undef PG8_MMA
#undef PG8_WAIT_V
#undef PG8_WAIT_L
#undef PG8_BAR
#undef PG8_SCHED
}

struct SchedPlain {
    TileOrder o; const char* A; const char* B; size_t strideA, strideB;
    __device__ __forceinline__ bool next(int i, Unit& u) const { int aux; if (!o.tile(i, u.pm, u.pn, aux)) return false; u.aux = aux; u.A = A + (size_t)u.pm * strideA; u.B = B + (size_t)u.pn * strideB; return true; }
};
struct SchedOne {
    int idx, nN; const char* A; const char* B; size_t strideA, strideB;
    __device__ __forceinline__ bool next(int i, Unit& u) const { if (i > 0 || idx < 0) return false; u.pm = idx / nN; u.pn = idx % nN; u.aux = 0; u.A = A + (size_t)u.pm * strideA; u.B = B + (size_t)u.pn * strideB; return true; }
};

__device__ __forceinline__ f32x4 act4(f32x4 v, int mode) {
    if (mode == 1) return v * QSCALE;
    if (mode == 3) return v * MSCALE;
    if (mode == 2) return (f32x4){gelu_tanh(v[0]), gelu_tanh(v[1]), gelu_tanh(v[2]), gelu_tanh(v[3])};
    if (mode == 4) return (f32x4){sigmoid_f(v[0]), sigmoid_f(v[1]), sigmoid_f(v[2]), sigmoid_f(v[3])};
    return v;
}
struct EpiProj {
    static constexpr bool PERM = true;
    bf16_t* P;
    __device__ __forceinline__ void operator()(const f32x4 (&acc)[2][2][4][2], const Unit& u, int wr, int wc, int fr, int fq) const {
        const int pn = u.pn, mode = pn < 2 ? 1 : (pn == 2 ? 0 : (pn < 7 ? 2 : (pn < 9 ? 3 : 4)));
        const int row0 = u.pm * BM + wr * 64 + fr, col0 = pn * BM + wc * 32 + 8 * fq;
#pragma unroll
        for (int ai = 0; ai < 2; ++ai)
#pragma unroll
            for (int m = 0; m < 4; ++m) { bf16_t* rowp = P + (size_t)(row0 + ai * HALF + m * 16) * NPROJ + col0;
#pragma unroll
                for (int bj = 0; bj < 2; ++bj) { const f32x4 v0 = act4(acc[ai][bj][m][0], mode), v1 = act4(acc[ai][bj][m][1], mode);
                    u32x4 w; w.x = cvt_pk_bf16(v0[0], v0[1]); w.y = cvt_pk_bf16(v0[2], v0[3]); w.z = cvt_pk_bf16(v1[0], v1[1]); w.w = cvt_pk_bf16(v1[2], v1[3]);
                    *(u32x4*)(rowp + bj * HALF) = w; } }
    }
};
struct EpiPlain {
    static constexpr bool PERM = true;
    bf16_t* P; int ldc;
    __device__ __forceinline__ void operator()(const f32x4 (&acc)[2][2][4][2], const Unit& u, int wr, int wc, int fr, int fq) const {
        const int row0 = u.pm * BM + wr * 64 + fr, col0 = u.pn * BM + wc * 32 + 8 * fq;
#pragma unroll
        for (int ai = 0; ai < 2; ++ai)
#pragma unroll
            for (int m = 0; m < 4; ++m) { bf16_t* rowp = P + (size_t)(row0 + ai * HALF + m * 16) * ldc + col0;
#pragma unroll
                for (int bj = 0; bj < 2; ++bj) { const f32x4 v0 = acc[ai][bj][m][0], v1 = acc[ai][bj][m][1];
                    u32x4 w; w.x = cvt_pk_bf16(v0[0], v0[1]); w.y = cvt_pk_bf16(v0[2], v0[3]); w.z = cvt_pk_bf16(v1[0], v1[1]); w.w = cvt_pk_bf16(v1[2], v1[3]);
                    *(u32x4*)(rowp + bj * HALF) = w; } }
    }
};
__device__ __forceinline__ f32x4 unpk4(unsigned a, unsigned b) { return (f32x4){__uint_as_float(a << 16), __uint_as_float(a & 0xffff0000u), __uint_as_float(b << 16), __uint_as_float(b & 0xffff0000u)}; }
struct SchedBranch {
    TileOrder o; const char* proj; const char* wbr;
    __device__ __forceinline__ bool next(int i, Unit& u) const { int aux; if (!o.tile(i, u.pm, u.pn, aux)) return false; u.aux = aux;
        const int acol = aux == 0 ? C_Q : (aux == 1 ? C_U : C_QM);
        u.A = proj + ((size_t)u.pm * 256 * NPROJ + acol) * 2; u.B = wbr + (size_t)aux * MiB + (size_t)u.pn * 256 * 512 * 2; return true; }
};
struct EpiBranch {
    static constexpr bool PERM = true;
    const bf16_t* proj; bf16_t* merged;
    __device__ __forceinline__ void operator()(const f32x4 (&acc)[2][2][4][2], const Unit& u, int wr, int wc, int fr, int fq) const {
        const int br = u.aux, row0 = u.pm * BM + wr * 64 + fr, col0 = u.pn * BM + wc * 32 + 8 * fq;
#pragma unroll
        for (int ai = 0; ai < 2; ++ai)
#pragma unroll
            for (int m = 0; m < 4; ++m) { const int row = row0 + ai * HALF + m * 16;
                const bf16_t* gp = proj + (size_t)row * NPROJ + C_G + br * 1024 + col0; bf16_t* mp = merged + (size_t)row * D + col0;
#pragma unroll
                for (int bj = 0; bj < 2; ++bj) { const u32x4 gw = *(const u32x4*)(gp + bj * HALF);
                    f32x4 v0 = acc[ai][bj][m][0] * unpk4(gw.x, gw.y), v1 = acc[ai][bj][m][1] * unpk4(gw.z, gw.w);
                    if (br > 0) { const u32x4 mw = *(const u32x4*)(mp + bj * HALF); v0 += unpk4(mw.x, mw.y); v1 += unpk4(mw.z, mw.w); }
                    u32x4 w; w.x = cvt_pk_bf16(v0[0], v0[1]); w.y = cvt_pk_bf16(v0[2], v0[3]); w.z = cvt_pk_bf16(v1[0], v1[1]); w.w = cvt_pk_bf16(v1[2], v1[3]);
                    *(u32x4*)(mp + bj * HALF) = w; } }
    }
};
struct EpiOut {
    static constexpr bool PERM = false;
    const float* xp; const float* xs; float* out; bf16_t* H2; float* ssq;
    __device__ __forceinline__ void operator()(const f32x4 (&acc)[2][2][4][2], const Unit& u, int wr, int wc, int fr, int fq) const {
        const int col0 = u.pn * BM + wc * 32 + 4 * fq;
#pragma unroll
        for (int ai = 0; ai < 2; ++ai)
#pragma unroll
            for (int m = 0; m < 4; ++m) { const int row = u.pm * BM + ai * HALF + wr * 64 + m * 16 + fr;
                const float* xr = (row < TP ? xp + (size_t)row * D : xs + (size_t)(row - TP) * D) + col0; const size_t ob = (size_t)row * D + col0; float s = 0.f;
#pragma unroll
                for (int bj = 0; bj < 2; ++bj)
#pragma unroll
                    for (int n = 0; n < 2; ++n) { const int off = bj * HALF + n * 16; const f32x4 x1 = *(const f32x4*)(xr + off) + acc[ai][bj][m][n];
                        *(f32x4*)(out + ob + off) = x1; s += (x1[0] * x1[0] + x1[1] * x1[1]) + (x1[2] * x1[2] + x1[3] * x1[3]);
                        const unsigned lo = cvt_pk_bf16(x1[0], x1[1]), hi = cvt_pk_bf16(x1[2], x1[3]);
                        *(unsigned long long*)(H2 + ob + off) = (unsigned long long)lo | ((unsigned long long)hi << 32); }
                s += __shfl_xor(s, 16); s += __shfl_xor(s, 32);
                if (fq == 0) ssq[(size_t)row * 16 + u.pn * 4 + wc] = s; }
    }
};
struct EpiDown {
    static constexpr bool PERM = false;
    float* out;
    __device__ __forceinline__ void operator()(const f32x4 (&acc)[2][2][4][2], const Unit& u, int wr, int wc, int fr, int fq) const {
        const int col0 = u.pn * BM + wc * 32 + 4 * fq;
#pragma unroll
        for (int ai = 0; ai < 2; ++ai)
#pragma unroll
            for (int m = 0; m < 4; ++m) { const int row = u.pm * BM + ai * HALF + wr * 64 + m * 16 + fr; float* op = out + (size_t)row * D + col0;
#pragma unroll
                for (int bj = 0; bj < 2; ++bj)
#pragma unroll
                    for (int n = 0; n < 2; ++n) { f32x4* o = (f32x4*)(op + bj * HALF + n * 16); *o = *o + acc[ai][bj][m][n]; } }
    }
};
struct EpiUpHalf {
    static constexpr bool PERM = true;
    bf16_t* P; const float* ssq;
    __device__ __forceinline__ void operator()(const f32x4 (&acc)[2][2][4][2], const Unit& u, int wr, int wc, int fr, int fq) const {
        const int row0 = u.pm * BM + wr * 64 + fr, col0 = u.pn * BM + wc * 32 + 8 * fq;
#pragma unroll
        for (int ai = 0; ai < 2; ++ai)
#pragma unroll
            for (int m = 0; m < 4; ++m) { const int row = row0 + ai * HALF + m * 16; bf16_t* rowp = P + (size_t)row * DFF + col0;
                const f32x4* sp = (const f32x4*)(ssq + (size_t)row * 16); const f32x4 s4 = (sp[0] + sp[1]) + (sp[2] + sp[3]);
                const float rstd = 1.0f / sqrtf(((s4[0] + s4[1]) + (s4[2] + s4[3])) * (1.0f / D) + EPS);
#pragma unroll
                for (int bj = 0; bj < 2; ++bj) { const f32x4 v0 = acc[ai][bj][m][0] * rstd, v1 = acc[ai][bj][m][1] * rstd;
                    u32x4 w; w.x = cvt_pk_bf16(v0[0], v0[1]); w.y = cvt_pk_bf16(v0[2], v0[3]); w.z = cvt_pk_bf16(v1[0], v1[1]); w.w = cvt_pk_bf16(v1[2], v1[3]);
                    *(u32x4*)(rowp + bj * HALF) = w; } }
    }
};
}

enum { PH_PRO = 0, PH_PROJ, PH_MIX, PH_MIX2, PH_SGU, PH_BR, PH_OUTP, PH_SSQ, PH_UP0, PH_CONV0, PH_UP1, PH_CONV1, PH_DOWN, PH_FINAL, PH_N };

__global__ void __launch_bounds__(NTHREADS, 2) fwd(Args a) {
    extern __shared__ __attribute__((aligned(16))) unsigned char lds_raw[];
    LAS unsigned char* lds = (LAS unsigned char*)lds_raw;
    cg::grid_group grid = cg::this_grid();
    Ctx c; c.tid = threadIdx.x; c.lane = c.tid & 63; c.wave = __builtin_amdgcn_readfirstlane(c.tid >> 6);
    c.gw = blockIdx.x * NWAVES + c.wave; c.ngw = gridDim.x * NWAVES; c.gtid = blockIdx.x * NTHREADS + c.tid; c.ngt = gridDim.x * NTHREADS;
    unsigned char* ws = a.ws;
    p0_prologue(a, c, lds);
    grid.sync();
    {
        pg8::SchedPlain S; S.o.init(T / 256, NPROJ / 256, (int)gridDim.x, (int)blockIdx.x); S.A = (const char*)(ws + WS_H); S.B = (const char*)(ws + WS_WIN); S.strideA = (size_t)256 * D * 2; S.strideB = (size_t)256 * D * 2;
        pg8::EpiProj E{(bf16_t*)(ws + WS_PROJ)};
        pg8::gemm_phase(lds, D, D, S, E);
        pg8::SchedOne S2; S2.idx = ((int)blockIdx.x >= 128 && (int)blockIdx.x < 128 + 36) ? (int)blockIdx.x - 128 : -1; S2.nN = 4;
        S2.A = (const char*)(ws + WS_MEMN); S2.B = (const char*)(ws + WS_WMKV); S2.strideA = (size_t)256 * D * 2; S2.strideB = (size_t)256 * D * 2;
        pg8::EpiPlain E2{(bf16_t*)(ws + WS_MKV), 1024};
        pg8::gemm_phase(lds, D, D, S2, E2);
    }
    grid.sync();
    naive_wattn(a, c); naive_sgu_stats(a, c); naive_mattn(a, c);
    grid.sync();
    naive_sgu(a, c);
    grid.sync();
    {
        pg8::SchedBranch S; S.o.init(T / 256, 4, (int)gridDim.x, (int)blockIdx.x, 3); S.proj = (const char*)(ws + WS_PROJ); S.wbr = (const char*)(ws + WS_WBR);
        pg8::EpiBranch E{(const bf16_t*)(ws + WS_PROJ), (bf16_t*)(ws + WS_H)};
        pg8::gemm_phase(lds, 512, NPROJ, S, E);
    }
    grid.sync();
    {
        pg8::SchedPlain S; S.o.init(T / 256, 4, (int)gridDim.x, (int)blockIdx.x); S.A = (const char*)(ws + WS_H); S.B = (const char*)(ws + WS_WOUT); S.strideA = (size_t)256 * D * 2; S.strideB = (size_t)256 * D * 2;
        pg8::EpiOut E{a.in[0], a.in[1], a.out, (bf16_t*)(ws + WS_H2), (float*)(ws + WS_SSQ1)};
        pg8::gemm_phase(lds, D, D, S, E);
    }
    grid.sync();
#pragma unroll 1
    for (int half = 0; half < 2; ++half) {
        pg8::SchedPlain S; S.o.init(T / 256, 11, (int)gridDim.x, (int)blockIdx.x); S.A = (const char*)(ws + WS_H2); S.B = (const char*)(ws + WS_WUP) + (size_t)half * DFF * D * 2; S.strideA = (size_t)256 * D * 2; S.strideB = (size_t)256 * D * 2;
        pg8::EpiUpHalf E{(bf16_t*)(ws + WS_AUP), (const float*)(ws + WS_SSQ1)};
        pg8::gemm_phase(lds, D, D, S, E);
        grid.sync();
        naive_conv(a, c, half);
        grid.sync();
    }
    {
        pg8::SchedPlain S; S.o.init(T / 256, 4, (int)gridDim.x, (int)blockIdx.x); S.A = (const char*)(ws + WS_G); S.B = (const char*)(ws + WS_WDN); S.strideA = (size_t)256 * DFF * 2; S.strideB = (size_t)256 * DFF * 2;
        pg8::EpiDown E{a.out};
        pg8::gemm_phase(lds, DFF, DFF, S, E);
    }
    grid.sync();
    final_norm(a, c);
}

extern "C" void kernel_launch(void* const* d_in, const int* in_sizes, int n_in, void* d_out, int out_size, void* d_ws, size_t ws_size, hipStream_t stream) {
    static int grid = 0;
    if (grid == 0) {
        if (n_in != 24 || out_size != T * D || ws_size < WS_END) { fprintf(stderr, "kernel_launch: unexpected shapes (n_in %d, out %d, ws %zu)\n", n_in, out_size, ws_size); grid = -1; return; }
        int dev = 0, cus = 0, per_cu = 0;
        (void)hipGetDevice(&dev); (void)hipDeviceGetAttribute(&cus, hipDeviceAttributeMultiprocessorCount, dev);
        (void)hipFuncSetAttribute((const void*)fwd, hipFuncAttributeMaxDynamicSharedMemorySize, LDS_BYTES);
        if (hipOccupancyMaxActiveBlocksPerMultiprocessor(&per_cu, (const void*)fwd, NTHREADS, LDS_BYTES) != hipSuccess || per_cu < 1) { fprintf(stderr, "kernel_launch: occupancy query says %d blocks/CU\n", per_cu); (void)hipGetLastError(); grid = -1; return; }
        grid = cus * 1;
    }
    if (grid < 0) return;
    Args a{};
    for (int i = 0; i < 24; ++i) a.in[i] = (const float*)d_in[i];
    a.out = (float*)d_out; a.ws = (unsigned char*)d_ws;
    void* kargs[] = {&a};
    hipError_t e = hipLaunchCooperativeKernel((const void*)fwd, dim3(grid), dim3(NTHREADS), kargs, LDS_BYTES, stream);
    if (e != hipSuccess) fprintf(stderr, "cooperative launch failed: %s (grid %d)\n", hipGetErrorString(e), grid);
}
```

```cpp
#include <hip/hip_runtime.h>
#include <hip/hip_cooperative_groups.h>
namespace cg = cooperative_groups;
#include <cstdio>
#include <cstdint>

typedef unsigned short bf16_t;
typedef short bf16x8 __attribute__((ext_vector_type(8)));
typedef float f32x4 __attribute__((ext_vector_type(4)));
typedef unsigned u32x4 __attribute__((ext_vector_type(4)));
#define LAS __attribute__((address_space(3)))

constexpr int D = 1024, TP = 16384, T = 32768, SEQP = 2048;
constexpr int NPROJ = 5376, DFF = 2816, NUP = 5632, MEMROWS = 2304;
constexpr int C_Q = 0, C_K = 512, C_V = 640, C_U = 768, C_SV = 1280, C_QM = 1792, C_G = 2304;
constexpr float EPS = 1e-6f, LOG2E = 1.4426950408889634f;
constexpr float QSCALE = 0.125f * LOG2E, MSCALE = 0.08838834764831845f * LOG2E;
constexpr int NTHREADS = 512, NWAVES = 8;

constexpr size_t MiB = 1u << 20;
constexpr size_t WS_CTL = 0;
constexpr size_t WS_WIN = 2 * MiB;
constexpr size_t WS_WMKV = 13 * MiB;
constexpr size_t WS_WBR = 15 * MiB;
constexpr size_t WS_WOUT = 18 * MiB;
constexpr size_t WS_WUP = 20 * MiB;
constexpr size_t WS_WDN = 31 * MiB;
constexpr size_t WS_SGUW = 37 * MiB;
constexpr size_t WS_MEMN = 38 * MiB;
constexpr size_t WS_MKV = 43 * MiB;
constexpr size_t WS_SSQ1 = 48 * MiB;
constexpr size_t WS_STAT = 50 * MiB;
constexpr size_t WS_H = 52 * MiB;
constexpr size_t WS_PROJ = 116 * MiB;
constexpr size_t WS_AUP = 52 * MiB;
constexpr size_t WS_G = 228 * MiB;
constexpr size_t WS_H2 = 448 * MiB;
constexpr size_t WS_END = 512 * MiB;

constexpr int LDS_BYTES = 147456;

__device__ __forceinline__ float bf2f(bf16_t v) { return __uint_as_float((unsigned)v << 16); }
__device__ __forceinline__ unsigned f2bf(float f) { unsigned u = __float_as_uint(f); return (u + 0x7fffu + ((u >> 16) & 1u)) >> 16; }
__device__ __forceinline__ unsigned pk2(float lo, float hi) { return f2bf(lo) | (f2bf(hi) << 16); }
__device__ __forceinline__ float gelu_tanh(float x) {
    const float u = x * (1.0f + 0.044715f * x * x) * (2.0f * 0.7978845608028654f * LOG2E);
    return x * __builtin_amdgcn_rcpf(1.0f + __builtin_amdgcn_exp2f(-u));
}
__device__ __forceinline__ float sigmoid_f(float x) { return __builtin_amdgcn_rcpf(1.0f + __builtin_amdgcn_exp2f(-x * LOG2E)); }
__device__ __forceinline__ float wave_sum(float v) {
#pragma unroll
    for (int o = 1; o < 64; o <<= 1) v += __shfl_xor(v, o);
    return v;
}
__device__ __forceinline__ int t5_bucket(int rel) {
    const int n = rel < 0 ? -rel : rel; const int ret = rel > 0 ? 16 : 0;
    if (n < 8) return ret + n;
    int l = (31 - __builtin_clz((unsigned)(n * n))) + 2; if (l > 15) l = 15;
    return ret + l;
}

struct Args {
    const float* in[24];
    float* out; unsigned char* ws;
    int ph_lo, ph_hi;
};

struct Ctx { int tid, lane, wave, gw, ngw, gtid, ngt; };

__device__ __forceinline__ const float* xrow(const Args& a, int r) { return r < TP ? a.in[0] + (size_t)r * D : a.in[1] + (size_t)(r - TP) * D; }
__device__ __forceinline__ const float* memrow(const Args& a, int r) { return r < 2048 ? a.in[2] + (size_t)r * D : a.in[3] + (size_t)(r - 2048) * D; }

__device__ __forceinline__ void tr_item(const float* W, int K, int N, bf16_t* WT, const float* ks, int upmap, LAS float* scr, int item, int lane) {
    const int nblk = N / 32, kb = item / nblk, nb = item % nblk, k0 = 64 * kb, n0 = 32 * nb;
#pragma unroll 8
    for (int i = 0; i < 32; ++i) { const int kk = 2 * i + (lane >> 5); float v = W[(size_t)(k0 + kk) * N + n0 + (lane & 31)]; if (ks) v *= ks[k0 + kk]; scr[kk * 33 + (lane & 31)] = v; }
    asm volatile("s_waitcnt lgkmcnt(0)" ::: "memory");
    int r0 = n0;
    if (upmap) { if (n0 < DFF) r0 = 256 * (n0 / 128) + (n0 % 128); else { const int m = n0 - DFF; r0 = 256 * (m / 128) + 128 + (m % 128); } }
    const int c = lane & 7;
#pragma unroll
    for (int j = 0; j < 4; ++j) { const int n = (lane >> 3) + 8 * j; const LAS float* s = scr + (8 * c) * 33 + n;
        u32x4 o; o.x = pk2(s[0 * 33], s[1 * 33]); o.y = pk2(s[2 * 33], s[3 * 33]); o.z = pk2(s[4 * 33], s[5 * 33]); o.w = pk2(s[6 * 33], s[7 * 33]);
        *(u32x4*)(WT + (size_t)(r0 + n) * K + k0 + 8 * c) = o; }
    asm volatile("s_waitcnt lgkmcnt(0)" ::: "memory");
}
__device__ __forceinline__ void rms_row_to_bf16(const float* xr, const float* g, bf16_t* orow, int lane) {
    f32x4 v[4]; float s = 0.f;
#pragma unroll
    for (int j = 0; j < 4; ++j) { v[j] = ((const f32x4*)xr)[lane + 64 * j]; s += (v[j].x * v[j].x + v[j].y * v[j].y) + (v[j].z * v[j].z + v[j].w * v[j].w); }
    const float rstd = 1.0f / sqrtf(wave_sum(s) * (1.0f / D) + EPS);
#pragma unroll
    for (int j = 0; j < 4; ++j) { const f32x4 gg = ((const f32x4*)g)[lane + 64 * j];
        const unsigned lo = pk2(v[j].x * rstd * gg.x, v[j].y * rstd * gg.y), hi = pk2(v[j].z * rstd * gg.z, v[j].w * rstd * gg.w);
        ((unsigned long long*)orow)[lane + 64 * j] = (unsigned long long)lo | ((unsigned long long)hi << 32); }
}
__device__ __forceinline__ void p0_prologue(const Args& a, const Ctx& c, LAS unsigned char* lds) {
    LAS float* scr = (LAS float*)(lds + c.wave * 16384);
    unsigned char* ws = a.ws;
    constexpr int I_IN = 16 * (NPROJ / 32), I_MKV = 16 * 32, I_BR = 8 * 32, I_OUT = 16 * 32, I_UP = 16 * (NUP / 32), I_DN = (DFF / 64) * 32;
    constexpr int NITEMS = I_IN + I_MKV + 3 * I_BR + I_OUT + I_UP + I_DN;
    for (int it = c.gw; it < NITEMS; it += c.ngw) {
        int r = it;
        if (r < I_IN) { tr_item(a.in[6], D, NPROJ, (bf16_t*)(ws + WS_WIN), nullptr, 0, scr, r, c.lane); continue; } r -= I_IN;
        if (r < I_MKV) { tr_item(a.in[13], D, 1024, (bf16_t*)(ws + WS_WMKV), nullptr, 0, scr, r, c.lane); continue; } r -= I_MKV;
        if (r < I_BR) { tr_item(a.in[14], 512, 1024, (bf16_t*)(ws + WS_WBR), nullptr, 0, scr, r, c.lane); continue; } r -= I_BR;
        if (r < I_BR) { tr_item(a.in[15], 512, 1024, (bf16_t*)(ws + WS_WBR + 1 * MiB), nullptr, 0, scr, r, c.lane); continue; } r -= I_BR;
        if (r < I_BR) { tr_item(a.in[16], 512, 1024, (bf16_t*)(ws + WS_WBR + 2 * MiB), nullptr, 0, scr, r, c.lane); continue; } r -= I_BR;
        if (r < I_OUT) { tr_item(a.in[17], D, 1024, (bf16_t*)(ws + WS_WOUT), nullptr, 0, scr, r, c.lane); continue; } r -= I_OUT;
        if (r < I_UP) { tr_item(a.in[19], D, NUP, (bf16_t*)(ws + WS_WUP), a.in[18], 1, scr, r, c.lane); continue; } r -= I_UP;
        tr_item(a.in[22], DFF, 1024, (bf16_t*)(ws + WS_WDN), nullptr, 0, scr, r, c.lane);
    }
    { bf16_t* o = (bf16_t*)(ws + WS_SGUW); const float* w = a.in[8];
      for (int i = c.gtid; i < 4 * 128 * 128 / 2; i += c.ngt) ((unsigned*)o)[i] = pk2(w[2 * i], w[2 * i + 1]); }
    for (int m = c.gw; m < T; m += c.ngw) rms_row_to_bf16(xrow(a, m), a.in[5], (bf16_t*)(ws + WS_H) + (size_t)m * D, c.lane);
    for (int m = c.gw; m < MEMROWS; m += c.ngw) rms_row_to_bf16(memrow(a, m), a.in[12], (bf16_t*)(ws + WS_MEMN) + (size_t)m * D, c.lane);
}

__device__ __forceinline__ void wt_mma(f32x4 (&acc)[4][4], const bf16_t* A, int lda, const bf16_t* B, int ldb, int K, int lane) {
    const bf16_t* a0 = A + (size_t)(lane & 15) * lda + 8 * (lane >> 4);
    const bf16_t* b0 = B + (size_t)(lane & 15) * ldb + 8 * (lane >> 4);
    for (int k = 0; k < K; k += 32) {
        bf16x8 af[4], bfr[4];
#pragma unroll
        for (int i = 0; i < 4; ++i) { af[i] = *(const bf16x8*)(a0 + (size_t)i * 16 * lda + k); bfr[i] = *(const bf16x8*)(b0 + (size_t)i * 16 * ldb + k); }
#pragma unroll
        for (int i = 0; i < 4; ++i)
#pragma unroll
            for (int j = 0; j < 4; ++j) acc[i][j] = __builtin_amdgcn_mfma_f32_16x16x32_bf16(af[i], bfr[j], acc[i][j], 0, 0, 0);
    }
}
__device__ __forceinline__ void zero_acc(f32x4 (&acc)[4][4]) {
#pragma unroll
    for (int i = 0; i < 4; ++i)
#pragma unroll
        for (int j = 0; j < 4; ++j) acc[i][j] = (f32x4){0.f, 0.f, 0.f, 0.f};
}
template <class Epi>
__device__ __forceinline__ void sgemm_phase(const bf16_t* A, int lda, const bf16_t* Bt, int ldb, int M, int N, int K, const Epi& epi, const Ctx& c) {
    const int nN = N / 64, ntask = (M / 64) * nN;
    for (int t = c.gw; t < ntask; t += c.ngw) {
        const int tm = t / nN, tn = t % nN;
        f32x4 acc[4][4]; zero_acc(acc);
        wt_mma(acc, A + (size_t)tm * 64 * lda, lda, Bt + (size_t)tn * 64 * ldb, ldb, K, c.lane);
#pragma unroll
        for (int i = 0; i < 4; ++i)
#pragma unroll
            for (int r = 0; r < 4; ++r) { const int row = tm * 64 + 16 * i + 4 * (c.lane >> 4) + r; const float rs = epi.rowpre(row);
#pragma unroll
                for (int j = 0; j < 4; ++j) epi(row, tn * 64 + 16 * j + (c.lane & 15), acc[i][j][r] * rs); }
    }
}

struct EpiProjN { bf16_t* P;
    __device__ __forceinline__ float rowpre(int) const { return 1.0f; }
    __device__ __forceinline__ void operator()(int r, int col, float v) const {
        float o;
        if (col < C_K) o = v * QSCALE; else if (col < C_U) o = v; else if (col < C_QM) o = gelu_tanh(v); else if (col < C_G) o = v * MSCALE; else o = sigmoid_f(v);
        P[(size_t)r * NPROJ + col] = (bf16_t)f2bf(o); } };
struct EpiBf16N { bf16_t* P; int ldc;
    __device__ __forceinline__ float rowpre(int) const { return 1.0f; }
    __device__ __forceinline__ void operator()(int r, int col, float v) const { P[(size_t)r * ldc + col] = (bf16_t)f2bf(v); } };
struct EpiOutN { const Args* a; bf16_t* H2;
    __device__ __forceinline__ float rowpre(int) const { return 1.0f; }
    __device__ __forceinline__ void operator()(int r, int col, float v) const { const float x1 = xrow(*a, r)[col] + v; a->out[(size_t)r * D + col] = x1; H2[(size_t)r * D + col] = (bf16_t)f2bf(x1); } };
struct EpiUpN { bf16_t* AUP; const float* ssq;
    __device__ __forceinline__ float rowpre(int r) const {
        float s = 0.f;
#pragma unroll
        for (int i = 0; i < 16; ++i) s += ssq[(size_t)r * 16 + i];
        return 1.0f / sqrtf(s * (1.0f / D) + EPS); }
    __device__ __forceinline__ void operator()(int r, int col, float v) const { AUP[(size_t)r * DFF + col] = (bf16_t)f2bf(v); } };
struct EpiDownN { float* out;
    __device__ __forceinline__ float rowpre(int) const { return 1.0f; }
    __device__ __forceinline__ void operator()(int r, int col, float v) const { out[(size_t)r * D + col] += v; } };

__device__ __forceinline__ float dot8(bf16x8 a, bf16x8 b) {
    float s = 0.f;
#pragma unroll
    for (int i = 0; i < 8; ++i) s += bf2f((bf16_t)a[i]) * bf2f((bf16_t)b[i]);
    return s;
}
__device__ __forceinline__ void naive_wattn(const Args& a, const Ctx& c) {
    bf16_t* proj = (bf16_t*)(a.ws + WS_PROJ);
    const float* relb = a.in[4]; const float* sink = a.in[7];
    for (int idx = c.gtid; idx < T * 8; idx += c.ngt) {
        const int h = idx & 7, row = idx >> 3, kvh = h >> 2;
        const int s0 = row < TP ? (row & ~(SEQP - 1)) : TP, S = row < TP ? SEQP : TP, pos = row - s0;
        bf16x8 q[8]; float o[64];
        bf16_t* qp = proj + (size_t)row * NPROJ + C_Q + h * 64;
#pragma unroll
        for (int d = 0; d < 8; ++d) q[d] = ((const bf16x8*)qp)[d];
#pragma unroll
        for (int d = 0; d < 64; ++d) o[d] = 0.f;
        float m = sink[h] * LOG2E, l = 1.0f;
        const int j0 = pos - 128 < 0 ? 0 : pos - 128, j1 = pos + 128 > S - 1 ? S - 1 : pos + 128;
        for (int j = j0; j <= j1; ++j) {
            const bf16x8* kp = (const bf16x8*)(proj + (size_t)(s0 + j) * NPROJ + C_K + kvh * 64);
            const bf16x8* vp = (const bf16x8*)(proj + (size_t)(s0 + j) * NPROJ + C_V + kvh * 64);
            float s = 0.f;
#pragma unroll
            for (int d = 0; d < 8; ++d) s += dot8(q[d], kp[d]);
            s += relb[t5_bucket(j - pos) * 8 + h] * LOG2E;
            if (s > m) { const float f = __builtin_amdgcn_exp2f(m - s); l *= f;
#pragma unroll
                for (int d = 0; d < 64; ++d) o[d] *= f;
                m = s; }
            const float p = __builtin_amdgcn_exp2f(s - m); l += p;
#pragma unroll
            for (int d = 0; d < 8; ++d) { const bf16x8 v = vp[d];
#pragma unroll
                for (int e = 0; e < 8; ++e) o[8 * d + e] += p * bf2f((bf16_t)v[e]); }
        }
        const float il = 1.0f / l;
#pragma unroll
        for (int d = 0; d < 64; ++d) qp[d] = (bf16_t)f2bf(o[d] * il);
    }
}
__device__ __forceinline__ void naive_mattn(const Args& a, const Ctx& c) {
    bf16_t* proj = (bf16_t*)(a.ws + WS_PROJ); const bf16_t* mkv = (const bf16_t*)(a.ws + WS_MKV);
    for (int idx = c.gtid; idx < T * 8; idx += c.ngt) {
        const int half = idx & 1, h = (idx >> 1) & 3, row = idx >> 3;
        const int b = row < TP ? row / SEQP : 8;
        bf16_t* qp = proj + (size_t)row * NPROJ + C_QM + h * 128;
        bf16x8 q[16]; float o[64];
#pragma unroll
        for (int d = 0; d < 16; ++d) q[d] = ((const bf16x8*)qp)[d];
#pragma unroll
        for (int d = 0; d < 64; ++d) o[d] = 0.f;
        float m = -3.0e38f, l = 0.f;
        for (int j = 0; j < 256; ++j) {
            const bf16x8* kp = (const bf16x8*)(mkv + (size_t)(b * 256 + j) * 1024 + h * 128);
            const bf16x8* vp = (const bf16x8*)(mkv + (size_t)(b * 256 + j) * 1024 + 512 + h * 128 + half * 64);
            float s = 0.f;
#pragma unroll
            for (int d = 0; d < 16; ++d) s += dot8(q[d], kp[d]);
            if (s > m) { const float f = __builtin_amdgcn_exp2f(m - s); l *= f;
#pragma unroll
                for (int d = 0; d < 64; ++d) o[d] *= f;
                m = s; }
            const float p = __builtin_amdgcn_exp2f(s - m); l += p;
#pragma unroll
            for (int d = 0; d < 8; ++d) { const bf16x8 v = vp[d];
#pragma unroll
                for (int e = 0; e < 8; ++e) o[8 * d + e] += p * bf2f((bf16_t)v[e]); }
        }
        const float il = 1.0f / l;
        asm volatile("" ::: "memory");
#pragma unroll
        for (int d = 0; d < 64; ++d) qp[half * 64 + d] = (bf16_t)f2bf(o[d] * il);
    }
}
__device__ __forceinline__ void naive_sgu_stats(const Args& a, const Ctx& c) {
    const bf16_t* proj = (const bf16_t*)(a.ws + WS_PROJ); float* stat = (float*)(a.ws + WS_STAT);
    for (int row = c.gw; row < T; row += c.ngw) {
        const bf16_t* vp = proj + (size_t)row * NPROJ + C_SV;
        float v[8]; float s = 0.f;
#pragma unroll
        for (int i = 0; i < 8; ++i) { v[i] = bf2f(vp[c.lane * 8 + i]); s += v[i]; }
        const float mu = wave_sum(s) * (1.0f / 512.0f); float q = 0.f;
#pragma unroll
        for (int i = 0; i < 8; ++i) { const float d = v[i] - mu; q += d * d; }
        const float rstd = 1.0f / sqrtf(wave_sum(q) * (1.0f / 512.0f) + EPS);
        if (c.lane == 0) { stat[2 * row] = mu; stat[2 * row + 1] = rstd; }
    }
}
__device__ __forceinline__ void naive_sgu(const Args& a, const Ctx& c) {
    bf16_t* proj = (bf16_t*)(a.ws + WS_PROJ); const float* stat = (const float*)(a.ws + WS_STAT);
    const float* w_s = a.in[8]; const float* b_s = a.in[9]; const float* lng = a.in[10]; const float* lnb = a.in[11];
    for (int idx = c.gtid; idx < T * 512; idx += c.ngt) {
        const int ch = idx & 511, row = idx >> 9, g = ch >> 7, i = row & 127, r0 = row & ~127;
        const float gg = lng[ch], bb = lnb[ch];
        float acc = 0.f;
        for (int j = 0; j < 128; ++j) {
            const float v = bf2f(proj[(size_t)(r0 + j) * NPROJ + C_SV + ch]);
            const float vn = (v - stat[2 * (r0 + j)]) * stat[2 * (r0 + j) + 1] * gg + bb;
            acc += w_s[(g * 128 + i) * 128 + j] * vn;
        }
        acc += b_s[g * 128 + i];
        bf16_t* up = proj + (size_t)row * NPROJ + C_U + ch;
        *up = (bf16_t)f2bf(bf2f(*up) * acc);
    }
}
__device__ __forceinline__ void naive_branch(const Args& a, const Ctx& c) {
    const bf16_t* proj = (const bf16_t*)(a.ws + WS_PROJ); bf16_t* merged = (bf16_t*)(a.ws + WS_H);
    const int nN = 1024 / 64, ntask = (T / 64) * nN;
    for (int t = c.gw; t < ntask; t += c.ngw) {
        const int tm = t / nN, tn = t % nN;
        f32x4 m[4][4]; zero_acc(m);
#pragma unroll 1
        for (int br = 0; br < 3; ++br) {
            const int acol = br == 0 ? C_Q : (br == 1 ? C_U : C_QM);
            f32x4 acc[4][4]; zero_acc(acc);
            wt_mma(acc, proj + (size_t)tm * 64 * NPROJ + acol, NPROJ, (const bf16_t*)(a.ws + WS_WBR + br * MiB) + (size_t)tn * 64 * 512, 512, 512, c.lane);
#pragma unroll
            for (int i = 0; i < 4; ++i)
#pragma unroll
                for (int j = 0; j < 4; ++j)
#pragma unroll
                    for (int r = 0; r < 4; ++r) { const int row = tm * 64 + 16 * i + 4 * (c.lane >> 4) + r, col = tn * 64 + 16 * j + (c.lane & 15);
                        m[i][j][r] += bf2f(proj[(size_t)row * NPROJ + C_G + br * 1024 + col]) * acc[i][j][r]; }
        }
#pragma unroll
        for (int i = 0; i < 4; ++i)
#pragma unroll
            for (int j = 0; j < 4; ++j)
#pragma unroll
                for (int r = 0; r < 4; ++r) { const int row = tm * 64 + 16 * i + 4 * (c.lane >> 4) + r, col = tn * 64 + 16 * j + (c.lane & 15);
                    merged[(size_t)row * D + col] = (bf16_t)f2bf(m[i][j][r]); }
    }
}
__device__ __forceinline__ void naive_ssq(const Args& a, const Ctx& c) {
    float* ssq = (float*)(a.ws + WS_SSQ1);
    for (int row = c.gw; row < T; row += c.ngw) {
        const f32x4* xr = (const f32x4*)(a.out + (size_t)row * D); float s = 0.f;
#pragma unroll
        for (int j = 0; j < 4; ++j) { const f32x4 v = xr[c.lane + 64 * j]; s += (v.x * v.x + v.y * v.y) + (v.z * v.z + v.w * v.w); }
        s = wave_sum(s);
        if (c.lane < 16) ssq[(size_t)row * 16 + c.lane] = c.lane == 0 ? s : 0.f;
    }
}
__device__ __forceinline__ void naive_conv(const Args& a, const Ctx& c, int half) {
    const bf16_t* aup = (const bf16_t*)(a.ws + WS_AUP); bf16_t* g = (bf16_t*)(a.ws + WS_G);
    const float* cw = a.in[20]; const float* cb = a.in[21];
    for (int idx = c.gtid; idx < T * 1408; idx += c.ngt) {
        const int row = idx / 1408, lc = idx % 1408, jj = lc >> 7, ii = lc & 127, ch = half * 1408 + lc;
        const int s0 = row < TP ? (row & ~(SEQP - 1)) : TP, S = row < TP ? SEQP : TP, pos = row - s0;
        const size_t o = (size_t)row * DFF + 256 * jj + ii;
        const float g1 = bf2f(aup[o]), u1 = bf2f(aup[o + 128]);
        const float g0 = pos > 0 ? bf2f(aup[o - DFF]) : 0.f, u0 = pos > 0 ? bf2f(aup[o - DFF + 128]) : 0.f;
        const float g2 = pos < S - 1 ? bf2f(aup[o + DFF]) : 0.f, u2 = pos < S - 1 ? bf2f(aup[o + DFF + 128]) : 0.f;
        const float ga = g0 * cw[ch] + g1 * cw[NUP + ch] + g2 * cw[2 * NUP + ch] + cb[ch];
        const float ua = u0 * cw[DFF + ch] + u1 * cw[NUP + DFF + ch] + u2 * cw[2 * NUP + DFF + ch] + cb[DFF + ch];
        g[(size_t)row * DFF + ch] = (bf16_t)f2bf(gelu_tanh(ga) * ua);
    }
}
__device__ __forceinline__ void final_norm(const Args& a, const Ctx& c) {
    const float* gf = a.in[23];
    for (int row = c.gw; row < T; row += c.ngw) {
        f32x4* xr = (f32x4*)(a.out + (size_t)row * D); f32x4 v[4]; float s = 0.f;
#pragma unroll
        for (int j = 0; j < 4; ++j) { v[j] = xr[c.lane + 64 * j]; s += (v[j].x * v[j].x + v[j].y * v[j].y) + (v[j].z * v[j].z + v[j].w * v[j].w); }
        const float rstd = 1.0f / sqrtf(wave_sum(s) * (1.0f / D) + EPS);
#pragma unroll
        for (int j = 0; j < 4; ++j) { const f32x4 gg = ((const f32x4*)gf)[c.lane + 64 * j]; xr[c.lane + 64 * j] = (f32x4){v[j].x * rstd * gg.x, v[j].y * rstd * gg.y, v[j].z * rstd * gg.z, v[j].w * rstd * gg.w}; }
    }
}

namespace pg8 {
constexpr int BM = 256, BK = 64, HALF = 128, HTB = HALF * BK * 2, STAGE_BYTES = 8 * HTB, NXCD = 8, WGM = 8;
__host__ __device__ __forceinline__ int lds_byte(int r, int c) { const int st = (r >> 4) * 2 + (c >> 5), rr = r & 15, cc = c & 31, ob = rr * 64 + cc * 2; return st * 1024 + (ob ^ (((ob >> 9) & 1) << 5)); }
__host__ __device__ __forceinline__ void stage_rc(int b, int& R, int& C) { const int st = b / 1024, sb = b % 1024, swz = sb ^ (((sb >> 9) & 1) << 5); R = (st >> 1) * 16 + swz / 64; C = (st & 1) * 32 + (swz % 64) / 2; }
__host__ __device__ __forceinline__ int perm32(int rho) { const int n = rho >> 4, i = rho & 15; return 8 * (i >> 2) + 4 * n + (i & 3); }

struct Unit { const char* A; const char* B; int pm, pn, aux; };

struct TileOrder {
    int nM, nN, nwg, G, c, rep;
    __device__ __forceinline__ void init(int nM_, int nN_, int G_, int c_, int rep_ = 1) { nM = nM_; nN = nN_; nwg = nM * nN; G = G_; c = c_; rep = rep_; }
    __device__ __forceinline__ bool tile(int i, int& pm, int& pn, int& aux) const {
        const int ti = i / rep; aux = i - ti * rep;
        const long L = (long)ti * G + c; if (L >= nwg) return false;
        int wgid = (int)L; { const int q = nwg / NXCD, r = nwg % NXCD, xcd = wgid % NXCD, off = wgid / NXCD; wgid = (xcd < r ? xcd * (q + 1) : r * (q + 1) + (xcd - r) * q) + off; }
        const int nig = WGM * nN, gid = wgid / nig, fm = gid * WGM, gsz = (nM - fm) < WGM ? (nM - fm) : WGM;
        pm = fm + ((wgid % nig) % gsz); pn = (wgid % nig) / gsz; return true;
    }
};
__device__ __forceinline__ unsigned cvt_pk_bf16(float lo, float hi) { unsigned r; asm volatile("v_cvt_pk_bf16_f32 %0, %1, %2" : "=v"(r) : "v"(lo), "v"(hi)); return r; }

template <class Epi, class Sched, bool ALIGN_EPI = true, bool SP2 = true>
__device__ __forceinline__ void gemm_phase(LAS unsigned char* lds, const int K, const int lda, const Sched& S, const Epi& E) {
    const int tid = threadIdx.x, wid = __builtin_amdgcn_readfirstlane(tid >> 6), lane = tid & 63, wr = wid >> 2, wc = wid & 3, fr = lane & 15, fq = lane >> 4;
    const int nt = K / BK;
    unsigned voffA[2], voffB[2];
#pragma unroll
    for (int i = 0; i < 2; ++i) { int R, C; stage_rc(tid * 16 + i * 8192, R, C); const int Rb = Epi::PERM ? ((R & ~31) + perm32(R & 31)) : R;
        voffA[i] = (unsigned)(R * lda + C) * 2u; voffB[i] = (unsigned)(Rb * K + C) * 2u; }
    const size_t kstep = (size_t)(BK * 2);
    const size_t hstepA = (size_t)HALF * lda * 2, hstepB = (size_t)HALF * K * 2;
    const unsigned ldsw = (unsigned)wid * 1024u;
    const int aoff = lds_byte(wr * 64 + fr, fq * 8), boff = lds_byte(wc * 32 + fr, fq * 8);
#define PG8_SA(b, h) (((b) * 2 + (h)) * HTB)
#define PG8_SB(b, h) ((4 + (b) * 2 + (h)) * HTB)
#define PG8_STAGE(bufoff, gbase, voff) do { _Pragma("unroll") for (int _i = 0; _i < 2; ++_i) \
        __builtin_amdgcn_global_load_lds((const unsigned*)((const char*)(gbase) + (voff)[_i]), (LAS unsigned*)(lds + (bufoff) + ldsw + _i * 8192), 16, 0, 0); } while (0)
#define PG8_LDA(dst, b, h) do { _Pragma("unroll") for (int m = 0; m < 4; ++m) _Pragma("unroll") for (int k = 0; k < 2; ++k) dst[m][k] = *(const LAS bf16x8*)(lds + PG8_SA(b, h) + aoff + m * 2048 + k * 1024); } while (0)
#define PG8_LDB(dst, b, h) do { _Pragma("unroll") for (int n = 0; n < 2; ++n) _Pragma("unroll") for (int k = 0; k < 2; ++k) dst[n][k] = *(const LAS bf16x8*)(lds + PG8_SB(b, h) + boff + n * 2048 + k * 1024); } while (0)
#define PG8_MMA(ai, bj, At, Bt) do { __builtin_amdgcn_s_setprio(1); _Pragma("unroll") for (int m = 0; m < 4; ++m) _Pragma("unroll") for (int n = 0; n < 2; ++n) _Pragma("unroll") for (int k = 0; k < 2; ++k) \
        acc[ai][bj][m][n] = __builtin_amdgcn_mfma_f32_16x16x32_bf16(Bt[n][k], At[m][k], acc[ai][bj][m][n], 0, 0, 0); __builtin_amdgcn_s_setprio(0); } while (0)
#define PG8_WAIT_V(n) asm volatile("s_waitcnt vmcnt(" #n ")" ::: "memory")
#define PG8_WAIT_L(n) asm volatile("s_waitcnt lgkmcnt(" #n ")" ::: "memory")
#define PG8_BAR __builtin_amdgcn_s_barrier()
#define PG8_SCHED __builtin_amdgcn_sched_barrier(0)
    Unit cur, nxt; int ui = 0;
    if (!S.next(0, cur)) return;
    f32x4 acc[2][2][4][2];
#pragma unroll
    for (int a = 0; a < 2; ++a)
#pragma unroll
        for (int b = 0; b < 2; ++b)
#pragma unroll
            for (int m = 0; m < 4; ++m)
#pragma unroll
                for (int n = 0; n < 2; ++n) acc[a][b][m][n] = (f32x4){0.f, 0.f, 0.f, 0.f};
    bf16x8 At[4][2], B0[2][2], B1[2][2];
    const char* cA = cur.A; const char* cB = cur.B;
    if constexpr (SP2) {
        PG8_STAGE(PG8_SB(0, 0), cB, voffB); PG8_STAGE(PG8_SB(0, 1), cB + hstepB, voffB); PG8_STAGE(PG8_SA(0, 0), cA, voffA); PG8_STAGE(PG8_SA(0, 1), cA + hstepA, voffA);
        if (wr == 1) PG8_BAR;
        PG8_WAIT_V(2); PG8_BAR;
        PG8_STAGE(PG8_SB(1, 0), cB + kstep, voffB); PG8_STAGE(PG8_SA(1, 0), cA + kstep, voffA); PG8_STAGE(PG8_SB(1, 1), cB + hstepB + kstep, voffB);
        PG8_WAIT_V(6); PG8_BAR;
    } else {
        PG8_STAGE(PG8_SB(0, 0), cB, voffB); PG8_STAGE(PG8_SA(0, 0), cA, voffA); PG8_STAGE(PG8_SB(0, 1), cB + hstepB, voffB); PG8_STAGE(PG8_SA(0, 1), cA + hstepA, voffA);
        if (wr == 1) PG8_BAR;
        PG8_WAIT_V(4); PG8_BAR;
        PG8_STAGE(PG8_SB(1, 0), cB + kstep, voffB); PG8_STAGE(PG8_SA(1, 0), cA + kstep, voffA); PG8_STAGE(PG8_SB(1, 1), cB + hstepB + kstep, voffB);
        PG8_WAIT_V(6); PG8_BAR;
    }
    for (;;) {
        const bool has_next = S.next(ui + 1, nxt);
        const char* nA = has_next ? nxt.A : cA; const char* nB = has_next ? nxt.B : cB;
        for (int t = 0; t < nt; t += 2) {
            const bool last = (t == nt - 2);
            const char* a1 = cA + (size_t)(t + 1) * kstep;
            const char* a2 = last ? nA : cA + (size_t)(t + 2) * kstep; const char* b2 = last ? nB : cB + (size_t)(t + 2) * kstep;
            const char* a3 = a2 + kstep; const char* b3 = b2 + kstep;
            if constexpr (SP2) {
            PG8_LDB(B0, 0, 0); PG8_LDB(B1, 0, 1); PG8_SCHED; PG8_LDA(At, 0, 0); PG8_STAGE(PG8_SA(1, 1), a1 + hstepA, voffA);
            PG8_WAIT_V(8); PG8_WAIT_L(0); PG8_BAR; PG8_MMA(0, 0, At, B0); PG8_MMA(0, 1, At, B1); PG8_BAR; PG8_SCHED;
            PG8_LDA(At, 0, 1); PG8_STAGE(PG8_SB(0, 0), b2, voffB); PG8_STAGE(PG8_SB(0, 1), b2 + hstepB, voffB); PG8_STAGE(PG8_SA(0, 0), a2, voffA);
            PG8_WAIT_V(8); PG8_WAIT_L(0); PG8_BAR; PG8_MMA(1, 0, At, B0); PG8_MMA(1, 1, At, B1); PG8_BAR; PG8_SCHED;
            PG8_LDB(B0, 1, 0); PG8_LDB(B1, 1, 1); PG8_SCHED; PG8_LDA(At, 1, 0); PG8_STAGE(PG8_SA(0, 1), a2 + hstepA, voffA);
            PG8_WAIT_V(8); PG8_WAIT_L(0); PG8_BAR; PG8_MMA(0, 0, At, B0); PG8_MMA(0, 1, At, B1); PG8_BAR; PG8_SCHED;
            PG8_LDA(At, 1, 1); PG8_STAGE(PG8_SB(1, 0), b3, voffB); PG8_STAGE(PG8_SB(1, 1), b3 + hstepB, voffB); PG8_STAGE(PG8_SA(1, 0), a3, voffA);
            PG8_WAIT_V(8); PG8_WAIT_L(0); PG8_BAR; PG8_MMA(1, 0, At, B0); PG8_MMA(1, 1, At, B1); PG8_BAR; PG8_SCHED;
            } else {
            PG8_LDB(B0, 0, 0); PG8_SCHED; PG8_LDA(At, 0, 0); PG8_STAGE(PG8_SA(1, 1), a1 + hstepA, voffA);
            PG8_WAIT_L(8); PG8_BAR; PG8_WAIT_L(0); PG8_MMA(0, 0, At, B0); PG8_BAR; PG8_SCHED;
            PG8_LDB(B1, 0, 1); PG8_STAGE(PG8_SB(0, 0), b2, voffB);
            PG8_BAR; PG8_WAIT_L(0); PG8_MMA(0, 1, At, B1); PG8_BAR;
            PG8_LDA(At, 0, 1); PG8_STAGE(PG8_SA(0, 0), a2, voffA);
            PG8_BAR; PG8_WAIT_L(0); PG8_MMA(1, 0, At, B0); PG8_BAR; PG8_SCHED;
            PG8_STAGE(PG8_SB(0, 1), b2 + hstepB, voffB);
            PG8_WAIT_V(6); PG8_BAR; PG8_MMA(1, 1, At, B1); PG8_BAR;
            PG8_LDB(B0, 1, 0); PG8_SCHED; PG8_LDA(At, 1, 0); PG8_STAGE(PG8_SA(0, 1), a2 + hstepA, voffA);
            PG8_WAIT_L(8); PG8_BAR; PG8_WAIT_L(0); PG8_MMA(0, 0, At, B0); PG8_BAR; PG8_SCHED;
            PG8_LDB(B1, 1, 1); PG8_STAGE(PG8_SB(1, 0), b3, voffB);
            PG8_BAR; PG8_WAIT_L(0); PG8_MMA(0, 1, At, B1); PG8_BAR;
            PG8_LDA(At, 1, 1); PG8_STAGE(PG8_SA(1, 0), a3, voffA);
            PG8_BAR; PG8_WAIT_L(0); PG8_MMA(1, 0, At, B0); PG8_BAR; PG8_SCHED;
            PG8_STAGE(PG8_SB(1, 1), b3 + hstepB, voffB);
            PG8_WAIT_V(6); PG8_BAR; PG8_MMA(1, 1, At, B1); PG8_BAR;
            }
        }
        if constexpr (ALIGN_EPI) { if (wr == 0) PG8_BAR; }
        E(acc, cur, wr, wc, fr, fq);
        if (!has_next) break;
#pragma unroll
        for (int a = 0; a < 2; ++a)
#pragma unroll
            for (int b = 0; b < 2; ++b)
#pragma unroll
                for (int m = 0; m < 4; ++m)
#pragma unroll
                    for (int n = 0; n < 2; ++n) acc[a][b][m][n] = (f32x4){0.f, 0.f, 0.f, 0.f};
        cur = nxt; cA = nA; cB = nB; ++ui;
        if constexpr (ALIGN_EPI) { if (wr == 1) PG8_BAR; }
    }
    PG8_WAIT_V(0);
    if constexpr (!ALIGN_EPI) { if (wr == 0) PG8_BAR; }
    PG8_BAR;
#undef PG8_SA
#undef PG8_SB
#undef PG8_STAGE
#undef PG8_LDA
#undef PG8_LDB
#undef PG8_MMA
#undef PG8_WAIT_V
#undef PG8_WAIT_L
#undef PG8_BAR
#undef PG8_SCHED
}

struct SchedPlain {
    TileOrder o; const char* A; const char* B; size_t strideA, strideB;
    __device__ __forceinline__ bool next(int i, Unit& u) const { int aux; if (!o.tile(i, u.pm, u.pn, aux)) return false; u.aux = aux; u.A = A + (size_t)u.pm * strideA; u.B = B + (size_t)u.pn * strideB; return true; }
};
struct SchedOne {
    int idx, nN; const char* A; const char* B; size_t strideA, strideB;
    __device__ __forceinline__ bool next(int i, Unit& u) const { if (i > 0 || idx < 0) return false; u.pm = idx / nN; u.pn = idx % nN; u.aux = 0; u.A = A + (size_t)u.pm * strideA; u.B = B + (size_t)u.pn * strideB; return true; }
};

__device__ __forceinline__ f32x4 act4(f32x4 v, int mode) {
    if (mode == 1) return v * QSCALE;
    if (mode == 3) return v * MSCALE;
    if (mode == 2) return (f32x4){gelu_tanh(v[0]), gelu_tanh(v[1]), gelu_tanh(v[2]), gelu_tanh(v[3])};
    if (mode == 4) return (f32x4){sigmoid_f(v[0]), sigmoid_f(v[1]), sigmoid_f(v[2]), sigmoid_f(v[3])};
    return v;
}
struct EpiProj {
    static constexpr bool PERM = true;
    bf16_t* P;
    __device__ __forceinline__ void operator()(const f32x4 (&acc)[2][2][4][2], const Unit& u, int wr, int wc, int fr, int fq) const {
        const int pn = u.pn, mode = pn < 2 ? 1 : (pn == 2 ? 0 : (pn < 7 ? 2 : (pn < 9 ? 3 : 4)));
        const int row0 = u.pm * BM + wr * 64 + fr, col0 = pn * BM + wc * 32 + 8 * fq;
#pragma unroll
        for (int ai = 0; ai < 2; ++ai)
#pragma unroll
            for (int m = 0; m < 4; ++m) { bf16_t* rowp = P + (size_t)(row0 + ai * HALF + m * 16) * NPROJ + col0;
#pragma unroll
                for (int bj = 0; bj < 2; ++bj) { const f32x4 v0 = act4(acc[ai][bj][m][0], mode), v1 = act4(acc[ai][bj][m][1], mode);
                    u32x4 w; w.x = cvt_pk_bf16(v0[0], v0[1]); w.y = cvt_pk_bf16(v0[2], v0[3]); w.z = cvt_pk_bf16(v1[0], v1[1]); w.w = cvt_pk_bf16(v1[2], v1[3]);
                    *(u32x4*)(rowp + bj * HALF) = w; } }
    }
};
struct EpiPlain {
    static constexpr bool PERM = true;
    bf16_t* P; int ldc;
    __device__ __forceinline__ void operator()(const f32x4 (&acc)[2][2][4][2], const Unit& u, int wr, int wc, int fr, int fq) const {
        const int row0 = u.pm * BM + wr * 64 + fr, col0 = u.pn * BM + wc * 32 + 8 * fq;
#pragma unroll
        for (int ai = 0; ai < 2; ++ai)
#pragma unroll
            for (int m = 0; m < 4; ++m) { bf16_t* rowp = P + (size_t)(row0 + ai * HALF + m * 16) * ldc + col0;
#pragma unroll
                for (int bj = 0; bj < 2; ++bj) { const f32x4 v0 = acc[ai][bj][m][0], v1 = acc[ai][bj][m][1];
                    u32x4 w; w.x = cvt_pk_bf16(v0[0], v0[1]); w.y = cvt_pk_bf16(v0[2], v0[3]); w.z = cvt_pk_bf16(v1[0], v1[1]); w.w = cvt_pk_bf16(v1[2], v1[3]);
                    *(u32x4*)(rowp + bj * HALF) = w; } }
    }
};
__device__ __forceinline__ f32x4 unpk4(unsigned a, unsigned b) { return (f32x4){__uint_as_float(a << 16), __uint_as_float(a & 0xffff0000u), __uint_as_float(b << 16), __uint_as_float(b & 0xffff0000u)}; }
struct SchedBranch {
    TileOrder o; const char* proj; const char* wbr;
    __device__ __forceinline__ bool next(int i, Unit& u) const { int aux; if (!o.tile(i, u.pm, u.pn, aux)) return false; u.aux = aux;
        const int acol = aux == 0 ? C_Q : (aux == 1 ? C_U : C_QM);
        u.A = proj + ((size_t)u.pm * 256 * NPROJ + acol) * 2; u.B = wbr + (size_t)aux * MiB + (size_t)u.pn * 256 * 512 * 2; return true; }
};
struct EpiBranch {
    static constexpr bool PERM = true;
    const bf16_t* proj; bf16_t* merged;
    __device__ __forceinline__ void operator()(const f32x4 (&acc)[2][2][4][2], const Unit& u, int wr, int wc, int fr, int fq) const {
        const int br = u.aux, row0 = u.pm * BM + wr * 64 + fr, col0 = u.pn * BM + wc * 32 + 8 * fq;
#pragma unroll
        for (int ai = 0; ai < 2; ++ai)
#pragma unroll
            for (int m = 0; m < 4; ++m) { const int row = row0 + ai * HALF + m * 16;
                const bf16_t* gp = proj + (size_t)row * NPROJ + C_G + br * 1024 + col0; bf16_t* mp = merged + (size_t)row * D + col0;
#pragma unroll
                for (int bj = 0; bj < 2; ++bj) { const u32x4 gw = *(const u32x4*)(gp + bj * HALF);
                    f32x4 v0 = acc[ai][bj][m][0] * unpk4(gw.x, gw.y), v1 = acc[ai][bj][m][1] * unpk4(gw.z, gw.w);
                    if (br > 0) { const u32x4 mw = *(const u32x4*)(mp + bj * HALF); v0 += unpk4(mw.x, mw.y); v1 += unpk4(mw.z, mw.w); }
                    u32x4 w; w.x = cvt_pk_bf16(v0[0], v0[1]); w.y = cvt_pk_bf16(v0[2], v0[3]); w.z = cvt_pk_bf16(v1[0], v1[1]); w.w = cvt_pk_bf16(v1[2], v1[3]);
                    *(u32x4*)(mp + bj * HALF) = w; } }
    }
};
struct EpiOut {
    static constexpr bool PERM = false;
    const float* xp; const float* xs; float* out; bf16_t* H2; float* ssq;
    __device__ __forceinline__ void operator()(const f32x4 (&acc)[2][2][4][2], const Unit& u, int wr, int wc, int fr, int fq) const {
        const int col0 = u.pn * BM + wc * 32 + 4 * fq;
#pragma unroll
        for (int ai = 0; ai < 2; ++ai)
#pragma unroll
            for (int m = 0; m < 4; ++m) { const int row = u.pm * BM + ai * HALF + wr * 64 + m * 16 + fr;
                const float* xr = (row < TP ? xp + (size_t)row * D : xs + (size_t)(row - TP) * D) + col0; const size_t ob = (size_t)row * D + col0; float s = 0.f;
#pragma unroll
                for (int bj = 0; bj < 2; ++bj)
#pragma unroll
                    for (int n = 0; n < 2; ++n) { const int off = bj * HALF + n * 16; const f32x4 x1 = *(const f32x4*)(xr + off) + acc[ai][bj][m][n];
                        *(f32x4*)(out + ob + off) = x1; s += (x1[0] * x1[0] + x1[1] * x1[1]) + (x1[2] * x1[2] + x1[3] * x1[3]);
                        const unsigned lo = cvt_pk_bf16(x1[0], x1[1]), hi = cvt_pk_bf16(x1[2], x1[3]);
                        *(unsigned long long*)(H2 + ob + off) = (unsigned long long)lo | ((unsigned long long)hi << 32); }
                s += __shfl_xor(s, 16); s += __shfl_xor(s, 32);
                if (fq == 0) ssq[(size_t)row * 16 + u.pn * 4 + wc] = s; }
    }
};
struct EpiDown {
    static constexpr bool PERM = false;
    float* out;
    __device__ __forceinline__ void operator()(const f32x4 (&acc)[2][2][4][2], const Unit& u, int wr, int wc, int fr, int fq) const {
        const int col0 = u.pn * BM + wc * 32 + 4 * fq;
#pragma unroll
        for (int ai = 0; ai < 2; ++ai)
#pragma unroll
            for (int m = 0; m < 4; ++m) { const int row = u.pm * BM + ai * HALF + wr * 64 + m * 16 + fr; float* op = out + (size_t)row * D + col0;
#pragma unroll
                for (int bj = 0; bj < 2; ++bj)
#pragma unroll
                    for (int n = 0; n < 2; ++n) { f32x4* o = (f32x4*)(op + bj * HALF + n * 16); *o = *o + acc[ai][bj][m][n]; } }
    }
};
struct EpiUpHalf {
    static constexpr bool PERM = true;
    bf16_t* P; const float* ssq;
    __device__ __forceinline__ void operator()(const f32x4 (&acc)[2][2][4][2], const Unit& u, int wr, int wc, int fr, int fq) const {
        const int row0 = u.pm * BM + wr * 64 + fr, col0 = u.pn * BM + wc * 32 + 8 * fq;
#pragma unroll
        for (int ai = 0; ai < 2; ++ai)
#pragma unroll
            for (int m = 0; m < 4; ++m) { const int row = row0 + ai * HALF + m * 16; bf16_t* rowp = P + (size_t)row * DFF + col0;
                const f32x4* sp = (const f32x4*)(ssq + (size_t)row * 16); const f32x4 s4 = (sp[0] + sp[1]) + (sp[2] + sp[3]);
                const float rstd = 1.0f / sqrtf(((s4[0] + s4[1]) + (s4[2] + s4[3])) * (1.0f / D) + EPS);
#pragma unroll
                for (int bj = 0; bj < 2; ++bj) { const f32x4 v0 = acc[ai][bj][m][0] * rstd, v1 = acc[ai][bj][m][1] * rstd;
                    u32x4 w; w.x = cvt_pk_bf16(v0[0], v0[1]); w.y = cvt_pk_bf16(v0[2], v0[3]); w.z = cvt_pk_bf16(v1[0], v1[1]); w.w = cvt_pk_bf16(v1[2], v1[3]);
                    *(u32x4*)(rowp + bj * HALF) = w; } }
    }
};
}

__device__ __forceinline__ bf16x8 pack8(f32x4 a, f32x4 b) {
    u32x4 w; w.x = pg8::cvt_pk_bf16(a[0], a[1]); w.y = pg8::cvt_pk_bf16(a[2], a[3]); w.z = pg8::cvt_pk_bf16(b[0], b[1]); w.w = pg8::cvt_pk_bf16(b[2], b[3]);
    return __builtin_bit_cast(bf16x8, w);
}
__device__ __forceinline__ float bflo(unsigned w) { return __uint_as_float(w << 16); }
__device__ __forceinline__ float bfhi(unsigned w) { return __uint_as_float(w & 0xffff0000u); }

constexpr int WA_K = 0, WA_KP = 144, WA_VT = 384 * 144, WA_VP = 784, WA_BIAS = WA_VT + 64 * 784;
__device__ __forceinline__ void wattn_unit(const Args& a, LAS unsigned char* lds, int blk, int kvh, int tid, int wave, int lane) {
    bf16_t* proj = (bf16_t*)(a.ws + WS_PROJ);
    const int R0 = blk * 128, s0 = R0 < TP ? (R0 & ~(SEQP - 1)) : TP, S = R0 < TP ? SEQP : TP, n = (R0 - s0) >> 7, nb = S >> 7;
    const bool has_l = n > 0, has_r = n < nb - 1;
#pragma unroll
    for (int i = 0; i < 6; ++i) { const int qd = tid + 512 * i, w = qd >> 3, ch = qd & 7; const bool ok = (w >= 128 || has_l) && (w < 256 || has_r);
        u32x4 v = (u32x4){0u, 0u, 0u, 0u};
        if (ok) v = *(const u32x4*)(proj + (size_t)(R0 - 128 + w) * NPROJ + C_K + kvh * 64 + ch * 8);
        *(LAS u32x4*)(lds + WA_K + w * WA_KP + ch * 16) = v; }
#pragma unroll
    for (int i = 0; i < 3; ++i) { const int p = tid + 512 * i, w = (p >> 3) * 2, ch = p & 7; const bool ok = (w >= 128 || has_l) && (w < 256 || has_r);
        u32x4 v0 = (u32x4){0u, 0u, 0u, 0u}, v1 = v0;
        if (ok) { const bf16_t* vp = proj + (size_t)(R0 - 128 + w) * NPROJ + C_V + kvh * 64 + ch * 8; v0 = *(const u32x4*)vp; v1 = *(const u32x4*)(vp + NPROJ); }
#pragma unroll
        for (int e = 0; e < 4; ++e) { const unsigned x0 = v0[e], x1 = v1[e]; const int d = ch * 8 + 2 * e;
            *(LAS unsigned*)(lds + WA_VT + d * WA_VP + w * 2) = (x0 & 0xffffu) | (x1 << 16);
            *(LAS unsigned*)(lds + WA_VT + (d + 1) * WA_VP + w * 2) = (x0 >> 16) | (x1 & 0xffff0000u); } }
    for (int i = tid; i < 4 * 257; i += 512) { const int hh = i / 257, r = i - hh * 257; ((LAS float*)(lds + WA_BIAS))[hh * 260 + r] = a.in[4][t5_bucket(r - 128) * 8 + 4 * kvh + hh] * LOG2E; }
    __syncthreads();
    const int q = lane & 15, g = lane >> 4, hh = wave & 3, h = 4 * kvh + hh;
    const float sink2 = a.in[7][h] * LOG2E;
    const LAS float* btab = (const LAS float*)(lds + WA_BIAS) + hh * 260;
    const LAS unsigned char* kbase = lds + WA_K + (8 * (q >> 2) + (q & 3)) * WA_KP + g * 16;
    const LAS unsigned char* vbase = lds + WA_VT + q * WA_VP + g * 16;
#pragma unroll 1
    for (int j = 0; j < 4; ++j) {
        const int i0 = 16 * ((wave >> 2) + 2 * j);
        bf16_t* qp = proj + (size_t)(R0 + i0 + q) * NPROJ + C_Q + h * 64 + 8 * g;
        const bf16x8 qf0 = *(const bf16x8*)qp, qf1 = *(const bf16x8*)(qp + 32);
        f32x4 sc[24];
#pragma unroll
        for (int t = 0; t < 24; ++t) {
            const bf16x8 k0 = *(const LAS bf16x8*)(kbase + (t >> 1) * 32 * WA_KP + (t & 1) * 4 * WA_KP), k1 = *(const LAS bf16x8*)(kbase + (t >> 1) * 32 * WA_KP + (t & 1) * 4 * WA_KP + 64);
            f32x4 z = (f32x4){0.f, 0.f, 0.f, 0.f};
            z = __builtin_amdgcn_mfma_f32_16x16x32_bf16(k0, qf0, z, 0, 0, 0); sc[t] = __builtin_amdgcn_mfma_f32_16x16x32_bf16(k1, qf1, z, 0, 0, 0); }
        const int iq = i0 + q; float mx = -1.0e30f;
        const int relb = 8 * g - 128 - iq;
#pragma unroll
        for (int t = 0; t < 24; ++t)
#pragma unroll
            for (int r = 0; r < 4; ++r) { const int wofs = 32 * (t >> 1) + 4 * (t & 1) + r, rel = relb + wofs, w = 8 * g + wofs;
                const bool ok = rel >= -128 && rel <= 128 && (w >= 128 || has_l) && (w < 256 || has_r);
                const int bi = min(max(rel + 128, 0), 256);
                const float v = ok ? sc[t][r] + btab[bi] : -1.0e30f; sc[t][r] = v; mx = fmaxf(mx, v); }
        mx = fmaxf(mx, __shfl_xor(mx, 16)); mx = fmaxf(mx, __shfl_xor(mx, 32)); mx = fmaxf(mx, sink2);
        float sum = 0.f;
#pragma unroll
        for (int t = 0; t < 24; ++t)
#pragma unroll
            for (int r = 0; r < 4; ++r) { const float p = __builtin_amdgcn_exp2f(sc[t][r] - mx); sc[t][r] = p; sum += p; }
        sum += __shfl_xor(sum, 16); sum += __shfl_xor(sum, 32);
        const float inv = 1.0f / (sum + __builtin_amdgcn_exp2f(sink2 - mx));
        f32x4 o[4];
#pragma unroll
        for (int dt = 0; dt < 4; ++dt) o[dt] = (f32x4){0.f, 0.f, 0.f, 0.f};
#pragma unroll
        for (int c = 0; c < 12; ++c) { const bf16x8 pf = pack8(sc[2 * c], sc[2 * c + 1]);
#pragma unroll
            for (int dt = 0; dt < 4; ++dt) { const bf16x8 vf = *(const LAS bf16x8*)(vbase + dt * 16 * WA_VP + c * 64);
                o[dt] = __builtin_amdgcn_mfma_f32_16x16x32_bf16(pf, vf, o[dt], 0, 0, 0); } }
#pragma unroll
        for (int r = 0; r < 4; ++r) { const float ir = __shfl(inv, 4 * g + r); bf16_t* op = proj + (size_t)(R0 + i0 + 4 * g + r) * NPROJ + C_Q + h * 64 + q;
#pragma unroll
            for (int dt = 0; dt < 4; ++dt) op[16 * dt] = (bf16_t)f2bf(o[dt][r] * ir); }
    }
    __syncthreads();
}

constexpr int MA_K = 0, MA_KP = 272, MA_VT = 256 * 272, MA_VP = 528;
__device__ __forceinline__ void mattn_unit(const Args& a, LAS unsigned char* lds, int tile, int hm, int tid, int wave, int lane) {
    bf16_t* proj = (bf16_t*)(a.ws + WS_PROJ); const bf16_t* mkv = (const bf16_t*)(a.ws + WS_MKV);
    const int R0 = tile * 512, b = R0 < TP ? R0 / SEQP : 8;
    const bf16_t* kb = mkv + (size_t)b * 256 * 1024 + hm * 128; const bf16_t* vb = kb + 512;
#pragma unroll
    for (int i = 0; i < 8; ++i) { const int qd = tid + 512 * i, w = qd >> 4, ch = qd & 15;
        *(LAS u32x4*)(lds + MA_K + w * MA_KP + ch * 16) = *(const u32x4*)(kb + (size_t)w * 1024 + ch * 8); }
#pragma unroll
    for (int i = 0; i < 4; ++i) { const int p = tid + 512 * i, w = (p >> 4) * 2, ch = p & 15;
        const u32x4 v0 = *(const u32x4*)(vb + (size_t)w * 1024 + ch * 8), v1 = *(const u32x4*)(vb + (size_t)(w + 1) * 1024 + ch * 8);
#pragma unroll
        for (int e = 0; e < 4; ++e) { const unsigned x0 = v0[e], x1 = v1[e]; const int d = ch * 8 + 2 * e;
            *(LAS unsigned*)(lds + MA_VT + d * MA_VP + w * 2) = (x0 & 0xffffu) | (x1 << 16);
            *(LAS unsigned*)(lds + MA_VT + (d + 1) * MA_VP + w * 2) = (x0 >> 16) | (x1 & 0xffff0000u); } }
    __syncthreads();
    const int q = lane & 15, g = lane >> 4;
    const LAS unsigned char* kbase = lds + MA_K + (8 * (q >> 2) + (q & 3)) * MA_KP + g * 16;
    const LAS unsigned char* vbase = lds + MA_VT + q * MA_VP + g * 16;
#pragma unroll 1
    for (int j = 0; j < 4; ++j) {
        const int i0 = 16 * (wave + 8 * j);
        bf16_t* qp = proj + (size_t)(R0 + i0 + q) * NPROJ + C_QM + hm * 128 + 8 * g;
        bf16x8 qf[4];
#pragma unroll
        for (int ks = 0; ks < 4; ++ks) qf[ks] = *(const bf16x8*)(qp + 32 * ks);
        f32x4 sc[16];
#pragma unroll
        for (int t = 0; t < 16; ++t) {
            f32x4 z = (f32x4){0.f, 0.f, 0.f, 0.f};
#pragma unroll
            for (int ks = 0; ks < 4; ++ks) { const bf16x8 kf = *(const LAS bf16x8*)(kbase + (t >> 1) * 32 * MA_KP + (t & 1) * 4 * MA_KP + ks * 64); z = __builtin_amdgcn_mfma_f32_16x16x32_bf16(kf, qf[ks], z, 0, 0, 0); }
            sc[t] = z; }
        float mx = -1.0e30f;
#pragma unroll
        for (int t = 0; t < 16; ++t)
#pragma unroll
            for (int r = 0; r < 4; ++r) mx = fmaxf(mx, sc[t][r]);
        mx = fmaxf(mx, __shfl_xor(mx, 16)); mx = fmaxf(mx, __shfl_xor(mx, 32));
        float sum = 0.f;
#pragma unroll
        for (int t = 0; t < 16; ++t)
#pragma unroll
            for (int r = 0; r < 4; ++r) { const float p = __builtin_amdgcn_exp2f(sc[t][r] - mx); sc[t][r] = p; sum += p; }
        sum += __shfl_xor(sum, 16); sum += __shfl_xor(sum, 32);
        const float inv = 1.0f / sum;
        f32x4 o[8];
#pragma unroll
        for (int dt = 0; dt < 8; ++dt) o[dt] = (f32x4){0.f, 0.f, 0.f, 0.f};
#pragma unroll
        for (int c = 0; c < 8; ++c) { const bf16x8 pf = pack8(sc[2 * c], sc[2 * c + 1]);
#pragma unroll
            for (int dt = 0; dt < 8; ++dt) { const bf16x8 vf = *(const LAS bf16x8*)(vbase + dt * 16 * MA_VP + c * 64);
                o[dt] = __builtin_amdgcn_mfma_f32_16x16x32_bf16(pf, vf, o[dt], 0, 0, 0); } }
#pragma unroll
        for (int r = 0; r < 4; ++r) { const float ir = __shfl(inv, 4 * g + r); bf16_t* op = proj + (size_t)(R0 + i0 + 4 * g + r) * NPROJ + C_QM + hm * 128 + q;
#pragma unroll
            for (int dt = 0; dt < 8; ++dt) op[16 * dt] = (bf16_t)f2bf(o[dt][r] * ir); }
    }
    __syncthreads();
}

constexpr int SG_P = 272;
__device__ __forceinline__ void sgu_unit(const Args& a, LAS unsigned char* lds, int chunk, int tid, int wave, int lane) {
    bf16_t* proj = (bf16_t*)(a.ws + WS_PROJ); const bf16_t* wsb = (const bf16_t*)(a.ws + WS_SGUW);
    const int R0 = chunk * 128;
    {
        const int tp = tid >> 3, part = tid & 7, t0 = 2 * tp;
        const bf16_t* v0p = proj + (size_t)(R0 + t0) * NPROJ + C_SV + part * 64; const bf16_t* v1p = v0p + NPROJ;
        u32x4 x0[8], x1[8]; float s0 = 0.f, s1 = 0.f;
#pragma unroll
        for (int i = 0; i < 8; ++i) { x0[i] = ((const u32x4*)v0p)[i]; x1[i] = ((const u32x4*)v1p)[i]; }
#pragma unroll
        for (int i = 0; i < 8; ++i)
#pragma unroll
            for (int e = 0; e < 4; ++e) { s0 += bflo(x0[i][e]) + bfhi(x0[i][e]); s1 += bflo(x1[i][e]) + bfhi(x1[i][e]); }
        s0 += __shfl_xor(s0, 1); s0 += __shfl_xor(s0, 2); s0 += __shfl_xor(s0, 4); s1 += __shfl_xor(s1, 1); s1 += __shfl_xor(s1, 2); s1 += __shfl_xor(s1, 4);
        const float mu0 = s0 * (1.0f / 512.0f), mu1 = s1 * (1.0f / 512.0f); float q0 = 0.f, q1 = 0.f;
#pragma unroll
        for (int i = 0; i < 8; ++i)
#pragma unroll
            for (int e = 0; e < 4; ++e) { float d;
                d = bflo(x0[i][e]) - mu0; q0 += d * d; d = bfhi(x0[i][e]) - mu0; q0 += d * d; d = bflo(x1[i][e]) - mu1; q1 += d * d; d = bfhi(x1[i][e]) - mu1; q1 += d * d; }
        q0 += __shfl_xor(q0, 1); q0 += __shfl_xor(q0, 2); q0 += __shfl_xor(q0, 4); q1 += __shfl_xor(q1, 1); q1 += __shfl_xor(q1, 2); q1 += __shfl_xor(q1, 4);
        const float r0 = 1.0f / sqrtf(q0 * (1.0f / 512.0f) + EPS), r1 = 1.0f / sqrtf(q1 * (1.0f / 512.0f) + EPS);
        const float* lng = a.in[10] + part * 64; const float* lnb = a.in[11] + part * 64;
        LAS unsigned char* wb0 = lds + (part * 64) * SG_P + t0 * 2;
#pragma unroll
        for (int i = 0; i < 8; ++i)
#pragma unroll
            for (int e = 0; e < 4; ++e) {
                const int cl = 8 * i + 2 * e;
                const float ga = lng[cl], ba = lnb[cl], gb = lng[cl + 1], bb = lnb[cl + 1];
                const unsigned wa = pg8::cvt_pk_bf16((bflo(x0[i][e]) - mu0) * r0 * ga + ba, (bflo(x1[i][e]) - mu1) * r1 * ga + ba);
                const unsigned wb = pg8::cvt_pk_bf16((bfhi(x0[i][e]) - mu0) * r0 * gb + bb, (bfhi(x1[i][e]) - mu1) * r1 * gb + bb);
                *(LAS unsigned*)(wb0 + cl * SG_P) = wa;
                *(LAS unsigned*)(wb0 + (cl + 1) * SG_P) = wb; }
    }
    __syncthreads();
    {
        const int cl = lane & 15, g4 = lane >> 4, grp = wave >> 1, cbase = grp * 128 + (wave & 1) * 64;
        const LAS unsigned char* abase = lds + (cbase + cl) * SG_P + g4 * 16;
        const float* bs = a.in[9] + grp * 128;
#pragma unroll 1
        for (int th = 0; th < 2; ++th) {
            const bf16_t* wbase = wsb + (size_t)(grp * 128 + 64 * th + cl) * 128 + 8 * g4;
            f32x4 acc[4][4];
#pragma unroll
            for (int ct = 0; ct < 4; ++ct)
#pragma unroll
                for (int it = 0; it < 4; ++it) acc[ct][it] = (f32x4){0.f, 0.f, 0.f, 0.f};
#pragma unroll
            for (int kc = 0; kc < 4; ++kc) {
                bf16x8 af[4], wf[4];
#pragma unroll
                for (int ct = 0; ct < 4; ++ct) af[ct] = *(const LAS bf16x8*)(abase + ct * 16 * SG_P + kc * 64);
#pragma unroll
                for (int it = 0; it < 4; ++it) wf[it] = *(const bf16x8*)(wbase + it * 16 * 128 + kc * 32);
#pragma unroll
                for (int ct = 0; ct < 4; ++ct)
#pragma unroll
                    for (int it = 0; it < 4; ++it) acc[ct][it] = __builtin_amdgcn_mfma_f32_16x16x32_bf16(af[ct], wf[it], acc[ct][it], 0, 0, 0);
            }
#pragma unroll
            for (int it = 0; it < 4; ++it) { const int i = 64 * th + 16 * it + cl; const float bi = bs[i];
#pragma unroll
                for (int ct = 0; ct < 4; ++ct) { bf16_t* up = proj + (size_t)(R0 + i) * NPROJ + C_U + cbase + 16 * ct + 4 * g4;
                    const unsigned long long uw = *(const unsigned long long*)up; const unsigned ulo = (unsigned)uw, uhi = (unsigned)(uw >> 32);
                    const f32x4 sv = acc[ct][it];
                    const unsigned lo = pg8::cvt_pk_bf16(bflo(ulo) * (sv[0] + bi), bfhi(ulo) * (sv[1] + bi)), hi = pg8::cvt_pk_bf16(bflo(uhi) * (sv[2] + bi), bfhi(uhi) * (sv[3] + bi));
                    *(unsigned long long*)up = (unsigned long long)lo | ((unsigned long long)hi << 32); } }
        }
    }
    __syncthreads();
}
__device__ __forceinline__ void mix_phase(const Args& a, LAS unsigned char* lds, int tid, int wave, int lane) {
    const int G = gridDim.x, bx = blockIdx.x, vcu = (G % 8 == 0) ? (bx % 8) * (G / 8) + bx / 8 : bx;
    for (int u = vcu; u < 256; u += G) { wattn_unit(a, lds, u, 0, tid, wave, lane); wattn_unit(a, lds, u, 1, tid, wave, lane); }
    for (int u = vcu; u < 256; u += G) mattn_unit(a, lds, u >> 2, u & 3, tid, wave, lane);
    for (int u = vcu; u < 256; u += G) sgu_unit(a, lds, u, tid, wave, lane);
}

enum { PH_PRO = 0, PH_PROJ, PH_MIX, PH_MIX2, PH_SGU, PH_BR, PH_OUTP, PH_SSQ, PH_UP0, PH_CONV0, PH_UP1, PH_CONV1, PH_DOWN, PH_FINAL, PH_N };

__global__ void __launch_bounds__(NTHREADS, 2) fwd(Args a) {
    extern __shared__ __attribute__((aligned(16))) unsigned char lds_raw[];
    LAS unsigned char* lds = (LAS unsigned char*)lds_raw;
    cg::grid_group grid = cg::this_grid();
    Ctx c; c.tid = threadIdx.x; c.lane = c.tid & 63; c.wave = __builtin_amdgcn_readfirstlane(c.tid >> 6);
    c.gw = blockIdx.x * NWAVES + c.wave; c.ngw = gridDim.x * NWAVES; c.gtid = blockIdx.x * NTHREADS + c.tid; c.ngt = gridDim.x * NTHREADS;
    unsigned char* ws = a.ws;
    p0_prologue(a, c, lds);
    grid.sync();
    {
        pg8::SchedPlain S; S.o.init(T / 256, NPROJ / 256, (int)gridDim.x, (int)blockIdx.x); S.A = (const char*)(ws + WS_H); S.B = (const char*)(ws + WS_WIN); S.strideA = (size_t)256 * D * 2; S.strideB = (size_t)256 * D * 2;
        pg8::EpiProj E{(bf16_t*)(ws + WS_PROJ)};
        pg8::gemm_phase(lds, D, D, S, E);
        pg8::SchedOne S2; S2.idx = ((int)blockIdx.x >= 128 && (int)blockIdx.x < 128 + 36) ? (int)blockIdx.x - 128 : -1; S2.nN = 4;
        S2.A = (const char*)(ws + WS_MEMN); S2.B = (const char*)(ws + WS_WMKV); S2.strideA = (size_t)256 * D * 2; S2.strideB = (size_t)256 * D * 2;
        pg8::EpiPlain E2{(bf16_t*)(ws + WS_MKV), 1024};
        pg8::gemm_phase(lds, D, D, S2, E2);
    }
    grid.sync();
    mix_phase(a, lds, c.tid, c.wave, c.lane);
    grid.sync();
    {
        pg8::SchedBranch S; S.o.init(T / 256, 4, (int)gridDim.x, (int)blockIdx.x, 3); S.proj = (const char*)(ws + WS_PROJ); S.wbr = (const char*)(ws + WS_WBR);
        pg8::EpiBranch E{(const bf16_t*)(ws + WS_PROJ), (bf16_t*)(ws + WS_H)};
        pg8::gemm_phase(lds, 512, NPROJ, S, E);
    }
    grid.sync();
    {
        pg8::SchedPlain S; S.o.init(T / 256, 4, (int)gridDim.x, (int)blockIdx.x); S.A = (const char*)(ws + WS_H); S.B = (const char*)(ws + WS_WOUT); S.strideA = (size_t)256 * D * 2; S.strideB = (size_t)256 * D * 2;
        pg8::EpiOut E{a.in[0], a.in[1], a.out, (bf16_t*)(ws + WS_H2), (float*)(ws + WS_SSQ1)};
        pg8::gemm_phase(lds, D, D, S, E);
    }
    grid.sync();
#pragma unroll 1
    for (int half = 0; half < 2; ++half) {
        pg8::SchedPlain S; S.o.init(T / 256, 11, (int)gridDim.x, (int)blockIdx.x); S.A = (const char*)(ws + WS_H2); S.B = (const char*)(ws + WS_WUP) + (size_t)half * DFF * D * 2; S.strideA = (size_t)256 * D * 2; S.strideB = (size_t)256 * D * 2;
        pg8::EpiUpHalf E{(bf16_t*)(ws + WS_AUP), (const float*)(ws + WS_SSQ1)};
        pg8::gemm_phase(lds, D, D, S, E);
        grid.sync();
        naive_conv(a, c, half);
        grid.sync();
    }
    {
        pg8::SchedPlain S; S.o.init(T / 256, 4, (int)gridDim.x, (int)blockIdx.x); S.A = (const char*)(ws + WS_G); S.B = (const char*)(ws + WS_WDN); S.strideA = (size_t)256 * DFF * 2; S.strideB = (size_t)256 * DFF * 2;
        pg8::EpiDown E{a.out};
        pg8::gemm_phase(lds, DFF, DFF, S, E);
    }
    grid.sync();
    final_norm(a, c);
}

extern "C" void kernel_launch(void* const* d_in, const int* in_sizes, int n_in, void* d_out, int out_size, void* d_ws, size_t ws_size, hipStream_t stream) {
    static int grid = 0;
    if (grid == 0) {
        if (n_in != 24 || out_size != T * D || ws_size < WS_END) { fprintf(stderr, "kernel_launch: unexpected shapes (n_in %d, out %d, ws %zu)\n", n_in, out_size, ws_size); grid = -1; return; }
        int dev = 0, cus = 0, per_cu = 0;
        (void)hipGetDevice(&dev); (void)hipDeviceGetAttribute(&cus, hipDeviceAttributeMultiprocessorCount, dev);
        (void)hipFuncSetAttribute((const void*)fwd, hipFuncAttributeMaxDynamicSharedMemorySize, LDS_BYTES);
        if (hipOccupancyMaxActiveBlocksPerMultiprocessor(&per_cu, (const void*)fwd, NTHREADS, LDS_BYTES) != hipSuccess || per_cu < 1) { fprintf(stderr, "kernel_launch: occupancy query says %d blocks/CU\n", per_cu); (void)hipGetLastError(); grid = -1; return; }
        grid = cus * 1;
    }
    if (grid < 0) return;
    Args a{};
    for (int i = 0; i < 24; ++i) a.in[i] = (const float*)d_in[i];
    a.out = (float*)d_out; a.ws = (unsigned char*)d_ws;
    void* kargs[] = {&a};
    hipError_t e = hipLaunchCooperativeKernel((const void*)fwd, dim3(grid), dim3(NTHREADS), kargs, LDS_BYTES, stream);
    if (e != hipSuccess) fprintf(stderr, "cooperative launch failed: %s (grid %d)\n", hipGetErrorString(e), grid);
}
```

```cpp
#include <hip/hip_runtime.h>
#include <hip/hip_cooperative_groups.h>
namespace cg = cooperative_groups;
#include <cstdio>
#include <cstdint>

typedef unsigned short bf16_t;
typedef short bf16x8 __attribute__((ext_vector_type(8)));
typedef float f32x4 __attribute__((ext_vector_type(4)));
typedef unsigned u32x4 __attribute__((ext_vector_type(4)));
#define LAS __attribute__((address_space(3)))

constexpr int D = 1024, TP = 16384, T = 32768, SEQP = 2048;
constexpr int NPROJ = 5376, DFF = 2816, NUP = 5632, MEMROWS = 2304;
constexpr int C_Q = 0, C_K = 512, C_V = 640, C_U = 768, C_SV = 1280, C_QM = 1792, C_G = 2304;
constexpr float EPS = 1e-6f, LOG2E = 1.4426950408889634f;
constexpr float QSCALE = 0.125f * LOG2E, MSCALE = 0.08838834764831845f * LOG2E;
constexpr int NTHREADS = 512, NWAVES = 8;

constexpr size_t MiB = 1u << 20;
constexpr size_t WS_CTL = 0;
constexpr size_t WS_WIN = 2 * MiB;
constexpr size_t WS_WMKV = 13 * MiB;
constexpr size_t WS_WBR = 15 * MiB;
constexpr size_t WS_WOUT = 18 * MiB;
constexpr size_t WS_WUP = 20 * MiB;
constexpr size_t WS_WDN = 31 * MiB;
constexpr size_t WS_SGUW = 37 * MiB;
constexpr size_t WS_MEMN = 38 * MiB;
constexpr size_t WS_MKV = 43 * MiB;
constexpr size_t WS_SSQ1 = 48 * MiB;
constexpr size_t WS_STAT = 50 * MiB;
constexpr size_t WS_H = 52 * MiB;
constexpr size_t WS_PROJ = 116 * MiB;
constexpr size_t WS_AUP = 52 * MiB;
constexpr size_t WS_G = 228 * MiB;
constexpr size_t WS_EDGE = 404 * MiB;
constexpr size_t WS_H2 = 448 * MiB;
constexpr size_t WS_END = 512 * MiB;

constexpr int LDS_BYTES = 147456;

__device__ __forceinline__ float bf2f(bf16_t v) { return __uint_as_float((unsigned)v << 16); }
__device__ __forceinline__ unsigned f2bf(float f) { unsigned u = __float_as_uint(f); return (u + 0x7fffu + ((u >> 16) & 1u)) >> 16; }
__device__ __forceinline__ unsigned pk2(float lo, float hi) { return f2bf(lo) | (f2bf(hi) << 16); }
__device__ __forceinline__ float gelu_tanh(float x) {
    const float u = x * (1.0f + 0.044715f * x * x) * (2.0f * 0.7978845608028654f * LOG2E);
    return x * __builtin_amdgcn_rcpf(1.0f + __builtin_amdgcn_exp2f(-u));
}
__device__ __forceinline__ float sigmoid_f(float x) { return __builtin_amdgcn_rcpf(1.0f + __builtin_amdgcn_exp2f(-x * LOG2E)); }
__device__ __forceinline__ float wave_sum(float v) {
#pragma unroll
    for (int o = 1; o < 64; o <<= 1) v += __shfl_xor(v, o);
    return v;
}
__device__ __forceinline__ int t5_bucket(int rel) {
    const int n = rel < 0 ? -rel : rel; const int ret = rel > 0 ? 16 : 0;
    if (n < 8) return ret + n;
    int l = (31 - __builtin_clz((unsigned)(n * n))) + 2; if (l > 15) l = 15;
    return ret + l;
}

struct Args {
    const float* in[24];
    float* out; unsigned char* ws;
    int ph_lo, ph_hi;
};

struct Ctx { int tid, lane, wave, gw, ngw, gtid, ngt; };

__device__ __forceinline__ const float* xrow(const Args& a, int r) { return r < TP ? a.in[0] + (size_t)r * D : a.in[1] + (size_t)(r - TP) * D; }
__device__ __forceinline__ const float* memrow(const Args& a, int r) { return r < 2048 ? a.in[2] + (size_t)r * D : a.in[3] + (size_t)(r - 2048) * D; }

__device__ __forceinline__ void tr_item(const float* W, int K, int N, bf16_t* WT, const float* ks, int upmap, LAS float* scr, int item, int lane) {
    const int nblk = N / 32, kb = item / nblk, nb = item % nblk, k0 = 64 * kb, n0 = 32 * nb;
#pragma unroll 8
    for (int i = 0; i < 32; ++i) { const int kk = 2 * i + (lane >> 5); float v = W[(size_t)(k0 + kk) * N + n0 + (lane & 31)]; if (ks) v *= ks[k0 + kk]; scr[kk * 33 + (lane & 31)] = v; }
    asm volatile("s_waitcnt lgkmcnt(0)" ::: "memory");
    int r0 = n0;
    if (upmap) { if (n0 < DFF) r0 = 256 * (n0 / 128) + (n0 % 128); else { const int m = n0 - DFF; r0 = 256 * (m / 128) + 128 + (m % 128); } }
    const int c = lane & 7;
#pragma unroll
    for (int j = 0; j < 4; ++j) { const int n = (lane >> 3) + 8 * j; const LAS float* s = scr + (8 * c) * 33 + n;
        u32x4 o; o.x = pk2(s[0 * 33], s[1 * 33]); o.y = pk2(s[2 * 33], s[3 * 33]); o.z = pk2(s[4 * 33], s[5 * 33]); o.w = pk2(s[6 * 33], s[7 * 33]);
        *(u32x4*)(WT + (size_t)(r0 + n) * K + k0 + 8 * c) = o; }
    asm volatile("s_waitcnt lgkmcnt(0)" ::: "memory");
}
__device__ __forceinline__ void rms_row_to_bf16(const float* xr, const float* g, bf16_t* orow, int lane) {
    f32x4 v[4]; float s = 0.f;
#pragma unroll
    for (int j = 0; j < 4; ++j) { v[j] = ((const f32x4*)xr)[lane + 64 * j]; s += (v[j].x * v[j].x + v[j].y * v[j].y) + (v[j].z * v[j].z + v[j].w * v[j].w); }
    const float rstd = 1.0f / sqrtf(wave_sum(s) * (1.0f / D) + EPS);
#pragma unroll
    for (int j = 0; j < 4; ++j) { const f32x4 gg = ((const f32x4*)g)[lane + 64 * j];
        const unsigned lo = pk2(v[j].x * rstd * gg.x, v[j].y * rstd * gg.y), hi = pk2(v[j].z * rstd * gg.z, v[j].w * rstd * gg.w);
        ((unsigned long long*)orow)[lane + 64 * j] = (unsigned long long)lo | ((unsigned long long)hi << 32); }
}
__device__ __forceinline__ void p0_prologue(const Args& a, const Ctx& c, LAS unsigned char* lds) {
    LAS float* scr = (LAS float*)(lds + c.wave * 16384);
    unsigned char* ws = a.ws;
    constexpr int I_IN = 16 * (NPROJ / 32), I_MKV = 16 * 32, I_BR = 8 * 32, I_OUT = 16 * 32, I_UP = 16 * (NUP / 32), I_DN = (DFF / 64) * 32;
    constexpr int NITEMS = I_IN + I_MKV + 3 * I_BR + I_OUT + I_UP + I_DN;
    for (int it = c.gw; it < NITEMS; it += c.ngw) {
        int r = it;
        if (r < I_IN) { tr_item(a.in[6], D, NPROJ, (bf16_t*)(ws + WS_WIN), nullptr, 0, scr, r, c.lane); continue; } r -= I_IN;
        if (r < I_MKV) { tr_item(a.in[13], D, 1024, (bf16_t*)(ws + WS_WMKV), nullptr, 0, scr, r, c.lane); continue; } r -= I_MKV;
        if (r < I_BR) { tr_item(a.in[14], 512, 1024, (bf16_t*)(ws + WS_WBR), nullptr, 0, scr, r, c.lane); continue; } r -= I_BR;
        if (r < I_BR) { tr_item(a.in[15], 512, 1024, (bf16_t*)(ws + WS_WBR + 1 * MiB), nullptr, 0, scr, r, c.lane); continue; } r -= I_BR;
        if (r < I_BR) { tr_item(a.in[16], 512, 1024, (bf16_t*)(ws + WS_WBR + 2 * MiB), nullptr, 0, scr, r, c.lane); continue; } r -= I_BR;
        if (r < I_OUT) { tr_item(a.in[17], D, 1024, (bf16_t*)(ws + WS_WOUT), nullptr, 0, scr, r, c.lane); continue; } r -= I_OUT;
        if (r < I_UP) { tr_item(a.in[19], D, NUP, (bf16_t*)(ws + WS_WUP), a.in[18], 1, scr, r, c.lane); continue; } r -= I_UP;
        tr_item(a.in[22], DFF, 1024, (bf16_t*)(ws + WS_WDN), nullptr, 0, scr, r, c.lane);
    }
    { bf16_t* o = (bf16_t*)(ws + WS_SGUW); const float* w = a.in[8];
      for (int i = c.gtid; i < 4 * 128 * 128 / 2; i += c.ngt) ((unsigned*)o)[i] = pk2(w[2 * i], w[2 * i + 1]); }
    for (int m = c.gw; m < T; m += c.ngw) rms_row_to_bf16(xrow(a, m), a.in[5], (bf16_t*)(ws + WS_H) + (size_t)m * D, c.lane);
    for (int m = c.gw; m < MEMROWS; m += c.ngw) rms_row_to_bf16(memrow(a, m), a.in[12], (bf16_t*)(ws + WS_MEMN) + (size_t)m * D, c.lane);
}

__device__ __forceinline__ void wt_mma(f32x4 (&acc)[4][4], const bf16_t* A, int lda, const bf16_t* B, int ldb, int K, int lane) {
    const bf16_t* a0 = A + (size_t)(lane & 15) * lda + 8 * (lane >> 4);
    const bf16_t* b0 = B + (size_t)(lane & 15) * ldb + 8 * (lane >> 4);
    for (int k = 0; k < K; k += 32) {
        bf16x8 af[4], bfr[4];
#pragma unroll
        for (int i = 0; i < 4; ++i) { af[i] = *(const bf16x8*)(a0 + (size_t)i * 16 * lda + k); bfr[i] = *(const bf16x8*)(b0 + (size_t)i * 16 * ldb + k); }
#pragma unroll
        for (int i = 0; i < 4; ++i)
#pragma unroll
            for (int j = 0; j < 4; ++j) acc[i][j] = __builtin_amdgcn_mfma_f32_16x16x32_bf16(af[i], bfr[j], acc[i][j], 0, 0, 0);
    }
}
__device__ __forceinline__ void zero_acc(f32x4 (&acc)[4][4]) {
#pragma unroll
    for (int i = 0; i < 4; ++i)
#pragma unroll
        for (int j = 0; j < 4; ++j) acc[i][j] = (f32x4){0.f, 0.f, 0.f, 0.f};
}
template <class Epi>
__device__ __forceinline__ void sgemm_phase(const bf16_t* A, int lda, const bf16_t* Bt, int ldb, int M, int N, int K, const Epi& epi, const Ctx& c) {
    const int nN = N / 64, ntask = (M / 64) * nN;
    for (int t = c.gw; t < ntask; t += c.ngw) {
        const int tm = t / nN, tn = t % nN;
        f32x4 acc[4][4]; zero_acc(acc);
        wt_mma(acc, A + (size_t)tm * 64 * lda, lda, Bt + (size_t)tn * 64 * ldb, ldb, K, c.lane);
#pragma unroll
        for (int i = 0; i < 4; ++i)
#pragma unroll
            for (int r = 0; r < 4; ++r) { const int row = tm * 64 + 16 * i + 4 * (c.lane >> 4) + r; const float rs = epi.rowpre(row);
#pragma unroll
                for (int j = 0; j < 4; ++j) epi(row, tn * 64 + 16 * j + (c.lane & 15), acc[i][j][r] * rs); }
    }
}

struct EpiProjN { bf16_t* P;
    __device__ __forceinline__ float rowpre(int) const { return 1.0f; }
    __device__ __forceinline__ void operator()(int r, int col, float v) const {
        float o;
        if (col < C_K) o = v * QSCALE; else if (col < C_U) o = v; else if (col < C_QM) o = gelu_tanh(v); else if (col < C_G) o = v * MSCALE; else o = sigmoid_f(v);
        P[(size_t)r * NPROJ + col] = (bf16_t)f2bf(o); } };
struct EpiBf16N { bf16_t* P; int ldc;
    __device__ __forceinline__ float rowpre(int) const { return 1.0f; }
    __device__ __forceinline__ void operator()(int r, int col, float v) const { P[(size_t)r * ldc + col] = (bf16_t)f2bf(v); } };
struct EpiOutN { const Args* a; bf16_t* H2;
    __device__ __forceinline__ float rowpre(int) const { return 1.0f; }
    __device__ __forceinline__ void operator()(int r, int col, float v) const { const float x1 = xrow(*a, r)[col] + v; a->out[(size_t)r * D + col] = x1; H2[(size_t)r * D + col] = (bf16_t)f2bf(x1); } };
struct EpiUpN { bf16_t* AUP; const float* ssq;
    __device__ __forceinline__ float rowpre(int r) const {
        float s = 0.f;
#pragma unroll
        for (int i = 0; i < 16; ++i) s += ssq[(size_t)r * 16 + i];
        return 1.0f / sqrtf(s * (1.0f / D) + EPS); }
    __device__ __forceinline__ void operator()(int r, int col, float v) const { AUP[(size_t)r * DFF + col] = (bf16_t)f2bf(v); } };
struct EpiDownN { float* out;
    __device__ __forceinline__ float rowpre(int) const { return 1.0f; }
    __device__ __forceinline__ void operator()(int r, int col, float v) const { out[(size_t)r * D + col] += v; } };

__device__ __forceinline__ float dot8(bf16x8 a, bf16x8 b) {
    float s = 0.f;
#pragma unroll
    for (int i = 0; i < 8; ++i) s += bf2f((bf16_t)a[i]) * bf2f((bf16_t)b[i]);
    return s;
}
__device__ __forceinline__ void naive_wattn(const Args& a, const Ctx& c) {
    bf16_t* proj = (bf16_t*)(a.ws + WS_PROJ);
    const float* relb = a.in[4]; const float* sink = a.in[7];
    for (int idx = c.gtid; idx < T * 8; idx += c.ngt) {
        const int h = idx & 7, row = idx >> 3, kvh = h >> 2;
        const int s0 = row < TP ? (row & ~(SEQP - 1)) : TP, S = row < TP ? SEQP : TP, pos = row - s0;
        bf16x8 q[8]; float o[64];
        bf16_t* qp = proj + (size_t)row * NPROJ + C_Q + h * 64;
#pragma unroll
        for (int d = 0; d < 8; ++d) q[d] = ((const bf16x8*)qp)[d];
#pragma unroll
        for (int d = 0; d < 64; ++d) o[d] = 0.f;
        float m = sink[h] * LOG2E, l = 1.0f;
        const int j0 = pos - 128 < 0 ? 0 : pos - 128, j1 = pos + 128 > S - 1 ? S - 1 : pos + 128;
        for (int j = j0; j <= j1; ++j) {
            const bf16x8* kp = (const bf16x8*)(proj + (size_t)(s0 + j) * NPROJ + C_K + kvh * 64);
            const bf16x8* vp = (const bf16x8*)(proj + (size_t)(s0 + j) * NPROJ + C_V + kvh * 64);
            float s = 0.f;
#pragma unroll
            for (int d = 0; d < 8; ++d) s += dot8(q[d], kp[d]);
            s += relb[t5_bucket(j - pos) * 8 + h] * LOG2E;
            if (s > m) { const float f = __builtin_amdgcn_exp2f(m - s); l *= f;
#pragma unroll
                for (int d = 0; d < 64; ++d) o[d] *= f;
                m = s; }
            const float p = __builtin_amdgcn_exp2f(s - m); l += p;
#pragma unroll
            for (int d = 0; d < 8; ++d) { const bf16x8 v = vp[d];
#pragma unroll
                for (int e = 0; e < 8; ++e) o[8 * d + e] += p * bf2f((bf16_t)v[e]); }
        }
        const float il = 1.0f / l;
#pragma unroll
        for (int d = 0; d < 64; ++d) qp[d] = (bf16_t)f2bf(o[d] * il);
    }
}
__device__ __forceinline__ void naive_mattn(const Args& a, const Ctx& c) {
    bf16_t* proj = (bf16_t*)(a.ws + WS_PROJ); const bf16_t* mkv = (const bf16_t*)(a.ws + WS_MKV);
    for (int idx = c.gtid; idx < T * 8; idx += c.ngt) {
        const int half = idx & 1, h = (idx >> 1) & 3, row = idx >> 3;
        const int b = row < TP ? row / SEQP : 8;
        bf16_t* qp = proj + (size_t)row * NPROJ + C_QM + h * 128;
        bf16x8 q[16]; float o[64];
#pragma unroll
        for (int d = 0; d < 16; ++d) q[d] = ((const bf16x8*)qp)[d];
#pragma unroll
        for (int d = 0; d < 64; ++d) o[d] = 0.f;
        float m = -3.0e38f, l = 0.f;
        for (int j = 0; j < 256; ++j) {
            const bf16x8* kp = (const bf16x8*)(mkv + (size_t)(b * 256 + j) * 1024 + h * 128);
            const bf16x8* vp = (const bf16x8*)(mkv + (size_t)(b * 256 + j) * 1024 + 512 + h * 128 + half * 64);
            float s = 0.f;
#pragma unroll
            for (int d = 0; d < 16; ++d) s += dot8(q[d], kp[d]);
            if (s > m) { const float f = __builtin_amdgcn_exp2f(m - s); l *= f;
#pragma unroll
                for (int d = 0; d < 64; ++d) o[d] *= f;
                m = s; }
            const float p = __builtin_amdgcn_exp2f(s - m); l += p;
#pragma unroll
            for (int d = 0; d < 8; ++d) { const bf16x8 v = vp[d];
#pragma unroll
                for (int e = 0; e < 8; ++e) o[8 * d + e] += p * bf2f((bf16_t)v[e]); }
        }
        const float il = 1.0f / l;
        asm volatile("" ::: "memory");
#pragma unroll
        for (int d = 0; d < 64; ++d) qp[half * 64 + d] = (bf16_t)f2bf(o[d] * il);
    }
}
__device__ __forceinline__ void naive_sgu_stats(const Args& a, const Ctx& c) {
    const bf16_t* proj = (const bf16_t*)(a.ws + WS_PROJ); float* stat = (float*)(a.ws + WS_STAT);
    for (int row = c.gw; row < T; row += c.ngw) {
        const bf16_t* vp = proj + (size_t)row * NPROJ + C_SV;
        float v[8]; float s = 0.f;
#pragma unroll
        for (int i = 0; i < 8; ++i) { v[i] = bf2f(vp[c.lane * 8 + i]); s += v[i]; }
        const float mu = wave_sum(s) * (1.0f / 512.0f); float q = 0.f;
#pragma unroll
        for (int i = 0; i < 8; ++i) { const float d = v[i] - mu; q += d * d; }
        const float rstd = 1.0f / sqrtf(wave_sum(q) * (1.0f / 512.0f) + EPS);
        if (c.lane == 0) { stat[2 * row] = mu; stat[2 * row + 1] = rstd; }
    }
}
__device__ __forceinline__ void naive_sgu(const Args& a, const Ctx& c) {
    bf16_t* proj = (bf16_t*)(a.ws + WS_PROJ); const float* stat = (const float*)(a.ws + WS_STAT);
    const float* w_s = a.in[8]; const float* b_s = a.in[9]; const float* lng = a.in[10]; const float* lnb = a.in[11];
    for (int idx = c.gtid; idx < T * 512; idx += c.ngt) {
        const int ch = idx & 511, row = idx >> 9, g = ch >> 7, i = row & 127, r0 = row & ~127;
        const float gg = lng[ch], bb = lnb[ch];
        float acc = 0.f;
        for (int j = 0; j < 128; ++j) {
            const float v = bf2f(proj[(size_t)(r0 + j) * NPROJ + C_SV + ch]);
            const float vn = (v - stat[2 * (r0 + j)]) * stat[2 * (r0 + j) + 1] * gg + bb;
            acc += w_s[(g * 128 + i) * 128 + j] * vn;
        }
        acc += b_s[g * 128 + i];
        bf16_t* up = proj + (size_t)row * NPROJ + C_U + ch;
        *up = (bf16_t)f2bf(bf2f(*up) * acc);
    }
}
__device__ __forceinline__ void naive_branch(const Args& a, const Ctx& c) {
    const bf16_t* proj = (const bf16_t*)(a.ws + WS_PROJ); bf16_t* merged = (bf16_t*)(a.ws + WS_H);
    const int nN = 1024 / 64, ntask = (T / 64) * nN;
    for (int t = c.gw; t < ntask; t += c.ngw) {
        const int tm = t / nN, tn = t % nN;
        f32x4 m[4][4]; zero_acc(m);
#pragma unroll 1
        for (int br = 0; br < 3; ++br) {
            const int acol = br == 0 ? C_Q : (br == 1 ? C_U : C_QM);
            f32x4 acc[4][4]; zero_acc(acc);
            wt_mma(acc, proj + (size_t)tm * 64 * NPROJ + acol, NPROJ, (const bf16_t*)(a.ws + WS_WBR + br * MiB) + (size_t)tn * 64 * 512, 512, 512, c.lane);
#pragma unroll
            for (int i = 0; i < 4; ++i)
#pragma unroll
                for (int j = 0; j < 4; ++j)
#pragma unroll
                    for (int r = 0; r < 4; ++r) { const int row = tm * 64 + 16 * i + 4 * (c.lane >> 4) + r, col = tn * 64 + 16 * j + (c.lane & 15);
                        m[i][j][r] += bf2f(proj[(size_t)row * NPROJ + C_G + br * 1024 + col]) * acc[i][j][r]; }
        }
#pragma unroll
        for (int i = 0; i < 4; ++i)
#pragma unroll
            for (int j = 0; j < 4; ++j)
#pragma unroll
                for (int r = 0; r < 4; ++r) { const int row = tm * 64 + 16 * i + 4 * (c.lane >> 4) + r, col = tn * 64 + 16 * j + (c.lane & 15);
                    merged[(size_t)row * D + col] = (bf16_t)f2bf(m[i][j][r]); }
    }
}
__device__ __forceinline__ void naive_ssq(const Args& a, const Ctx& c) {
    float* ssq = (float*)(a.ws + WS_SSQ1);
    for (int row = c.gw; row < T; row += c.ngw) {
        const f32x4* xr = (const f32x4*)(a.out + (size_t)row * D); float s = 0.f;
#pragma unroll
        for (int j = 0; j < 4; ++j) { const f32x4 v = xr[c.lane + 64 * j]; s += (v.x * v.x + v.y * v.y) + (v.z * v.z + v.w * v.w); }
        s = wave_sum(s);
        if (c.lane < 16) ssq[(size_t)row * 16 + c.lane] = c.lane == 0 ? s : 0.f;
    }
}
__device__ __forceinline__ void naive_conv(const Args& a, const Ctx& c, int half) {
    const bf16_t* aup = (const bf16_t*)(a.ws + WS_AUP); bf16_t* g = (bf16_t*)(a.ws + WS_G);
    const float* cw = a.in[20]; const float* cb = a.in[21];
    for (int idx = c.gtid; idx < T * 1408; idx += c.ngt) {
        const int row = idx / 1408, lc = idx % 1408, jj = lc >> 7, ii = lc & 127, ch = half * 1408 + lc;
        const int s0 = row < TP ? (row & ~(SEQP - 1)) : TP, S = row < TP ? SEQP : TP, pos = row - s0;
        const size_t o = (size_t)row * DFF + 256 * jj + ii;
        const float g1 = bf2f(aup[o]), u1 = bf2f(aup[o + 128]);
        const float g0 = pos > 0 ? bf2f(aup[o - DFF]) : 0.f, u0 = pos > 0 ? bf2f(aup[o - DFF + 128]) : 0.f;
        const float g2 = pos < S - 1 ? bf2f(aup[o + DFF]) : 0.f, u2 = pos < S - 1 ? bf2f(aup[o + DFF + 128]) : 0.f;
        const float ga = g0 * cw[ch] + g1 * cw[NUP + ch] + g2 * cw[2 * NUP + ch] + cb[ch];
        const float ua = u0 * cw[DFF + ch] + u1 * cw[NUP + DFF + ch] + u2 * cw[2 * NUP + DFF + ch] + cb[DFF + ch];
        g[(size_t)row * DFF + ch] = (bf16_t)f2bf(gelu_tanh(ga) * ua);
    }
}
__device__ __forceinline__ void final_norm(const Args& a, const Ctx& c) {
    const float* gf = a.in[23];
    for (int row = c.gw; row < T; row += c.ngw) {
        f32x4* xr = (f32x4*)(a.out + (size_t)row * D); f32x4 v[4]; float s = 0.f;
#pragma unroll
        for (int j = 0; j < 4; ++j) { v[j] = xr[c.lane + 64 * j]; s += (v[j].x * v[j].x + v[j].y * v[j].y) + (v[j].z * v[j].z + v[j].w * v[j].w); }
        const float rstd = 1.0f / sqrtf(wave_sum(s) * (1.0f / D) + EPS);
#pragma unroll
        for (int j = 0; j < 4; ++j) { const f32x4 gg = ((const f32x4*)gf)[c.lane + 64 * j]; xr[c.lane + 64 * j] = (f32x4){v[j].x * rstd * gg.x, v[j].y * rstd * gg.y, v[j].z * rstd * gg.z, v[j].w * rstd * gg.w}; }
    }
}

namespace pg8 {
constexpr int BM = 256, BK = 64, HALF = 128, HTB = HALF * BK * 2, STAGE_BYTES = 8 * HTB, NXCD = 8, WGM = 8;
__host__ __device__ __forceinline__ int lds_byte(int r, int c) { const int st = (r >> 4) * 2 + (c >> 5), rr = r & 15, cc = c & 31, ob = rr * 64 + cc * 2; return st * 1024 + (ob ^ (((ob >> 9) & 1) << 5)); }
__host__ __device__ __forceinline__ void stage_rc(int b, int& R, int& C) { const int st = b / 1024, sb = b % 1024, swz = sb ^ (((sb >> 9) & 1) << 5); R = (st >> 1) * 16 + swz / 64; C = (st & 1) * 32 + (swz % 64) / 2; }
__host__ __device__ __forceinline__ int perm32(int rho) { const int n = rho >> 4, i = rho & 15; return 8 * (i >> 2) + 4 * n + (i & 3); }

struct Unit { const char* A; const char* B; int pm, pn, aux; };

struct TileOrder {
    int nM, nN, nwg, G, c, rep;
    __device__ __forceinline__ void init(int nM_, int nN_, int G_, int c_, int rep_ = 1) { nM = nM_; nN = nN_; nwg = nM * nN; G = G_; c = c_; rep = rep_; }
    __device__ __forceinline__ bool tile(int i, int& pm, int& pn, int& aux) const {
        const int ti = i / rep; aux = i - ti * rep;
        const long L = (long)ti * G + c; if (L >= nwg) return false;
        int wgid = (int)L; { const int q = nwg / NXCD, r = nwg % NXCD, xcd = wgid % NXCD, off = wgid / NXCD; wgid = (xcd < r ? xcd * (q + 1) : r * (q + 1) + (xcd - r) * q) + off; }
        const int nig = WGM * nN, gid = wgid / nig, fm = gid * WGM, gsz = (nM - fm) < WGM ? (nM - fm) : WGM;
        pm = fm + ((wgid % nig) % gsz); pn = (wgid % nig) / gsz; return true;
    }
};
__device__ __forceinline__ unsigned cvt_pk_bf16(float lo, float hi) { unsigned r; asm volatile("v_cvt_pk_bf16_f32 %0, %1, %2" : "=v"(r) : "v"(lo), "v"(hi)); return r; }

template <class Epi, class Sched, bool ALIGN_EPI = true, bool SP2 = true>
__device__ __forceinline__ void gemm_phase(LAS unsigned char* lds, const int K, const int lda, const Sched& S, const Epi& E) {
    const int tid = threadIdx.x, wid = __builtin_amdgcn_readfirstlane(tid >> 6), lane = tid & 63, wr = wid >> 2, wc = wid & 3, fr = lane & 15, fq = lane >> 4;
    const int nt = K / BK;
    unsigned voffA[2], voffB[2];
#pragma unroll
    for (int i = 0; i < 2; ++i) { int R, C; stage_rc(tid * 16 + i * 8192, R, C); const int Rb = Epi::PERM ? ((R & ~31) + perm32(R & 31)) : R;
        voffA[i] = (unsigned)(R * lda + C) * 2u; voffB[i] = (unsigned)(Rb * K + C) * 2u; }
    const size_t kstep = (size_t)(BK * 2);
    const size_t hstepA = (size_t)HALF * lda * 2, hstepB = (size_t)HALF * K * 2;
    const unsigned ldsw = (unsigned)wid * 1024u;
    const int aoff = lds_byte(wr * 64 + fr, fq * 8), boff = lds_byte(wc * 32 + fr, fq * 8);
#define PG8_SA(b, h) (((b) * 2 + (h)) * HTB)
#define PG8_SB(b, h) ((4 + (b) * 2 + (h)) * HTB)
#define PG8_STAGE(bufoff, gbase, voff) do { _Pragma("unroll") for (int _i = 0; _i < 2; ++_i) \
        __builtin_amdgcn_global_load_lds((const unsigned*)((const char*)(gbase) + (voff)[_i]), (LAS unsigned*)(lds + (bufoff) + ldsw + _i * 8192), 16, 0, 0); } while (0)
#define PG8_LDA(dst, b, h) do { _Pragma("unroll") for (int m = 0; m < 4; ++m) _Pragma("unroll") for (int k = 0; k < 2; ++k) dst[m][k] = *(const LAS bf16x8*)(lds + PG8_SA(b, h) + aoff + m * 2048 + k * 1024); } while (0)
#define PG8_LDB(dst, b, h) do { _Pragma("unroll") for (int n = 0; n < 2; ++n) _Pragma("unroll") for (int k = 0; k < 2; ++k) dst[n][k] = *(const LAS bf16x8*)(lds + PG8_SB(b, h) + boff + n * 2048 + k * 1024); } while (0)
#define PG8_MMA(ai, bj, At, Bt) do { __builtin_amdgcn_s_setprio(1); _Pragma("unroll") for (int m = 0; m < 4; ++m) _Pragma("unroll") for (int n = 0; n < 2; ++n) _Pragma("unroll") for (int k = 0; k < 2; ++k) \
        acc[ai][bj][m][n] = __builtin_amdgcn_mfma_f32_16x16x32_bf16(Bt[n][k], At[m][k], acc[ai][bj][m][n], 0, 0, 0); __builtin_amdgcn_s_setprio(0); } while (0)
#define PG8_WAIT_V(n) asm volatile("s_waitcnt vmcnt(" #n ")" ::: "memory")
#define PG8_WAIT_L(n) asm volatile("s_waitcnt lgkmcnt(" #n ")" ::: "memory")
#define PG8_BAR __builtin_amdgcn_s_barrier()
#define PG8_SCHED __builtin_amdgcn_sched_barrier(0)
    Unit cur, nxt; int ui = 0;
    if (!S.next(0, cur)) return;
    f32x4 acc[2][2][4][2];
#pragma unroll
    for (int a = 0; a < 2; ++a)
#pragma unroll
        for (int b = 0; b < 2; ++b)
#pragma unroll
            for (int m = 0; m < 4; ++m)
#pragma unroll
                for (int n = 0; n < 2; ++n) acc[a][b][m][n] = (f32x4){0.f, 0.f, 0.f, 0.f};
    bf16x8 At[4][2], B0[2][2], B1[2][2];
    const char* cA = cur.A; const char* cB = cur.B;
    if constexpr (SP2) {
        PG8_STAGE(PG8_SB(0, 0), cB, voffB); PG8_STAGE(PG8_SB(0, 1), cB + hstepB, voffB); PG8_STAGE(PG8_SA(0, 0), cA, voffA); PG8_STAGE(PG8_SA(0, 1), cA + hstepA, voffA);
        if (wr == 1) PG8_BAR;
        PG8_WAIT_V(2); PG8_BAR;
        PG8_STAGE(PG8_SB(1, 0), cB + kstep, voffB); PG8_STAGE(PG8_SA(1, 0), cA + kstep, voffA); PG8_STAGE(PG8_SB(1, 1), cB + hstepB + kstep, voffB);
        PG8_WAIT_V(6); PG8_BAR;
    } else {
        PG8_STAGE(PG8_SB(0, 0), cB, voffB); PG8_STAGE(PG8_SA(0, 0), cA, voffA); PG8_STAGE(PG8_SB(0, 1), cB + hstepB, voffB); PG8_STAGE(PG8_SA(0, 1), cA + hstepA, voffA);
        if (wr == 1) PG8_BAR;
        PG8_WAIT_V(4); PG8_BAR;
        PG8_STAGE(PG8_SB(1, 0), cB + kstep, voffB); PG8_STAGE(PG8_SA(1, 0), cA + kstep, voffA); PG8_STAGE(PG8_SB(1, 1), cB + hstepB + kstep, voffB);
        PG8_WAIT_V(6); PG8_BAR;
    }
    for (;;) {
        const bool has_next = S.next(ui + 1, nxt);
        const char* nA = has_next ? nxt.A : cA; const char* nB = has_next ? nxt.B : cB;
        for (int t = 0; t < nt; t += 2) {
            const bool last = (t == nt - 2);
            const char* a1 = cA + (size_t)(t + 1) * kstep;
            const char* a2 = last ? nA : cA + (size_t)(t + 2) * kstep; const char* b2 = last ? nB : cB + (size_t)(t + 2) * kstep;
            const char* a3 = a2 + kstep; const char* b3 = b2 + kstep;
            if constexpr (SP2) {
            PG8_LDB(B0, 0, 0); PG8_LDB(B1, 0, 1); PG8_SCHED; PG8_LDA(At, 0, 0); PG8_STAGE(PG8_SA(1, 1), a1 + hstepA, voffA);
            PG8_WAIT_V(8); PG8_WAIT_L(0); PG8_BAR; PG8_MMA(0, 0, At, B0); PG8_MMA(0, 1, At, B1); PG8_BAR; PG8_SCHED;
            PG8_LDA(At, 0, 1); PG8_STAGE(PG8_SB(0, 0), b2, voffB); PG8_STAGE(PG8_SB(0, 1), b2 + hstepB, voffB); PG8_STAGE(PG8_SA(0, 0), a2, voffA);
            PG8_WAIT_V(8); PG8_WAIT_L(0); PG8_BAR; PG8_MMA(1, 0, At, B0); PG8_MMA(1, 1, At, B1); PG8_BAR; PG8_SCHED;
            PG8_LDB(B0, 1, 0); PG8_LDB(B1, 1, 1); PG8_SCHED; PG8_LDA(At, 1, 0); PG8_STAGE(PG8_SA(0, 1), a2 + hstepA, voffA);
            PG8_WAIT_V(8); PG8_WAIT_L(0); PG8_BAR; PG8_MMA(0, 0, At, B0); PG8_MMA(0, 1, At, B1); PG8_BAR; PG8_SCHED;
            PG8_LDA(At, 1, 1); PG8_STAGE(PG8_SB(1, 0), b3, voffB); PG8_STAGE(PG8_SB(1, 1), b3 + hstepB, voffB); PG8_STAGE(PG8_SA(1, 0), a3, voffA);
            PG8_WAIT_V(8); PG8_WAIT_L(0); PG8_BAR; PG8_MMA(1, 0, At, B0); PG8_MMA(1, 1, At, B1); PG8_BAR; PG8_SCHED;
            } else {
            PG8_LDB(B0, 0, 0); PG8_SCHED; PG8_LDA(At, 0, 0); PG8_STAGE(PG8_SA(1, 1), a1 + hstepA, voffA);
            PG8_WAIT_L(8); PG8_BAR; PG8_WAIT_L(0); PG8_MMA(0, 0, At, B0); PG8_BAR; PG8_SCHED;
            PG8_LDB(B1, 0, 1); PG8_STAGE(PG8_SB(0, 0), b2, voffB);
            PG8_BAR; PG8_WAIT_L(0); PG8_MMA(0, 1, At, B1); PG8_BAR;
            PG8_LDA(At, 0, 1); PG8_STAGE(PG8_SA(0, 0), a2, voffA);
            PG8_BAR; PG8_WAIT_L(0); PG8_MMA(1, 0, At, B0); PG8_BAR; PG8_SCHED;
            PG8_STAGE(PG8_SB(0, 1), b2 + hstepB, voffB);
            PG8_WAIT_V(6); PG8_BAR; PG8_MMA(1, 1, At, B1); PG8_BAR;
            PG8_LDB(B0, 1, 0); PG8_SCHED; PG8_LDA(At, 1, 0); PG8_STAGE(PG8_SA(0, 1), a2 + hstepA, voffA);
            PG8_WAIT_L(8); PG8_BAR; PG8_WAIT_L(0); PG8_MMA(0, 0, At, B0); PG8_BAR; PG8_SCHED;
            PG8_LDB(B1, 1, 1); PG8_STAGE(PG8_SB(1, 0), b3, voffB);
            PG8_BAR; PG8_WAIT_L(0); PG8_MMA(0, 1, At, B1); PG8_BAR;
            PG8_LDA(At, 1, 1); PG8_STAGE(PG8_SA(1, 0), a3, voffA);
            PG8_BAR; PG8_WAIT_L(0); PG8_MMA(1, 0, At, B0); PG8_BAR; PG8_SCHED;
            PG8_STAGE(PG8_SB(1, 1), b3 + hstepB, voffB);
            PG8_WAIT_V(6); PG8_BAR; PG8_MMA(1, 1, At, B1); PG8_BAR;
            }
        }
        if constexpr (ALIGN_EPI) { if (wr == 0) PG8_BAR; }
        E(acc, cur, wr, wc, fr, fq);
        if (!has_next) break;
#pragma unroll
        for (int a = 0; a < 2; ++a)
#pragma unroll
            for (int b = 0; b < 2; ++b)
#pragma unroll
                for (int m = 0; m < 4; ++m)
#pragma unroll
                    for (int n = 0; n < 2; ++n) acc[a][b][m][n] = (f32x4){0.f, 0.f, 0.f, 0.f};
        cur = nxt; cA = nA; cB = nB; ++ui;
        if constexpr (ALIGN_EPI) { if (wr == 1) PG8_BAR; }
    }
    PG8_WAIT_V(0);
    if constexpr (!ALIGN_EPI) { if (wr == 0) PG8_BAR; }
    PG8_BAR;
#undef PG8_SA
#undef PG8_SB
#undef PG8_STAGE
#undef PG8_LDA
#undef PG8_LDB
#undef PG8_MMA
#undef PG8_WAIT_V
#undef PG8_WAIT_L
#undef PG8_BAR
#undef PG8_SCHED
}

struct SchedPlain {
    TileOrder o; const char* A; const char* B; size_t strideA, strideB;
    __device__ __forceinline__ bool next(int i, Unit& u) const { int aux; if (!o.tile(i, u.pm, u.pn, aux)) return false; u.aux = aux; u.A = A + (size_t)u.pm * strideA; u.B = B + (size_t)u.pn * strideB; return true; }
};
struct SchedOne {
    int idx, nN; const char* A; const char* B; size_t strideA, strideB;
    __device__ __forceinline__ bool next(int i, Unit& u) const { if (i > 0 || idx < 0) return false; u.pm = idx / nN; u.pn = idx % nN; u.aux = 0; u.A = A + (size_t)u.pm * strideA; u.B = B + (size_t)u.pn * strideB; return true; }
};

__device__ __forceinline__ f32x4 act4(f32x4 v, int mode) {
    if (mode == 1) return v * QSCALE;
    if (mode == 3) return v * MSCALE;
    if (mode == 2) return (f32x4){gelu_tanh(v[0]), gelu_tanh(v[1]), gelu_tanh(v[2]), gelu_tanh(v[3])};
    if (mode == 4) return (f32x4){sigmoid_f(v[0]), sigmoid_f(v[1]), sigmoid_f(v[2]), sigmoid_f(v[3])};
    return v;
}
struct EpiProj {
    static constexpr bool PERM = true;
    bf16_t* P;
    __device__ __forceinline__ void operator()(const f32x4 (&acc)[2][2][4][2], const Unit& u, int wr, int wc, int fr, int fq) const {
        const int pn = u.pn, mode = pn < 2 ? 1 : (pn == 2 ? 0 : (pn < 7 ? 2 : (pn < 9 ? 3 : 4)));
        const int row0 = u.pm * BM + wr * 64 + fr, col0 = pn * BM + wc * 32 + 8 * fq;
#pragma unroll
        for (int ai = 0; ai < 2; ++ai)
#pragma unroll
            for (int m = 0; m < 4; ++m) { bf16_t* rowp = P + (size_t)(row0 + ai * HALF + m * 16) * NPROJ + col0;
#pragma unroll
                for (int bj = 0; bj < 2; ++bj) { const f32x4 v0 = act4(acc[ai][bj][m][0], mode), v1 = act4(acc[ai][bj][m][1], mode);
                    u32x4 w; w.x = cvt_pk_bf16(v0[0], v0[1]); w.y = cvt_pk_bf16(v0[2], v0[3]); w.z = cvt_pk_bf16(v1[0], v1[1]); w.w = cvt_pk_bf16(v1[2], v1[3]);
                    *(u32x4*)(rowp + bj * HALF) = w; } }
    }
};
struct EpiPlain {
    static constexpr bool PERM = true;
    bf16_t* P; int ldc;
    __device__ __forceinline__ void operator()(const f32x4 (&acc)[2][2][4][2], const Unit& u, int wr, int wc, int fr, int fq) const {
        const int row0 = u.pm * BM + wr * 64 + fr, col0 = u.pn * BM + wc * 32 + 8 * fq;
#pragma unroll
        for (int ai = 0; ai < 2; ++ai)
#pragma unroll
            for (int m = 0; m < 4; ++m) { bf16_t* rowp = P + (size_t)(row0 + ai * HALF + m * 16) * ldc + col0;
#pragma unroll
                for (int bj = 0; bj < 2; ++bj) { const f32x4 v0 = acc[ai][bj][m][0], v1 = acc[ai][bj][m][1];
                    u32x4 w; w.x = cvt_pk_bf16(v0[0], v0[1]); w.y = cvt_pk_bf16(v0[2], v0[3]); w.z = cvt_pk_bf16(v1[0], v1[1]); w.w = cvt_pk_bf16(v1[2], v1[3]);
                    *(u32x4*)(rowp + bj * HALF) = w; } }
    }
};
__device__ __forceinline__ f32x4 unpk4(unsigned a, unsigned b) { return (f32x4){__uint_as_float(a << 16), __uint_as_float(a & 0xffff0000u), __uint_as_float(b << 16), __uint_as_float(b & 0xffff0000u)}; }
struct SchedBranch {
    TileOrder o; const char* proj; const char* wbr;
    __device__ __forceinline__ bool next(int i, Unit& u) const { int aux; if (!o.tile(i, u.pm, u.pn, aux)) return false; u.aux = aux;
        const int acol = aux == 0 ? C_Q : (aux == 1 ? C_U : C_QM);
        u.A = proj + ((size_t)u.pm * 256 * NPROJ + acol) * 2; u.B = wbr + (size_t)aux * MiB + (size_t)u.pn * 256 * 512 * 2; return true; }
};
struct EpiBranch {
    static constexpr bool PERM = true;
    const bf16_t* proj; bf16_t* merged;
    __device__ __forceinline__ void operator()(const f32x4 (&acc)[2][2][4][2], const Unit& u, int wr, int wc, int fr, int fq) const {
        const int br = u.aux, row0 = u.pm * BM + wr * 64 + fr, col0 = u.pn * BM + wc * 32 + 8 * fq;
#pragma unroll
        for (int ai = 0; ai < 2; ++ai)
#pragma unroll
            for (int m = 0; m < 4; ++m) { const int row = row0 + ai * HALF + m * 16;
                const bf16_t* gp = proj + (size_t)row * NPROJ + C_G + br * 1024 + col0; bf16_t* mp = merged + (size_t)row * D + col0;
#pragma unroll
                for (int bj = 0; bj < 2; ++bj) { const u32x4 gw = *(const u32x4*)(gp + bj * HALF);
                    f32x4 v0 = acc[ai][bj][m][0] * unpk4(gw.x, gw.y), v1 = acc[ai][bj][m][1] * unpk4(gw.z, gw.w);
                    if (br > 0) { const u32x4 mw = *(const u32x4*)(mp + bj * HALF); v0 += unpk4(mw.x, mw.y); v1 += unpk4(mw.z, mw.w); }
                    u32x4 w; w.x = cvt_pk_bf16(v0[0], v0[1]); w.y = cvt_pk_bf16(v0[2], v0[3]); w.z = cvt_pk_bf16(v1[0], v1[1]); w.w = cvt_pk_bf16(v1[2], v1[3]);
                    *(u32x4*)(mp + bj * HALF) = w; } }
    }
};
struct EpiOut {
    static constexpr bool PERM = false;
    const float* xp; const float* xs; float* out; bf16_t* H2; float* ssq;
    __device__ __forceinline__ void operator()(const f32x4 (&acc)[2][2][4][2], const Unit& u, int wr, int wc, int fr, int fq) const {
        const int col0 = u.pn * BM + wc * 32 + 4 * fq;
#pragma unroll
        for (int ai = 0; ai < 2; ++ai)
#pragma unroll
            for (int m = 0; m < 4; ++m) { const int row = u.pm * BM + ai * HALF + wr * 64 + m * 16 + fr;
                const float* xr = (row < TP ? xp + (size_t)row * D : xs + (size_t)(row - TP) * D) + col0; const size_t ob = (size_t)row * D + col0; float s = 0.f;
#pragma unroll
                for (int bj = 0; bj < 2; ++bj)
#pragma unroll
                    for (int n = 0; n < 2; ++n) { const int off = bj * HALF + n * 16; const f32x4 x1 = *(const f32x4*)(xr + off) + acc[ai][bj][m][n];
                        *(f32x4*)(out + ob + off) = x1; s += (x1[0] * x1[0] + x1[1] * x1[1]) + (x1[2] * x1[2] + x1[3] * x1[3]);
                        const unsigned lo = cvt_pk_bf16(x1[0], x1[1]), hi = cvt_pk_bf16(x1[2], x1[3]);
                        *(unsigned long long*)(H2 + ob + off) = (unsigned long long)lo | ((unsigned long long)hi << 32); }
                s += __shfl_xor(s, 16); s += __shfl_xor(s, 32);
                if (fq == 0) ssq[(size_t)row * 16 + u.pn * 4 + wc] = s; }
    }
};
struct EpiDown {
    static constexpr bool PERM = false;
    float* out;
    __device__ __forceinline__ void operator()(const f32x4 (&acc)[2][2][4][2], const Unit& u, int wr, int wc, int fr, int fq) const {
        const int col0 = u.pn * BM + wc * 32 + 4 * fq;
#pragma unroll
        for (int ai = 0; ai < 2; ++ai)
#pragma unroll
            for (int m = 0; m < 4; ++m) { const int row = u.pm * BM + ai * HALF + wr * 64 + m * 16 + fr; float* op = out + (size_t)row * D + col0;
#pragma unroll
                for (int bj = 0; bj < 2; ++bj)
#pragma unroll
                    for (int n = 0; n < 2; ++n) { f32x4* o = (f32x4*)(op + bj * HALF + n * 16); *o = *o + acc[ai][bj][m][n]; } }
    }
};
struct EpiUpHalf {
    static constexpr bool PERM = true;
    bf16_t* P; const float* ssq;
    __device__ __forceinline__ void operator()(const f32x4 (&acc)[2][2][4][2], const Unit& u, int wr, int wc, int fr, int fq) const {
        const int row0 = u.pm * BM + wr * 64 + fr, col0 = u.pn * BM + wc * 32 + 8 * fq;
#pragma unroll
        for (int ai = 0; ai < 2; ++ai)
#pragma unroll
            for (int m = 0; m < 4; ++m) { const int row = row0 + ai * HALF + m * 16; bf16_t* rowp = P + (size_t)row * DFF + col0;
                const f32x4* sp = (const f32x4*)(ssq + (size_t)row * 16); const f32x4 s4 = (sp[0] + sp[1]) + (sp[2] + sp[3]);
                const float rstd = 1.0f / sqrtf(((s4[0] + s4[1]) + (s4[2] + s4[3])) * (1.0f / D) + EPS);
#pragma unroll
                for (int bj = 0; bj < 2; ++bj) { const f32x4 v0 = acc[ai][bj][m][0] * rstd, v1 = acc[ai][bj][m][1] * rstd;
                    u32x4 w; w.x = cvt_pk_bf16(v0[0], v0[1]); w.y = cvt_pk_bf16(v0[2], v0[3]); w.z = cvt_pk_bf16(v1[0], v1[1]); w.w = cvt_pk_bf16(v1[2], v1[3]);
                    *(u32x4*)(rowp + bj * HALF) = w; } }
    }
};
struct EpiUpConv {
    static constexpr bool PERM = true;
    bf16_t* G; const float* ssq; const float* cw; const float* cb; float* edge; LAS unsigned char* xch;
    __device__ __forceinline__ void operator()(f32x4 (&acc)[2][2][4][2], const Unit& u, int wr, int wc, int fr, int fq) const {
        const int lane = fq * 16 + fr;
        float rs[2];
#pragma unroll
        for (int ai = 0; ai < 2; ++ai) { const unsigned row = (unsigned)(u.pm * BM + ai * HALF + wr * 64 + lane);
            const f32x4* sp = (const f32x4*)(ssq + row * 16u); const f32x4 s4 = (sp[0] + sp[1]) + (sp[2] + sp[3]);
            rs[ai] = 1.0f / sqrtf(((s4[0] + s4[1]) + (s4[2] + s4[3])) * (1.0f / D) + EPS); }
#pragma unroll
        for (int ai = 0; ai < 2; ++ai)
#pragma unroll
            for (int m = 0; m < 4; ++m) { const float rstd = __shfl(rs[ai], 16 * m + fr);
#pragma unroll
                for (int bj = 0; bj < 2; ++bj)
#pragma unroll
                    for (int n = 0; n < 2; ++n) acc[ai][bj][m][n] = acc[ai][bj][m][n] * rstd; }
        asm volatile("" ::: "memory");
        const int colw = wc * 32 + 8 * fq;
#pragma unroll
        for (int ai = 0; ai < 2; ++ai) { const int blk = 2 * ai + wr;
            if (fr == 0) {
#pragma unroll
                for (int bj = 0; bj < 2; ++bj)
#pragma unroll
                    for (int n = 0; n < 2; ++n) *(LAS f32x4*)(xch + ((0 * 4 + blk) * 256 + bj * 128 + colw + 4 * n) * 4) = acc[ai][bj][0][n]; }
            if (fr == 15) {
#pragma unroll
                for (int bj = 0; bj < 2; ++bj)
#pragma unroll
                    for (int n = 0; n < 2; ++n) *(LAS f32x4*)(xch + ((1 * 4 + blk) * 256 + bj * 128 + colw + 4 * n) * 4) = acc[ai][bj][3][n]; } }
        { float* eb = edge + (size_t)(u.pm * 22 + u.pn) * 4 * 256 + colw;
          if (wr == 0 && fr < 2) {
#pragma unroll
              for (int bj = 0; bj < 2; ++bj)
#pragma unroll
                  for (int n = 0; n < 2; ++n) *(f32x4*)(eb + fr * 256 + bj * 128 + 4 * n) = acc[0][bj][0][n]; }
          if (wr == 1 && fr >= 14) {
#pragma unroll
              for (int bj = 0; bj < 2; ++bj)
#pragma unroll
                  for (int n = 0; n < 2; ++n) *(f32x4*)(eb + (fr - 12) * 256 + bj * 128 + 4 * n) = acc[1][bj][3][n]; } }
        asm volatile("s_waitcnt lgkmcnt(0)" ::: "memory"); __builtin_amdgcn_s_barrier(); asm volatile("" ::: "memory");
        const int srcP = (lane & 48) | ((fr + 15) & 15), srcN = (lane & 48) | ((fr + 1) & 15);
        const int ch0 = u.pn * 128 + colw;
#pragma unroll
        for (int n = 0; n < 2; ++n)
#pragma unroll
            for (int bj = 0; bj < 2; ++bj) {
                const float* cwp = cw + bj * DFF + ch0 + 4 * n;
                const f32x4 w0 = *(const f32x4*)cwp, w1 = *(const f32x4*)(cwp + NUP), w2 = *(const f32x4*)(cwp + 2 * NUP), wb = *(const f32x4*)(cb + bj * DFF + ch0 + 4 * n);
#pragma unroll
                for (int ai = 0; ai < 2; ++ai) { const int blk = 2 * ai + wr;
                    f32x4 po = blk > 0 ? *(const LAS f32x4*)(xch + ((1 * 4 + blk - 1) * 256 + bj * 128 + colw + 4 * n) * 4) : (f32x4){0.f, 0.f, 0.f, 0.f};
                    const f32x4 en = blk < 3 ? *(const LAS f32x4*)(xch + ((0 * 4 + blk + 1) * 256 + bj * 128 + colw + 4 * n) * 4) : (f32x4){0.f, 0.f, 0.f, 0.f};
#pragma unroll
                    for (int m = 0; m < 4; ++m) {
                        const f32x4 cur = acc[ai][bj][m][n], nm1 = m < 3 ? acc[ai][bj][m < 3 ? m + 1 : 3][n] : en;
                        f32x4 pv, nv;
#pragma unroll
                        for (int e = 0; e < 4; ++e) { pv[e] = __shfl(fr == 15 ? po[e] : cur[e], srcP); nv[e] = __shfl(fr == 0 ? nm1[e] : cur[e], srcN); }
                        acc[ai][bj][m][n] = pv * w0 + cur * w1 + nv * w2 + wb;
                        asm volatile("" : "+v"(acc[ai][bj][m][n]));
                        po = cur;
                    } }
                asm volatile("" ::: "memory");
            }
#pragma unroll
        for (int ai = 0; ai < 2; ++ai)
#pragma unroll
            for (int m = 0; m < 4; ++m) { const unsigned row = (unsigned)(u.pm * BM + ai * HALF + wr * 64 + m * 16 + fr);
                const f32x4 ga = acc[ai][0][m][0], gb = acc[ai][0][m][1], ua = acc[ai][1][m][0], ub = acc[ai][1][m][1];
                u32x4 w; w.x = cvt_pk_bf16(gelu_tanh(ga[0]) * ua[0], gelu_tanh(ga[1]) * ua[1]); w.y = cvt_pk_bf16(gelu_tanh(ga[2]) * ua[2], gelu_tanh(ga[3]) * ua[3]);
                w.z = cvt_pk_bf16(gelu_tanh(gb[0]) * ub[0], gelu_tanh(gb[1]) * ub[1]); w.w = cvt_pk_bf16(gelu_tanh(gb[2]) * ub[2], gelu_tanh(gb[3]) * ub[3]);
                *(u32x4*)(G + (row * (unsigned)DFF + (unsigned)ch0)) = w;
                if (m & 1) asm volatile("" ::: "memory"); }
    }
};
}

__device__ __forceinline__ bf16x8 pack8(f32x4 a, f32x4 b) {
    u32x4 w; w.x = pg8::cvt_pk_bf16(a[0], a[1]); w.y = pg8::cvt_pk_bf16(a[2], a[3]); w.z = pg8::cvt_pk_bf16(b[0], b[1]); w.w = pg8::cvt_pk_bf16(b[2], b[3]);
    return __builtin_bit_cast(bf16x8, w);
}
__device__ __forceinline__ float bflo(unsigned w) { return __uint_as_float(w << 16); }
__device__ __forceinline__ float bfhi(unsigned w) { return __uint_as_float(w & 0xffff0000u); }

constexpr int WA_K = 0, WA_KP = 144, WA_VT = 384 * 144, WA_VP = 784, WA_BIAS = WA_VT + 64 * 784;
__device__ __forceinline__ void wattn_unit(const Args& a, LAS unsigned char* lds, int blk, int kvh, int tid, int wave, int lane) {
    bf16_t* proj = (bf16_t*)(a.ws + WS_PROJ);
    const int R0 = blk * 128, s0 = R0 < TP ? (R0 & ~(SEQP - 1)) : TP, S = R0 < TP ? SEQP : TP, n = (R0 - s0) >> 7, nb = S >> 7;
    const bool has_l = n > 0, has_r = n < nb - 1;
#pragma unroll
    for (int i = 0; i < 6; ++i) { const int qd = tid + 512 * i, w = qd >> 3, ch = qd & 7; const bool ok = (w >= 128 || has_l) && (w < 256 || has_r);
        u32x4 v = (u32x4){0u, 0u, 0u, 0u};
        if (ok) v = *(const u32x4*)(proj + (size_t)(R0 - 128 + w) * NPROJ + C_K + kvh * 64 + ch * 8);
        *(LAS u32x4*)(lds + WA_K + w * WA_KP + ch * 16) = v; }
#pragma unroll
    for (int i = 0; i < 3; ++i) { const int p = tid + 512 * i, w = (p >> 3) * 2, ch = p & 7; const bool ok = (w >= 128 || has_l) && (w < 256 || has_r);
        u32x4 v0 = (u32x4){0u, 0u, 0u, 0u}, v1 = v0;
        if (ok) { const bf16_t* vp = proj + (size_t)(R0 - 128 + w) * NPROJ + C_V + kvh * 64 + ch * 8; v0 = *(const u32x4*)vp; v1 = *(const u32x4*)(vp + NPROJ); }
#pragma unroll
        for (int e = 0; e < 4; ++e) { const unsigned x0 = v0[e], x1 = v1[e]; const int d = ch * 8 + 2 * e;
            *(LAS unsigned*)(lds + WA_VT + d * WA_VP + w * 2) = (x0 & 0xffffu) | (x1 << 16);
            *(LAS unsigned*)(lds + WA_VT + (d + 1) * WA_VP + w * 2) = (x0 >> 16) | (x1 & 0xffff0000u); } }
    for (int i = tid; i < 4 * 257; i += 512) { const int hh = i / 257, r = i - hh * 257; ((LAS float*)(lds + WA_BIAS))[hh * 260 + r] = a.in[4][t5_bucket(r - 128) * 8 + 4 * kvh + hh] * LOG2E; }
    __syncthreads();
    const int q = lane & 15, g = lane >> 4, hh = wave & 3, h = 4 * kvh + hh;
    const float sink2 = a.in[7][h] * LOG2E;
    const LAS float* btab = (const LAS float*)(lds + WA_BIAS) + hh * 260;
    const LAS unsigned char* kbase = lds + WA_K + (8 * (q >> 2) + (q & 3)) * WA_KP + g * 16;
    const LAS unsigned char* vbase = lds + WA_VT + q * WA_VP + g * 16;
#pragma unroll 1
    for (int j = 0; j < 4; ++j) {
        const int i0 = 16 * ((wave >> 2) + 2 * j);
        bf16_t* qp = proj + (size_t)(R0 + i0 + q) * NPROJ + C_Q + h * 64 + 8 * g;
        const bf16x8 qf0 = *(const bf16x8*)qp, qf1 = *(const bf16x8*)(qp + 32);
        f32x4 sc[24];
#pragma unroll
        for (int t = 0; t < 24; ++t) {
            const bf16x8 k0 = *(const LAS bf16x8*)(kbase + (t >> 1) * 32 * WA_KP + (t & 1) * 4 * WA_KP), k1 = *(const LAS bf16x8*)(kbase + (t >> 1) * 32 * WA_KP + (t & 1) * 4 * WA_KP + 64);
            f32x4 z = (f32x4){0.f, 0.f, 0.f, 0.f};
            z = __builtin_amdgcn_mfma_f32_16x16x32_bf16(k0, qf0, z, 0, 0, 0); sc[t] = __builtin_amdgcn_mfma_f32_16x16x32_bf16(k1, qf1, z, 0, 0, 0); }
        const int iq = i0 + q; float mx = -1.0e30f;
        const int relb = 8 * g - 128 - iq;
#pragma unroll
        for (int t = 0; t < 24; ++t)
#pragma unroll
            for (int r = 0; r < 4; ++r) { const int wofs = 32 * (t >> 1) + 4 * (t & 1) + r, rel = relb + wofs, w = 8 * g + wofs;
                const bool ok = rel >= -128 && rel <= 128 && (w >= 128 || has_l) && (w < 256 || has_r);
                const int bi = min(max(rel + 128, 0), 256);
                const float v = ok ? sc[t][r] + btab[bi] : -1.0e30f; sc[t][r] = v; mx = fmaxf(mx, v); }
        mx = fmaxf(mx, __shfl_xor(mx, 16)); mx = fmaxf(mx, __shfl_xor(mx, 32)); mx = fmaxf(mx, sink2);
        float sum = 0.f;
#pragma unroll
        for (int t = 0; t < 24; ++t)
#pragma unroll
            for (int r = 0; r < 4; ++r) { const float p = __builtin_amdgcn_exp2f(sc[t][r] - mx); sc[t][r] = p; sum += p; }
        sum += __shfl_xor(sum, 16); sum += __shfl_xor(sum, 32);
        const float inv = 1.0f / (sum + __builtin_amdgcn_exp2f(sink2 - mx));
        f32x4 o[4];
#pragma unroll
        for (int dt = 0; dt < 4; ++dt) o[dt] = (f32x4){0.f, 0.f, 0.f, 0.f};
#pragma unroll
        for (int c = 0; c < 12; ++c) { const bf16x8 pf = pack8(sc[2 * c], sc[2 * c + 1]);
#pragma unroll
            for (int dt = 0; dt < 4; ++dt) { const bf16x8 vf = *(const LAS bf16x8*)(vbase + dt * 16 * WA_VP + c * 64);
                o[dt] = __builtin_amdgcn_mfma_f32_16x16x32_bf16(pf, vf, o[dt], 0, 0, 0); } }
#pragma unroll
        for (int r = 0; r < 4; ++r) { const float ir = __shfl(inv, 4 * g + r); bf16_t* op = proj + (size_t)(R0 + i0 + 4 * g + r) * NPROJ + C_Q + h * 64 + q;
#pragma unroll
            for (int dt = 0; dt < 4; ++dt) op[16 * dt] = (bf16_t)f2bf(o[dt][r] * ir); }
    }
    __syncthreads();
}

constexpr int MA_K = 0, MA_KP = 272, MA_VT = 256 * 272, MA_VP = 528;
__device__ __forceinline__ void mattn_unit(const Args& a, LAS unsigned char* lds, int tile, int hm, int tid, int wave, int lane) {
    bf16_t* proj = (bf16_t*)(a.ws + WS_PROJ); const bf16_t* mkv = (const bf16_t*)(a.ws + WS_MKV);
    const int R0 = tile * 512, b = R0 < TP ? R0 / SEQP : 8;
    const bf16_t* kb = mkv + (size_t)b * 256 * 1024 + hm * 128; const bf16_t* vb = kb + 512;
#pragma unroll
    for (int i = 0; i < 8; ++i) { const int qd = tid + 512 * i, w = qd >> 4, ch = qd & 15;
        *(LAS u32x4*)(lds + MA_K + w * MA_KP + ch * 16) = *(const u32x4*)(kb + (size_t)w * 1024 + ch * 8); }
#pragma unroll
    for (int i = 0; i < 4; ++i) { const int p = tid + 512 * i, w = (p >> 4) * 2, ch = p & 15;
        const u32x4 v0 = *(const u32x4*)(vb + (size_t)w * 1024 + ch * 8), v1 = *(const u32x4*)(vb + (size_t)(w + 1) * 1024 + ch * 8);
#pragma unroll
        for (int e = 0; e < 4; ++e) { const unsigned x0 = v0[e], x1 = v1[e]; const int d = ch * 8 + 2 * e;
            *(LAS unsigned*)(lds + MA_VT + d * MA_VP + w * 2) = (x0 & 0xffffu) | (x1 << 16);
            *(LAS unsigned*)(lds + MA_VT + (d + 1) * MA_VP + w * 2) = (x0 >> 16) | (x1 & 0xffff0000u); } }
    __syncthreads();
    const int q = lane & 15, g = lane >> 4;
    const LAS unsigned char* kbase = lds + MA_K + (8 * (q >> 2) + (q & 3)) * MA_KP + g * 16;
    const LAS unsigned char* vbase = lds + MA_VT + q * MA_VP + g * 16;
#pragma unroll 1
    for (int j = 0; j < 4; ++j) {
        const int i0 = 16 * (wave + 8 * j);
        bf16_t* qp = proj + (size_t)(R0 + i0 + q) * NPROJ + C_QM + hm * 128 + 8 * g;
        bf16x8 qf[4];
#pragma unroll
        for (int ks = 0; ks < 4; ++ks) qf[ks] = *(const bf16x8*)(qp + 32 * ks);
        f32x4 sc[16];
#pragma unroll
        for (int t = 0; t < 16; ++t) {
            f32x4 z = (f32x4){0.f, 0.f, 0.f, 0.f};
#pragma unroll
            for (int ks = 0; ks < 4; ++ks) { const bf16x8 kf = *(const LAS bf16x8*)(kbase + (t >> 1) * 32 * MA_KP + (t & 1) * 4 * MA_KP + ks * 64); z = __builtin_amdgcn_mfma_f32_16x16x32_bf16(kf, qf[ks], z, 0, 0, 0); }
            sc[t] = z; }
        float mx = -1.0e30f;
#pragma unroll
        for (int t = 0; t < 16; ++t)
#pragma unroll
            for (int r = 0; r < 4; ++r) mx = fmaxf(mx, sc[t][r]);
        mx = fmaxf(mx, __shfl_xor(mx, 16)); mx = fmaxf(mx, __shfl_xor(mx, 32));
        float sum = 0.f;
#pragma unroll
        for (int t = 0; t < 16; ++t)
#pragma unroll
            for (int r = 0; r < 4; ++r) { const float p = __builtin_amdgcn_exp2f(sc[t][r] - mx); sc[t][r] = p; sum += p; }
        sum += __shfl_xor(sum, 16); sum += __shfl_xor(sum, 32);
        const float inv = 1.0f / sum;
        f32x4 o[8];
#pragma unroll
        for (int dt = 0; dt < 8; ++dt) o[dt] = (f32x4){0.f, 0.f, 0.f, 0.f};
#pragma unroll
        for (int c = 0; c < 8; ++c) { const bf16x8 pf = pack8(sc[2 * c], sc[2 * c + 1]);
#pragma unroll
            for (int dt = 0; dt < 8; ++dt) { const bf16x8 vf = *(const LAS bf16x8*)(vbase + dt * 16 * MA_VP + c * 64);
                o[dt] = __builtin_amdgcn_mfma_f32_16x16x32_bf16(pf, vf, o[dt], 0, 0, 0); } }
#pragma unroll
        for (int r = 0; r < 4; ++r) { const float ir = __shfl(inv, 4 * g + r); bf16_t* op = proj + (size_t)(R0 + i0 + 4 * g + r) * NPROJ + C_QM + hm * 128 + q;
#pragma unroll
            for (int dt = 0; dt < 8; ++dt) op[16 * dt] = (bf16_t)f2bf(o[dt][r] * ir); }
    }
    __syncthreads();
}

constexpr int SG_P = 272;
__device__ __forceinline__ void sgu_unit(const Args& a, LAS unsigned char* lds, int chunk, int tid, int wave, int lane) {
    bf16_t* proj = (bf16_t*)(a.ws + WS_PROJ); const bf16_t* wsb = (const bf16_t*)(a.ws + WS_SGUW);
    const int R0 = chunk * 128;
    {
        const int tp = tid >> 3, part = tid & 7, t0 = 2 * tp;
        const bf16_t* v0p = proj + (size_t)(R0 + t0) * NPROJ + C_SV + part * 64; const bf16_t* v1p = v0p + NPROJ;
        u32x4 x0[8], x1[8]; float s0 = 0.f, s1 = 0.f;
#pragma unroll
        for (int i = 0; i < 8; ++i) { x0[i] = ((const u32x4*)v0p)[i]; x1[i] = ((const u32x4*)v1p)[i]; }
#pragma unroll
        for (int i = 0; i < 8; ++i)
#pragma unroll
            for (int e = 0; e < 4; ++e) { s0 += bflo(x0[i][e]) + bfhi(x0[i][e]); s1 += bflo(x1[i][e]) + bfhi(x1[i][e]); }
        s0 += __shfl_xor(s0, 1); s0 += __shfl_xor(s0, 2); s0 += __shfl_xor(s0, 4); s1 += __shfl_xor(s1, 1); s1 += __shfl_xor(s1, 2); s1 += __shfl_xor(s1, 4);
        const float mu0 = s0 * (1.0f / 512.0f), mu1 = s1 * (1.0f / 512.0f); float q0 = 0.f, q1 = 0.f;
#pragma unroll
        for (int i = 0; i < 8; ++i)
#pragma unroll
            for (int e = 0; e < 4; ++e) { float d;
                d = bflo(x0[i][e]) - mu0; q0 += d * d; d = bfhi(x0[i][e]) - mu0; q0 += d * d; d = bflo(x1[i][e]) - mu1; q1 += d * d; d = bfhi(x1[i][e]) - mu1; q1 += d * d; }
        q0 += __shfl_xor(q0, 1); q0 += __shfl_xor(q0, 2); q0 += __shfl_xor(q0, 4); q1 += __shfl_xor(q1, 1); q1 += __shfl_xor(q1, 2); q1 += __shfl_xor(q1, 4);
        const float r0 = 1.0f / sqrtf(q0 * (1.0f / 512.0f) + EPS), r1 = 1.0f / sqrtf(q1 * (1.0f / 512.0f) + EPS);
        const float* lng = a.in[10] + part * 64; const float* lnb = a.in[11] + part * 64;
        LAS unsigned char* wb0 = lds + (part * 64) * SG_P + t0 * 2;
#pragma unroll
        for (int i = 0; i < 8; ++i)
#pragma unroll
            for (int e = 0; e < 4; ++e) {
                const int cl = 8 * i + 2 * e;
                const float ga = lng[cl], ba = lnb[cl], gb = lng[cl + 1], bb = lnb[cl + 1];
                const unsigned wa = pg8::cvt_pk_bf16((bflo(x0[i][e]) - mu0) * r0 * ga + ba, (bflo(x1[i][e]) - mu1) * r1 * ga + ba);
                const unsigned wb = pg8::cvt_pk_bf16((bfhi(x0[i][e]) - mu0) * r0 * gb + bb, (bfhi(x1[i][e]) - mu1) * r1 * gb + bb);
                *(LAS unsigned*)(wb0 + cl * SG_P) = wa;
                *(LAS unsigned*)(wb0 + (cl + 1) * SG_P) = wb; }
    }
    __syncthreads();
    {
        const int cl = lane & 15, g4 = lane >> 4, grp = wave >> 1, cbase = grp * 128 + (wave & 1) * 64;
        const LAS unsigned char* abase = lds + (cbase + cl) * SG_P + g4 * 16;
        const float* bs = a.in[9] + grp * 128;
#pragma unroll 1
        for (int th = 0; th < 2; ++th) {
            const bf16_t* wbase = wsb + (size_t)(grp * 128 + 64 * th + cl) * 128 + 8 * g4;
            f32x4 acc[4][4];
#pragma unroll
            for (int ct = 0; ct < 4; ++ct)
#pragma unroll
                for (int it = 0; it < 4; ++it) acc[ct][it] = (f32x4){0.f, 0.f, 0.f, 0.f};
#pragma unroll
            for (int kc = 0; kc < 4; ++kc) {
                bf16x8 af[4], wf[4];
#pragma unroll
                for (int ct = 0; ct < 4; ++ct) af[ct] = *(const LAS bf16x8*)(abase + ct * 16 * SG_P + kc * 64);
#pragma unroll
                for (int it = 0; it < 4; ++it) wf[it] = *(const bf16x8*)(wbase + it * 16 * 128 + kc * 32);
#pragma unroll
                for (int ct = 0; ct < 4; ++ct)
#pragma unroll
                    for (int it = 0; it < 4; ++it) acc[ct][it] = __builtin_amdgcn_mfma_f32_16x16x32_bf16(af[ct], wf[it], acc[ct][it], 0, 0, 0);
            }
#pragma unroll
            for (int it = 0; it < 4; ++it) { const int i = 64 * th + 16 * it + cl; const float bi = bs[i];
#pragma unroll
                for (int ct = 0; ct < 4; ++ct) { bf16_t* up = proj + (size_t)(R0 + i) * NPROJ + C_U + cbase + 16 * ct + 4 * g4;
                    const unsigned long long uw = *(const unsigned long long*)up; const unsigned ulo = (unsigned)uw, uhi = (unsigned)(uw >> 32);
                    const f32x4 sv = acc[ct][it];
                    const unsigned lo = pg8::cvt_pk_bf16(bflo(ulo) * (sv[0] + bi), bfhi(ulo) * (sv[1] + bi)), hi = pg8::cvt_pk_bf16(bflo(uhi) * (sv[2] + bi), bfhi(uhi) * (sv[3] + bi));
                    *(unsigned long long*)up = (unsigned long long)lo | ((unsigned long long)hi << 32); } }
        }
    }
    __syncthreads();
}
__device__ __forceinline__ void mix_phase(const Args& a, LAS unsigned char* lds, int tid, int wave, int lane) {
    const int G = gridDim.x, bx = blockIdx.x, vcu = (G % 8 == 0) ? (bx % 8) * (G / 8) + bx / 8 : bx;
    for (int u = vcu; u < 256; u += G) { wattn_unit(a, lds, u, 0, tid, wave, lane); wattn_unit(a, lds, u, 1, tid, wave, lane); }
    for (int u = vcu; u < 256; u += G) mattn_unit(a, lds, u >> 2, u & 3, tid, wave, lane);
    for (int u = vcu; u < 256; u += G) sgu_unit(a, lds, u, tid, wave, lane);
}

__device__ __forceinline__ void ffn_edge_fix(const Args& a, int pm, int tid) {
    const float* edge = (const float*)(a.ws + WS_EDGE); bf16_t* G = (bf16_t*)(a.ws + WS_G); const float* cw = a.in[20]; const float* cb = a.in[21];
    const bool sstart = pm < 64 ? (pm & 7) == 0 : pm == 64, send = pm < 64 ? (pm & 7) == 7 : pm == 127;
    for (int idx = tid; idx < 2 * DFF; idx += NTHREADS) {
        const int bot = idx >= DFF, ch = bot ? idx - DFF : idx, j = ch >> 7, cl = ch & 127;
        const float* e0 = edge + (size_t)(pm * 22 + j) * 1024 + cl;
        float pg, pu, cg, cu, ng, nu;
        if (!bot) { cg = e0[0]; cu = e0[128]; ng = e0[256]; nu = e0[256 + 128];
            if (sstart) { pg = 0.f; pu = 0.f; } else { const float* ep = e0 - 22 * 1024 + 3 * 256; pg = ep[0]; pu = ep[128]; } }
        else { pg = e0[512]; pu = e0[512 + 128]; cg = e0[768]; cu = e0[768 + 128];
            if (send) { ng = 0.f; nu = 0.f; } else { const float* en = e0 + 22 * 1024; ng = en[0]; nu = en[128]; } }
        const float ga = pg * cw[ch] + cg * cw[NUP + ch] + ng * cw[2 * NUP + ch] + cb[ch];
        const float ua = pu * cw[DFF + ch] + cu * cw[NUP + DFF + ch] + nu * cw[2 * NUP + DFF + ch] + cb[DFF + ch];
        G[(size_t)(pm * 256 + (bot ? 255 : 0)) * DFF + ch] = (bf16_t)f2bf(gelu_tanh(ga) * ua);
    }
}

enum { PH_PRO = 0, PH_PROJ, PH_MIX, PH_MIX2, PH_SGU, PH_BR, PH_OUTP, PH_SSQ, PH_UP0, PH_CONV0, PH_UP1, PH_CONV1, PH_DOWN, PH_FINAL, PH_N };

__global__ void __launch_bounds__(NTHREADS, 2) fwd(Args a) {
    extern __shared__ __attribute__((aligned(16))) unsigned char lds_raw[];
    LAS unsigned char* lds = (LAS unsigned char*)lds_raw;
    cg::grid_group grid = cg::this_grid();
    Ctx c; c.tid = threadIdx.x; c.lane = c.tid & 63; c.wave = __builtin_amdgcn_readfirstlane(c.tid >> 6);
    c.gw = blockIdx.x * NWAVES + c.wave; c.ngw = gridDim.x * NWAVES; c.gtid = blockIdx.x * NTHREADS + c.tid; c.ngt = gridDim.x * NTHREADS;
    unsigned char* ws = a.ws;
    p0_prologue(a, c, lds);
    grid.sync();
    {
        pg8::SchedPlain S; S.o.init(T / 256, NPROJ / 256, (int)gridDim.x, (int)blockIdx.x); S.A = (const char*)(ws + WS_H); S.B = (const char*)(ws + WS_WIN); S.strideA = (size_t)256 * D * 2; S.strideB = (size_t)256 * D * 2;
        pg8::EpiProj E{(bf16_t*)(ws + WS_PROJ)};
        pg8::gemm_phase(lds, D, D, S, E);
        pg8::SchedOne S2; S2.idx = ((int)blockIdx.x >= 128 && (int)blockIdx.x < 128 + 36) ? (int)blockIdx.x - 128 : -1; S2.nN = 4;
        S2.A = (const char*)(ws + WS_MEMN); S2.B = (const char*)(ws + WS_WMKV); S2.strideA = (size_t)256 * D * 2; S2.strideB = (size_t)256 * D * 2;
        pg8::EpiPlain E2{(bf16_t*)(ws + WS_MKV), 1024};
        pg8::gemm_phase(lds, D, D, S2, E2);
    }
    grid.sync();
    mix_phase(a, lds, c.tid, c.wave, c.lane);
    grid.sync();
    {
        pg8::SchedBranch S; S.o.init(T / 256, 4, (int)gridDim.x, (int)blockIdx.x, 3); S.proj = (const char*)(ws + WS_PROJ); S.wbr = (const char*)(ws + WS_WBR);
        pg8::EpiBranch E{(const bf16_t*)(ws + WS_PROJ), (bf16_t*)(ws + WS_H)};
        pg8::gemm_phase(lds, 512, NPROJ, S, E);
    }
    grid.sync();
    {
        pg8::SchedPlain S; S.o.init(T / 256, 4, (int)gridDim.x, (int)blockIdx.x); S.A = (const char*)(ws + WS_H); S.B = (const char*)(ws + WS_WOUT); S.strideA = (size_t)256 * D * 2; S.strideB = (size_t)256 * D * 2;
        pg8::EpiOut E{a.in[0], a.in[1], a.out, (bf16_t*)(ws + WS_H2), (float*)(ws + WS_SSQ1)};
        pg8::gemm_phase(lds, D, D, S, E);
    }
    grid.sync();
    {
        pg8::SchedPlain S; S.o.init(T / 256, 22, (int)gridDim.x, (int)blockIdx.x); S.A = (const char*)(ws + WS_H2); S.B = (const char*)(ws + WS_WUP); S.strideA = (size_t)256 * D * 2; S.strideB = (size_t)256 * D * 2;
        pg8::EpiUpConv E{(bf16_t*)(ws + WS_G), (const float*)(ws + WS_SSQ1), a.in[20], a.in[21], (float*)(ws + WS_EDGE), lds + 131072};
        pg8::gemm_phase(lds, D, D, S, E);
    }
    grid.sync();
    {
        pg8::SchedPlain S; S.o.init(T / 256, 4, (int)gridDim.x, (int)blockIdx.x); S.A = (const char*)(ws + WS_G); S.B = (const char*)(ws + WS_WDN); S.strideA = (size_t)256 * DFF * 2; S.strideB = (size_t)256 * DFF * 2;
        { int pm, pn, aux; for (int i = 0; S.o.tile(i, pm, pn, aux); ++i) ffn_edge_fix(a, pm, c.tid); }
        asm volatile("s_waitcnt vmcnt(0)" ::: "memory"); __syncthreads();
        pg8::EpiDown E{a.out};
        pg8::gemm_phase(lds, DFF, DFF, S, E);
    }
    grid.sync();
    final_norm(a, c);
}

extern "C" void kernel_launch(void* const* d_in, const int* in_sizes, int n_in, void* d_out, int out_size, void* d_ws, size_t ws_size, hipStream_t stream) {
    static int grid = 0;
    if (grid == 0) {
        if (n_in != 24 || out_size != T * D || ws_size < WS_END) { fprintf(stderr, "kernel_launch: unexpected shapes (n_in %d, out %d, ws %zu)\n", n_in, out_size, ws_size); grid = -1; return; }
        int dev = 0, cus = 0, per_cu = 0;
        (void)hipGetDevice(&dev); (void)hipDeviceGetAttribute(&cus, hipDeviceAttributeMultiprocessorCount, dev);
        (void)hipFuncSetAttribute((const void*)fwd, hipFuncAttributeMaxDynamicSharedMemorySize, LDS_BYTES);
        if (hipOccupancyMaxActiveBlocksPerMultiprocessor(&per_cu, (const void*)fwd, NTHREADS, LDS_BYTES) != hipSuccess || per_cu < 1) { fprintf(stderr, "kernel_launch: occupancy query says %d blocks/CU\n", per_cu); (void)hipGetLastError(); grid = -1; return; }
        grid = cus * 1;
    }
    if (grid < 0) return;
    Args a{};
    for (int i = 0; i < 24; ++i) a.in[i] = (const float*)d_in[i];
    a.out = (float*)d_out; a.ws = (unsigned char*)d_ws;
    void* kargs[] = {&a};
    hipError_t e = hipLaunchCooperativeKernel((const void*)fwd, dim3(grid), dim3(NTHREADS), kargs, LDS_BYTES, stream);
    if (e != hipSuccess) fprintf(stderr, "cooperative launch failed: %s (grid %d)\n", hipGetErrorString(e), grid);
}
```

```cpp
#include <hip/hip_runtime.h>
#include <hip/hip_cooperative_groups.h>
namespace cg = cooperative_groups;
#include <cstdio>
#include <cstdint>

typedef unsigned short bf16_t;
typedef short bf16x8 __attribute__((ext_vector_type(8)));
typedef float f32x4 __attribute__((ext_vector_type(4)));
typedef unsigned u32x4 __attribute__((ext_vector_type(4)));
#define LAS __attribute__((address_space(3)))

constexpr int D = 1024, TP = 16384, T = 32768, SEQP = 2048;
constexpr int NPROJ = 5376, DFF = 2816, NUP = 5632, MEMROWS = 2304;
constexpr int C_Q = 0, C_K = 512, C_V = 640, C_U = 768, C_SV = 1280, C_QM = 1792, C_G = 2304;
constexpr float EPS = 1e-6f, LOG2E = 1.4426950408889634f;
constexpr float QSCALE = 0.125f * LOG2E, MSCALE = 0.08838834764831845f * LOG2E;
constexpr int NTHREADS = 512, NWAVES = 8;

constexpr size_t MiB = 1u << 20;
constexpr size_t WS_CTL = 0;
constexpr size_t WS_WIN = 2 * MiB;
constexpr size_t WS_WMKV = 13 * MiB;
constexpr size_t WS_WBR = 15 * MiB;
constexpr size_t WS_WOUT = 18 * MiB;
constexpr size_t WS_WUP = 20 * MiB;
constexpr size_t WS_WDN = 31 * MiB;
constexpr size_t WS_SGUW = 37 * MiB;
constexpr size_t WS_MEMN = 38 * MiB;
constexpr size_t WS_MKV = 43 * MiB;
constexpr size_t WS_SSQ1 = 48 * MiB;
constexpr size_t WS_STAT = 50 * MiB;
constexpr size_t WS_H = 52 * MiB;
constexpr size_t WS_PROJ = 116 * MiB;
constexpr size_t WS_AUP = 52 * MiB;
constexpr size_t WS_G = 228 * MiB;
constexpr size_t WS_EDGE = 404 * MiB;
constexpr size_t WS_H2 = 448 * MiB;
constexpr size_t WS_END = 512 * MiB;

constexpr int LDS_BYTES = 147456, MISC_OFF = 147456 - 256;

__device__ __forceinline__ float bf2f(bf16_t v) { return __uint_as_float((unsigned)v << 16); }
__device__ __forceinline__ unsigned f2bf(float f) { unsigned u = __float_as_uint(f); return (u + 0x7fffu + ((u >> 16) & 1u)) >> 16; }
__device__ __forceinline__ unsigned pk2(float lo, float hi) { return f2bf(lo) | (f2bf(hi) << 16); }
__device__ __forceinline__ float gelu_tanh(float x) {
    const float u = x * (1.0f + 0.044715f * x * x) * (2.0f * 0.7978845608028654f * LOG2E);
    return x * __builtin_amdgcn_rcpf(1.0f + __builtin_amdgcn_exp2f(-u));
}
__device__ __forceinline__ float sigmoid_f(float x) { return __builtin_amdgcn_rcpf(1.0f + __builtin_amdgcn_exp2f(-x * LOG2E)); }
__device__ __forceinline__ float wave_sum(float v) {
#pragma unroll
    for (int o = 1; o < 64; o <<= 1) v += __shfl_xor(v, o);
    return v;
}
__device__ __forceinline__ int t5_bucket(int rel) {
    const int n = rel < 0 ? -rel : rel; const int ret = rel > 0 ? 16 : 0;
    if (n < 8) return ret + n;
    int l = (31 - __builtin_clz((unsigned)(n * n))) + 2; if (l > 15) l = 15;
    return ret + l;
}

struct Args {
    const float* in[24];
    float* out; unsigned char* ws;
    int coop_sync, pad;
};

struct Ctx { int tid, lane, wave, gw, ngw, gtid, ngt; };

__device__ __forceinline__ const float* xrow(const Args& a, int r) { return r < TP ? a.in[0] + (size_t)r * D : a.in[1] + (size_t)(r - TP) * D; }
__device__ __forceinline__ const float* memrow(const Args& a, int r) { return r < 2048 ? a.in[2] + (size_t)r * D : a.in[3] + (size_t)(r - 2048) * D; }

__device__ __forceinline__ void tr_item(const float* W, int K, int N, bf16_t* WT, const float* ks, int upmap, LAS float* scr, int item, int lane) {
    const int nblk = N / 32, kb = item / nblk, nb = item % nblk, k0 = 64 * kb, n0 = 32 * nb;
#pragma unroll 8
    for (int i = 0; i < 32; ++i) { const int kk = 2 * i + (lane >> 5); float v = W[(size_t)(k0 + kk) * N + n0 + (lane & 31)]; if (ks) v *= ks[k0 + kk]; scr[kk * 33 + (lane & 31)] = v; }
    asm volatile("s_waitcnt lgkmcnt(0)" ::: "memory");
    int r0 = n0;
    if (upmap) { if (n0 < DFF) r0 = 256 * (n0 / 128) + (n0 % 128); else { const int m = n0 - DFF; r0 = 256 * (m / 128) + 128 + (m % 128); } }
    const int c = lane & 7;
#pragma unroll
    for (int j = 0; j < 4; ++j) { const int n = (lane >> 3) + 8 * j; const LAS float* s = scr + (8 * c) * 33 + n;
        u32x4 o; o.x = pk2(s[0 * 33], s[1 * 33]); o.y = pk2(s[2 * 33], s[3 * 33]); o.z = pk2(s[4 * 33], s[5 * 33]); o.w = pk2(s[6 * 33], s[7 * 33]);
        *(u32x4*)(WT + (size_t)(r0 + n) * K + k0 + 8 * c) = o; }
    asm volatile("s_waitcnt lgkmcnt(0)" ::: "memory");
}
__device__ __forceinline__ void rms_row_to_bf16(const float* xr, const float* g, bf16_t* orow, int lane) {
    f32x4 v[4]; float s = 0.f;
#pragma unroll
    for (int j = 0; j < 4; ++j) { v[j] = ((const f32x4*)xr)[lane + 64 * j]; s += (v[j].x * v[j].x + v[j].y * v[j].y) + (v[j].z * v[j].z + v[j].w * v[j].w); }
    const float rstd = 1.0f / sqrtf(wave_sum(s) * (1.0f / D) + EPS);
#pragma unroll
    for (int j = 0; j < 4; ++j) { const f32x4 gg = ((const f32x4*)g)[lane + 64 * j];
        const unsigned lo = pk2(v[j].x * rstd * gg.x, v[j].y * rstd * gg.y), hi = pk2(v[j].z * rstd * gg.z, v[j].w * rstd * gg.w);
        ((unsigned long long*)orow)[lane + 64 * j] = (unsigned long long)lo | ((unsigned long long)hi << 32); }
}
__device__ __forceinline__ void p0_prologue(const Args& a, const Ctx& c, LAS unsigned char* lds) {
    LAS float* scr = (LAS float*)(lds + c.wave * 16384);
    unsigned char* ws = a.ws;
    constexpr int I_IN = 16 * (NPROJ / 32), I_MKV = 16 * 32, I_BR = 8 * 32, I_OUT = 16 * 32, I_UP = 16 * (NUP / 32), I_DN = (DFF / 64) * 32;
    constexpr int NITEMS = I_IN + I_MKV + 3 * I_BR + I_OUT + I_UP + I_DN;
    for (int it = c.gw; it < NITEMS; it += c.ngw) {
        int r = it;
        if (r < I_IN) { tr_item(a.in[6], D, NPROJ, (bf16_t*)(ws + WS_WIN), nullptr, 0, scr, r, c.lane); continue; } r -= I_IN;
        if (r < I_MKV) { tr_item(a.in[13], D, 1024, (bf16_t*)(ws + WS_WMKV), nullptr, 0, scr, r, c.lane); continue; } r -= I_MKV;
        if (r < I_BR) { tr_item(a.in[14], 512, 1024, (bf16_t*)(ws + WS_WBR), nullptr, 0, scr, r, c.lane); continue; } r -= I_BR;
        if (r < I_BR) { tr_item(a.in[15], 512, 1024, (bf16_t*)(ws + WS_WBR + 1 * MiB), nullptr, 0, scr, r, c.lane); continue; } r -= I_BR;
        if (r < I_BR) { tr_item(a.in[16], 512, 1024, (bf16_t*)(ws + WS_WBR + 2 * MiB), nullptr, 0, scr, r, c.lane); continue; } r -= I_BR;
        if (r < I_OUT) { tr_item(a.in[17], D, 1024, (bf16_t*)(ws + WS_WOUT), nullptr, 0, scr, r, c.lane); continue; } r -= I_OUT;
        if (r < I_UP) { tr_item(a.in[19], D, NUP, (bf16_t*)(ws + WS_WUP), a.in[18], 1, scr, r, c.lane); continue; } r -= I_UP;
        tr_item(a.in[22], DFF, 1024, (bf16_t*)(ws + WS_WDN), nullptr, 0, scr, r, c.lane);
    }
    { bf16_t* o = (bf16_t*)(ws + WS_SGUW); const float* w = a.in[8];
      for (int i = c.gtid; i < 4 * 128 * 128 / 2; i += c.ngt) ((unsigned*)o)[i] = pk2(w[2 * i], w[2 * i + 1]); }
    for (int m = c.gw; m < T; m += c.ngw) rms_row_to_bf16(xrow(a, m), a.in[5], (bf16_t*)(ws + WS_H) + (size_t)m * D, c.lane);
    for (int m = c.gw; m < MEMROWS; m += c.ngw) rms_row_to_bf16(memrow(a, m), a.in[12], (bf16_t*)(ws + WS_MEMN) + (size_t)m * D, c.lane);
}

__device__ __forceinline__ void wt_mma(f32x4 (&acc)[4][4], const bf16_t* A, int lda, const bf16_t* B, int ldb, int K, int lane) {
    const bf16_t* a0 = A + (size_t)(lane & 15) * lda + 8 * (lane >> 4);
    const bf16_t* b0 = B + (size_t)(lane & 15) * ldb + 8 * (lane >> 4);
    for (int k = 0; k < K; k += 32) {
        bf16x8 af[4], bfr[4];
#pragma unroll
        for (int i = 0; i < 4; ++i) { af[i] = *(const bf16x8*)(a0 + (size_t)i * 16 * lda + k); bfr[i] = *(const bf16x8*)(b0 + (size_t)i * 16 * ldb + k); }
#pragma unroll
        for (int i = 0; i < 4; ++i)
#pragma unroll
            for (int j = 0; j < 4; ++j) acc[i][j] = __builtin_amdgcn_mfma_f32_16x16x32_bf16(af[i], bfr[j], acc[i][j], 0, 0, 0);
    }
}
__device__ __forceinline__ void zero_acc(f32x4 (&acc)[4][4]) {
#pragma unroll
    for (int i = 0; i < 4; ++i)
#pragma unroll
        for (int j = 0; j < 4; ++j) acc[i][j] = (f32x4){0.f, 0.f, 0.f, 0.f};
}
template <class Epi>
__device__ __forceinline__ void sgemm_phase(const bf16_t* A, int lda, const bf16_t* Bt, int ldb, int M, int N, int K, const Epi& epi, const Ctx& c) {
    const int nN = N / 64, ntask = (M / 64) * nN;
    for (int t = c.gw; t < ntask; t += c.ngw) {
        const int tm = t / nN, tn = t % nN;
        f32x4 acc[4][4]; zero_acc(acc);
        wt_mma(acc, A + (size_t)tm * 64 * lda, lda, Bt + (size_t)tn * 64 * ldb, ldb, K, c.lane);
#pragma unroll
        for (int i = 0; i < 4; ++i)
#pragma unroll
            for (int r = 0; r < 4; ++r) { const int row = tm * 64 + 16 * i + 4 * (c.lane >> 4) + r; const float rs = epi.rowpre(row);
#pragma unroll
                for (int j = 0; j < 4; ++j) epi(row, tn * 64 + 16 * j + (c.lane & 15), acc[i][j][r] * rs); }
    }
}

struct EpiProjN { bf16_t* P;
    __device__ __forceinline__ float rowpre(int) const { return 1.0f; }
    __device__ __forceinline__ void operator()(int r, int col, float v) const {
        float o;
        if (col < C_K) o = v * QSCALE; else if (col < C_U) o = v; else if (col < C_QM) o = gelu_tanh(v); else if (col < C_G) o = v * MSCALE; else o = sigmoid_f(v);
        P[(size_t)r * NPROJ + col] = (bf16_t)f2bf(o); } };
struct EpiBf16N { bf16_t* P; int ldc;
    __device__ __forceinline__ float rowpre(int) const { return 1.0f; }
    __device__ __forceinline__ void operator()(int r, int col, float v) const { P[(size_t)r * ldc + col] = (bf16_t)f2bf(v); } };
struct EpiOutN { const Args* a; bf16_t* H2;
    __device__ __forceinline__ float rowpre(int) const { return 1.0f; }
    __device__ __forceinline__ void operator()(int r, int col, float v) const { const float x1 = xrow(*a, r)[col] + v; a->out[(size_t)r * D + col] = x1; H2[(size_t)r * D + col] = (bf16_t)f2bf(x1); } };
struct EpiUpN { bf16_t* AUP; const float* ssq;
    __device__ __forceinline__ float rowpre(int r) const {
        float s = 0.f;
#pragma unroll
        for (int i = 0; i < 16; ++i) s += ssq[(size_t)r * 16 + i];
        return 1.0f / sqrtf(s * (1.0f / D) + EPS); }
    __device__ __forceinline__ void operator()(int r, int col, float v) const { AUP[(size_t)r * DFF + col] = (bf16_t)f2bf(v); } };
struct EpiDownN { float* out;
    __device__ __forceinline__ float rowpre(int) const { return 1.0f; }
    __device__ __forceinline__ void operator()(int r, int col, float v) const { out[(size_t)r * D + col] += v; } };

__device__ __forceinline__ float dot8(bf16x8 a, bf16x8 b) {
    float s = 0.f;
#pragma unroll
    for (int i = 0; i < 8; ++i) s += bf2f((bf16_t)a[i]) * bf2f((bf16_t)b[i]);
    return s;
}
__device__ __forceinline__ void naive_wattn(const Args& a, const Ctx& c) {
    bf16_t* proj = (bf16_t*)(a.ws + WS_PROJ);
    const float* relb = a.in[4]; const float* sink = a.in[7];
    for (int idx = c.gtid; idx < T * 8; idx += c.ngt) {
        const int h = idx & 7, row = idx >> 3, kvh = h >> 2;
        const int s0 = row < TP ? (row & ~(SEQP - 1)) : TP, S = row < TP ? SEQP : TP, pos = row - s0;
        bf16x8 q[8]; float o[64];
        bf16_t* qp = proj + (size_t)row * NPROJ + C_Q + h * 64;
#pragma unroll
        for (int d = 0; d < 8; ++d) q[d] = ((const bf16x8*)qp)[d];
#pragma unroll
        for (int d = 0; d < 64; ++d) o[d] = 0.f;
        float m = sink[h] * LOG2E, l = 1.0f;
        const int j0 = pos - 128 < 0 ? 0 : pos - 128, j1 = pos + 128 > S - 1 ? S - 1 : pos + 128;
        for (int j = j0; j <= j1; ++j) {
            const bf16x8* kp = (const bf16x8*)(proj + (size_t)(s0 + j) * NPROJ + C_K + kvh * 64);
            const bf16x8* vp = (const bf16x8*)(proj + (size_t)(s0 + j) * NPROJ + C_V + kvh * 64);
            float s = 0.f;
#pragma unroll
            for (int d = 0; d < 8; ++d) s += dot8(q[d], kp[d]);
            s += relb[t5_bucket(j - pos) * 8 + h] * LOG2E;
            if (s > m) { const float f = __builtin_amdgcn_exp2f(m - s); l *= f;
#pragma unroll
                for (int d = 0; d < 64; ++d) o[d] *= f;
                m = s; }
            const float p = __builtin_amdgcn_exp2f(s - m); l += p;
#pragma unroll
            for (int d = 0; d < 8; ++d) { const bf16x8 v = vp[d];
#pragma unroll
                for (int e = 0; e < 8; ++e) o[8 * d + e] += p * bf2f((bf16_t)v[e]); }
        }
        const float il = 1.0f / l;
#pragma unroll
        for (int d = 0; d < 64; ++d) qp[d] = (bf16_t)f2bf(o[d] * il);
    }
}
__device__ __forceinline__ void naive_mattn(const Args& a, const Ctx& c) {
    bf16_t* proj = (bf16_t*)(a.ws + WS_PROJ); const bf16_t* mkv = (const bf16_t*)(a.ws + WS_MKV);
    for (int idx = c.gtid; idx < T * 8; idx += c.ngt) {
        const int half = idx & 1, h = (idx >> 1) & 3, row = idx >> 3;
        const int b = row < TP ? row / SEQP : 8;
        bf16_t* qp = proj + (size_t)row * NPROJ + C_QM + h * 128;
        bf16x8 q[16]; float o[64];
#pragma unroll
        for (int d = 0; d < 16; ++d) q[d] = ((const bf16x8*)qp)[d];
#pragma unroll
        for (int d = 0; d < 64; ++d) o[d] = 0.f;
        float m = -3.0e38f, l = 0.f;
        for (int j = 0; j < 256; ++j) {
            const bf16x8* kp = (const bf16x8*)(mkv + (size_t)(b * 256 + j) * 1024 + h * 128);
            const bf16x8* vp = (const bf16x8*)(mkv + (size_t)(b * 256 + j) * 1024 + 512 + h * 128 + half * 64);
            float s = 0.f;
#pragma unroll
            for (int d = 0; d < 16; ++d) s += dot8(q[d], kp[d]);
            if (s > m) { const float f = __builtin_amdgcn_exp2f(m - s); l *= f;
#pragma unroll
                for (int d = 0; d < 64; ++d) o[d] *= f;
                m = s; }
            const float p = __builtin_amdgcn_exp2f(s - m); l += p;
#pragma unroll
            for (int d = 0; d < 8; ++d) { const bf16x8 v = vp[d];
#pragma unroll
                for (int e = 0; e < 8; ++e) o[8 * d + e] += p * bf2f((bf16_t)v[e]); }
        }
        const float il = 1.0f / l;
        asm volatile("" ::: "memory");
#pragma unroll
        for (int d = 0; d < 64; ++d) qp[half * 64 + d] = (bf16_t)f2bf(o[d] * il);
    }
}
__device__ __forceinline__ void naive_sgu_stats(const Args& a, const Ctx& c) {
    const bf16_t* proj = (const bf16_t*)(a.ws + WS_PROJ); float* stat = (float*)(a.ws + WS_STAT);
    for (int row = c.gw; row < T; row += c.ngw) {
        const bf16_t* vp = proj + (size_t)row * NPROJ + C_SV;
        float v[8]; float s = 0.f;
#pragma unroll
        for (int i = 0; i < 8; ++i) { v[i] = bf2f(vp[c.lane * 8 + i]); s += v[i]; }
        const float mu = wave_sum(s) * (1.0f / 512.0f); float q = 0.f;
#pragma unroll
        for (int i = 0; i < 8; ++i) { const float d = v[i] - mu; q += d * d; }
        const float rstd = 1.0f / sqrtf(wave_sum(q) * (1.0f / 512.0f) + EPS);
        if (c.lane == 0) { stat[2 * row] = mu; stat[2 * row + 1] = rstd; }
    }
}
__device__ __forceinline__ void naive_sgu(const Args& a, const Ctx& c) {
    bf16_t* proj = (bf16_t*)(a.ws + WS_PROJ); const float* stat = (const float*)(a.ws + WS_STAT);
    const float* w_s = a.in[8]; const float* b_s = a.in[9]; const float* lng = a.in[10]; const float* lnb = a.in[11];
    for (int idx = c.gtid; idx < T * 512; idx += c.ngt) {
        const int ch = idx & 511, row = idx >> 9, g = ch >> 7, i = row & 127, r0 = row & ~127;
        const float gg = lng[ch], bb = lnb[ch];
        float acc = 0.f;
        for (int j = 0; j < 128; ++j) {
            const float v = bf2f(proj[(size_t)(r0 + j) * NPROJ + C_SV + ch]);
            const float vn = (v - stat[2 * (r0 + j)]) * stat[2 * (r0 + j) + 1] * gg + bb;
            acc += w_s[(g * 128 + i) * 128 + j] * vn;
        }
        acc += b_s[g * 128 + i];
        bf16_t* up = proj + (size_t)row * NPROJ + C_U + ch;
        *up = (bf16_t)f2bf(bf2f(*up) * acc);
    }
}
__device__ __forceinline__ void naive_branch(const Args& a, const Ctx& c) {
    const bf16_t* proj = (const bf16_t*)(a.ws + WS_PROJ); bf16_t* merged = (bf16_t*)(a.ws + WS_H);
    const int nN = 1024 / 64, ntask = (T / 64) * nN;
    for (int t = c.gw; t < ntask; t += c.ngw) {
        const int tm = t / nN, tn = t % nN;
        f32x4 m[4][4]; zero_acc(m);
#pragma unroll 1
        for (int br = 0; br < 3; ++br) {
            const int acol = br == 0 ? C_Q : (br == 1 ? C_U : C_QM);
            f32x4 acc[4][4]; zero_acc(acc);
            wt_mma(acc, proj + (size_t)tm * 64 * NPROJ + acol, NPROJ, (const bf16_t*)(a.ws + WS_WBR + br * MiB) + (size_t)tn * 64 * 512, 512, 512, c.lane);
#pragma unroll
            for (int i = 0; i < 4; ++i)
#pragma unroll
                for (int j = 0; j < 4; ++j)
#pragma unroll
                    for (int r = 0; r < 4; ++r) { const int row = tm * 64 + 16 * i + 4 * (c.lane >> 4) + r, col = tn * 64 + 16 * j + (c.lane & 15);
                        m[i][j][r] += bf2f(proj[(size_t)row * NPROJ + C_G + br * 1024 + col]) * acc[i][j][r]; }
        }
#pragma unroll
        for (int i = 0; i < 4; ++i)
#pragma unroll
            for (int j = 0; j < 4; ++j)
#pragma unroll
                for (int r = 0; r < 4; ++r) { const int row = tm * 64 + 16 * i + 4 * (c.lane >> 4) + r, col = tn * 64 + 16 * j + (c.lane & 15);
                    merged[(size_t)row * D + col] = (bf16_t)f2bf(m[i][j][r]); }
    }
}
__device__ __forceinline__ void naive_ssq(const Args& a, const Ctx& c) {
    float* ssq = (float*)(a.ws + WS_SSQ1);
    for (int row = c.gw; row < T; row += c.ngw) {
        const f32x4* xr = (const f32x4*)(a.out + (size_t)row * D); float s = 0.f;
#pragma unroll
        for (int j = 0; j < 4; ++j) { const f32x4 v = xr[c.lane + 64 * j]; s += (v.x * v.x + v.y * v.y) + (v.z * v.z + v.w * v.w); }
        s = wave_sum(s);
        if (c.lane < 16) ssq[(size_t)row * 16 + c.lane] = c.lane == 0 ? s : 0.f;
    }
}
__device__ __forceinline__ void naive_conv(const Args& a, const Ctx& c, int half) {
    const bf16_t* aup = (const bf16_t*)(a.ws + WS_AUP); bf16_t* g = (bf16_t*)(a.ws + WS_G);
    const float* cw = a.in[20]; const float* cb = a.in[21];
    for (int idx = c.gtid; idx < T * 1408; idx += c.ngt) {
        const int row = idx / 1408, lc = idx % 1408, jj = lc >> 7, ii = lc & 127, ch = half * 1408 + lc;
        const int s0 = row < TP ? (row & ~(SEQP - 1)) : TP, S = row < TP ? SEQP : TP, pos = row - s0;
        const size_t o = (size_t)row * DFF + 256 * jj + ii;
        const float g1 = bf2f(aup[o]), u1 = bf2f(aup[o + 128]);
        const float g0 = pos > 0 ? bf2f(aup[o - DFF]) : 0.f, u0 = pos > 0 ? bf2f(aup[o - DFF + 128]) : 0.f;
        const float g2 = pos < S - 1 ? bf2f(aup[o + DFF]) : 0.f, u2 = pos < S - 1 ? bf2f(aup[o + DFF + 128]) : 0.f;
        const float ga = g0 * cw[ch] + g1 * cw[NUP + ch] + g2 * cw[2 * NUP + ch] + cb[ch];
        const float ua = u0 * cw[DFF + ch] + u1 * cw[NUP + DFF + ch] + u2 * cw[2 * NUP + DFF + ch] + cb[DFF + ch];
        g[(size_t)row * DFF + ch] = (bf16_t)f2bf(gelu_tanh(ga) * ua);
    }
}
__device__ __forceinline__ void final_norm(const Args& a, const Ctx& c) {
    const float* gf = a.in[23];
    for (int row = c.gw; row < T; row += c.ngw) {
        f32x4* xr = (f32x4*)(a.out + (size_t)row * D); f32x4 v[4]; float s = 0.f;
#pragma unroll
        for (int j = 0; j < 4; ++j) { v[j] = xr[c.lane + 64 * j]; s += (v[j].x * v[j].x + v[j].y * v[j].y) + (v[j].z * v[j].z + v[j].w * v[j].w); }
        const float rstd = 1.0f / sqrtf(wave_sum(s) * (1.0f / D) + EPS);
#pragma unroll
        for (int j = 0; j < 4; ++j) { const f32x4 gg = ((const f32x4*)gf)[c.lane + 64 * j]; xr[c.lane + 64 * j] = (f32x4){v[j].x * rstd * gg.x, v[j].y * rstd * gg.y, v[j].z * rstd * gg.z, v[j].w * rstd * gg.w}; }
    }
}

namespace pg8 {
constexpr int BM = 256, BK = 64, HALF = 128, HTB = HALF * BK * 2, STAGE_BYTES = 8 * HTB, NXCD = 8, WGM = 8;
__host__ __device__ __forceinline__ int lds_byte(int r, int c) { const int st = (r >> 4) * 2 + (c >> 5), rr = r & 15, cc = c & 31, ob = rr * 64 + cc * 2; return st * 1024 + (ob ^ (((ob >> 9) & 1) << 5)); }
__host__ __device__ __forceinline__ void stage_rc(int b, int& R, int& C) { const int st = b / 1024, sb = b % 1024, swz = sb ^ (((sb >> 9) & 1) << 5); R = (st >> 1) * 16 + swz / 64; C = (st & 1) * 32 + (swz % 64) / 2; }
__host__ __device__ __forceinline__ int perm32(int rho) { const int n = rho >> 4, i = rho & 15; return 8 * (i >> 2) + 4 * n + (i & 3); }

struct Unit { const char* A; const char* B; int pm, pn, aux; };

struct TileOrder {
    int nM, nN, nwg, G, c, rep;
    __device__ __forceinline__ void init(int nM_, int nN_, int G_, int c_, int rep_ = 1) { nM = nM_; nN = nN_; nwg = nM * nN; G = G_; c = c_; rep = rep_; }
    __device__ __forceinline__ bool tile(int i, int& pm, int& pn, int& aux) const {
        const int ti = i / rep; aux = i - ti * rep;
        const long L = (long)ti * G + c; if (L >= nwg) return false;
        int wgid = (int)L; { const int q = nwg / NXCD, r = nwg % NXCD, xcd = wgid % NXCD, off = wgid / NXCD; wgid = (xcd < r ? xcd * (q + 1) : r * (q + 1) + (xcd - r) * q) + off; }
        const int nig = WGM * nN, gid = wgid / nig, fm = gid * WGM, gsz = (nM - fm) < WGM ? (nM - fm) : WGM;
        pm = fm + ((wgid % nig) % gsz); pn = (wgid % nig) / gsz; return true;
    }
};
__device__ __forceinline__ unsigned cvt_pk_bf16(float lo, float hi) { unsigned r; asm volatile("v_cvt_pk_bf16_f32 %0, %1, %2" : "=v"(r) : "v"(lo), "v"(hi)); return r; }

template <class Epi, class Sched, bool ALIGN_EPI = true, bool SP2 = true>
__device__ __forceinline__ void gemm_phase(LAS unsigned char* lds, const int K, const int lda, const Sched& S, const Epi& E) {
    const int tid = threadIdx.x, wid = __builtin_amdgcn_readfirstlane(tid >> 6), lane = tid & 63, wr = wid >> 2, wc = wid & 3, fr = lane & 15, fq = lane >> 4;
    const int nt = K / BK;
    unsigned voffA[2], voffB[2];
#pragma unroll
    for (int i = 0; i < 2; ++i) { int R, C; stage_rc(tid * 16 + i * 8192, R, C); const int Rb = Epi::PERM ? ((R & ~31) + perm32(R & 31)) : R;
        voffA[i] = (unsigned)(R * lda + C) * 2u; voffB[i] = (unsigned)(Rb * K + C) * 2u; }
    const size_t kstep = (size_t)(BK * 2);
    const size_t hstepA = (size_t)HALF * lda * 2, hstepB = (size_t)HALF * K * 2;
    const unsigned ldsw = (unsigned)wid * 1024u;
    const int aoff = lds_byte(wr * 64 + fr, fq * 8), boff = lds_byte(wc * 32 + fr, fq * 8);
#define PG8_SA(b, h) (((b) * 2 + (h)) * HTB)
#define PG8_SB(b, h) ((4 + (b) * 2 + (h)) * HTB)
#define PG8_STAGE(bufoff, gbase, voff) do { _Pragma("unroll") for (int _i = 0; _i < 2; ++_i) \
        __builtin_amdgcn_global_load_lds((const unsigned*)((const char*)(gbase) + (voff)[_i]), (LAS unsigned*)(lds + (bufoff) + ldsw + _i * 8192), 16, 0, 0); } while (0)
#define PG8_LDA(dst, b, h) do { _Pragma("unroll") for (int m = 0; m < 4; ++m) _Pragma("unroll") for (int k = 0; k < 2; ++k) dst[m][k] = *(const LAS bf16x8*)(lds + PG8_SA(b, h) + aoff + m * 2048 + k * 1024); } while (0)
#define PG8_LDB(dst, b, h) do { _Pragma("unroll") for (int n = 0; n < 2; ++n) _Pragma("unroll") for (int k = 0; k < 2; ++k) dst[n][k] = *(const LAS bf16x8*)(lds + PG8_SB(b, h) + boff + n * 2048 + k * 1024); } while (0)
#define PG8_MMA(ai, bj, At, Bt) do { __builtin_amdgcn_s_setprio(1); _Pragma("unroll") for (int m = 0; m < 4; ++m) _Pragma("unroll") for (int n = 0; n < 2; ++n) _Pragma("unroll") for (int k = 0; k < 2; ++k) \
        acc[ai][bj][m][n] = __builtin_amdgcn_mfma_f32_16x16x32_bf16(Bt[n][k], At[m][k], acc[ai][bj][m][n], 0, 0, 0); __builtin_amdgcn_s_setprio(0); } while (0)
#define PG8_WAIT_V(n) asm volatile("s_waitcnt vmcnt(" #n ")" ::: "memory")
#define PG8_WAIT_L(n) asm volatile("s_waitcnt lgkmcnt(" #n ")" ::: "memory")
#define PG8_BAR __builtin_amdgcn_s_barrier()
#define PG8_SCHED __builtin_amdgcn_sched_barrier(0)
    Unit cur, nxt; int ui = 0;
    if (!S.next(0, cur)) return;
    f32x4 acc[2][2][4][2];
#pragma unroll
    for (int a = 0; a < 2; ++a)
#pragma unroll
        for (int b = 0; b < 2; ++b)
#pragma unroll
            for (int m = 0; m < 4; ++m)
#pragma unroll
                for (int n = 0; n < 2; ++n) acc[a][b][m][n] = (f32x4){0.f, 0.f, 0.f, 0.f};
    bf16x8 At[4][2], B0[2][2], B1[2][2];
    const char* cA = cur.A; const char* cB = cur.B;
    if constexpr (SP2) {
        PG8_STAGE(PG8_SB(0, 0), cB, voffB); PG8_STAGE(PG8_SB(0, 1), cB + hstepB, voffB); PG8_STAGE(PG8_SA(0, 0), cA, voffA); PG8_STAGE(PG8_SA(0, 1), cA + hstepA, voffA);
        if (wr == 1) PG8_BAR;
        PG8_WAIT_V(2); PG8_BAR;
        PG8_STAGE(PG8_SB(1, 0), cB + kstep, voffB); PG8_STAGE(PG8_SA(1, 0), cA + kstep, voffA); PG8_STAGE(PG8_SB(1, 1), cB + hstepB + kstep, voffB);
        PG8_WAIT_V(6); PG8_BAR;
    } else {
        PG8_STAGE(PG8_SB(0, 0), cB, voffB); PG8_STAGE(PG8_SA(0, 0), cA, voffA); PG8_STAGE(PG8_SB(0, 1), cB + hstepB, voffB); PG8_STAGE(PG8_SA(0, 1), cA + hstepA, voffA);
        if (wr == 1) PG8_BAR;
        PG8_WAIT_V(4); PG8_BAR;
        PG8_STAGE(PG8_SB(1, 0), cB + kstep, voffB); PG8_STAGE(PG8_SA(1, 0), cA + kstep, voffA); PG8_STAGE(PG8_SB(1, 1), cB + hstepB + kstep, voffB);
        PG8_WAIT_V(6); PG8_BAR;
    }
    for (;;) {
        const bool has_next = S.next(ui + 1, nxt);
        const char* nA = has_next ? nxt.A : cA; const char* nB = has_next ? nxt.B : cB;
        for (int t = 0; t < nt; t += 2) {
            const bool last = (t == nt - 2);
            const char* a1 = cA + (size_t)(t + 1) * kstep;
            const char* a2 = last ? nA : cA + (size_t)(t + 2) * kstep; const char* b2 = last ? nB : cB + (size_t)(t + 2) * kstep;
            const char* a3 = a2 + kstep; const char* b3 = b2 + kstep;
            if constexpr (SP2) {
            PG8_LDB(B0, 0, 0); PG8_LDB(B1, 0, 1); PG8_SCHED; PG8_LDA(At, 0, 0); PG8_STAGE(PG8_SA(1, 1), a1 + hstepA, voffA);
            PG8_WAIT_V(8); PG8_WAIT_L(0); PG8_BAR; PG8_MMA(0, 0, At, B0); PG8_MMA(0, 1, At, B1); PG8_BAR; PG8_SCHED;
            PG8_LDA(At, 0, 1); PG8_STAGE(PG8_SB(0, 0), b2, voffB); PG8_STAGE(PG8_SB(0, 1), b2 + hstepB, voffB); PG8_STAGE(PG8_SA(0, 0), a2, voffA);
            PG8_WAIT_V(8); PG8_WAIT_L(0); PG8_BAR; PG8_MMA(1, 0, At, B0); PG8_MMA(1, 1, At, B1); PG8_BAR; PG8_SCHED;
            PG8_LDB(B0, 1, 0); PG8_LDB(B1, 1, 1); PG8_SCHED; PG8_LDA(At, 1, 0); PG8_STAGE(PG8_SA(0, 1), a2 + hstepA, voffA);
            PG8_WAIT_V(8); PG8_WAIT_L(0); PG8_BAR; PG8_MMA(0, 0, At, B0); PG8_MMA(0, 1, At, B1); PG8_BAR; PG8_SCHED;
            PG8_LDA(At, 1, 1); PG8_STAGE(PG8_SB(1, 0), b3, voffB); PG8_STAGE(PG8_SB(1, 1), b3 + hstepB, voffB); PG8_STAGE(PG8_SA(1, 0), a3, voffA);
            PG8_WAIT_V(8); PG8_WAIT_L(0); PG8_BAR; PG8_MMA(1, 0, At, B0); PG8_MMA(1, 1, At, B1); PG8_BAR; PG8_SCHED;
            } else {
            PG8_LDB(B0, 0, 0); PG8_SCHED; PG8_LDA(At, 0, 0); PG8_STAGE(PG8_SA(1, 1), a1 + hstepA, voffA);
            PG8_WAIT_L(8); PG8_BAR; PG8_WAIT_L(0); PG8_MMA(0, 0, At, B0); PG8_BAR; PG8_SCHED;
            PG8_LDB(B1, 0, 1); PG8_STAGE(PG8_SB(0, 0), b2, voffB);
            PG8_BAR; PG8_WAIT_L(0); PG8_MMA(0, 1, At, B1); PG8_BAR;
            PG8_LDA(At, 0, 1); PG8_STAGE(PG8_SA(0, 0), a2, voffA);
            PG8_BAR; PG8_WAIT_L(0); PG8_MMA(1, 0, At, B0); PG8_BAR; PG8_SCHED;
            PG8_STAGE(PG8_SB(0, 1), b2 + hstepB, voffB);
            PG8_WAIT_V(6); PG8_BAR; PG8_MMA(1, 1, At, B1); PG8_BAR;
            PG8_LDB(B0, 1, 0); PG8_SCHED; PG8_LDA(At, 1, 0); PG8_STAGE(PG8_SA(0, 1), a2 + hstepA, voffA);
            PG8_WAIT_L(8); PG8_BAR; PG8_WAIT_L(0); PG8_MMA(0, 0, At, B0); PG8_BAR; PG8_SCHED;
            PG8_LDB(B1, 1, 1); PG8_STAGE(PG8_SB(1, 0), b3, voffB);
            PG8_BAR; PG8_WAIT_L(0); PG8_MMA(0, 1, At, B1); PG8_BAR;
            PG8_LDA(At, 1, 1); PG8_STAGE(PG8_SA(1, 0), a3, voffA);
            PG8_BAR; PG8_WAIT_L(0); PG8_MMA(1, 0, At, B0); PG8_BAR; PG8_SCHED;
            PG8_STAGE(PG8_SB(1, 1), b3 + hstepB, voffB);
            PG8_WAIT_V(6); PG8_BAR; PG8_MMA(1, 1, At, B1); PG8_BAR;
            }
        }
        if constexpr (ALIGN_EPI) { if (wr == 0) PG8_BAR; }
        E(acc, cur, wr, wc, fr, fq);
        if (!has_next) break;
#pragma unroll
        for (int a = 0; a < 2; ++a)
#pragma unroll
            for (int b = 0; b < 2; ++b)
#pragma unroll
                for (int m = 0; m < 4; ++m)
#pragma unroll
                    for (int n = 0; n < 2; ++n) acc[a][b][m][n] = (f32x4){0.f, 0.f, 0.f, 0.f};
        cur = nxt; cA = nA; cB = nB; ++ui;
        if constexpr (ALIGN_EPI) { if (wr == 1) PG8_BAR; }
    }
    PG8_WAIT_V(0);
    if constexpr (!ALIGN_EPI) { if (wr == 0) PG8_BAR; }
    PG8_BAR;
#undef PG8_SA
#undef PG8_SB
#undef PG8_STAGE
#undef PG8_LDA
#undef PG8_LDB
#undef PG8_MMA
#undef PG8_WAIT_V
#undef PG8_WAIT_L
#undef PG8_BAR
#undef PG8_SCHED
}

struct SchedPlain {
    TileOrder o; const char* A; const char* B; size_t strideA, strideB;
    __device__ __forceinline__ bool next(int i, Unit& u) const { int aux; if (!o.tile(i, u.pm, u.pn, aux)) return false; u.aux = aux; u.A = A + (size_t)u.pm * strideA; u.B = B + (size_t)u.pn * strideB; return true; }
};
struct SchedOne {
    int idx, nN; const char* A; const char* B; size_t strideA, strideB;
    __device__ __forceinline__ bool next(int i, Unit& u) const { if (i > 0 || idx < 0) return false; u.pm = idx / nN; u.pn = idx % nN; u.aux = 0; u.A = A + (size_t)u.pm * strideA; u.B = B + (size_t)u.pn * strideB; return true; }
};

__device__ __forceinline__ f32x4 act4(f32x4 v, int mode) {
    if (mode == 1) return v * QSCALE;
    if (mode == 3) return v * MSCALE;
    if (mode == 2) return (f32x4){gelu_tanh(v[0]), gelu_tanh(v[1]), gelu_tanh(v[2]), gelu_tanh(v[3])};
    if (mode == 4) return (f32x4){sigmoid_f(v[0]), sigmoid_f(v[1]), sigmoid_f(v[2]), sigmoid_f(v[3])};
    return v;
}
struct EpiProj {
    static constexpr bool PERM = true;
    bf16_t* P;
    __device__ __forceinline__ void operator()(const f32x4 (&acc)[2][2][4][2], const Unit& u, int wr, int wc, int fr, int fq) const {
        const int pn = u.pn, mode = pn < 2 ? 1 : (pn == 2 ? 0 : (pn < 7 ? 2 : (pn < 9 ? 3 : 4)));
        const int row0 = u.pm * BM + wr * 64 + fr, col0 = pn * BM + wc * 32 + 8 * fq;
#pragma unroll
        for (int ai = 0; ai < 2; ++ai)
#pragma unroll
            for (int m = 0; m < 4; ++m) { bf16_t* rowp = P + (size_t)(row0 + ai * HALF + m * 16) * NPROJ + col0;
#pragma unroll
                for (int bj = 0; bj < 2; ++bj) { const f32x4 v0 = act4(acc[ai][bj][m][0], mode), v1 = act4(acc[ai][bj][m][1], mode);
                    u32x4 w; w.x = cvt_pk_bf16(v0[0], v0[1]); w.y = cvt_pk_bf16(v0[2], v0[3]); w.z = cvt_pk_bf16(v1[0], v1[1]); w.w = cvt_pk_bf16(v1[2], v1[3]);
                    *(u32x4*)(rowp + bj * HALF) = w; } }
    }
};
struct EpiPlain {
    static constexpr bool PERM = true;
    bf16_t* P; int ldc;
    __device__ __forceinline__ void operator()(const f32x4 (&acc)[2][2][4][2], const Unit& u, int wr, int wc, int fr, int fq) const {
        const int row0 = u.pm * BM + wr * 64 + fr, col0 = u.pn * BM + wc * 32 + 8 * fq;
#pragma unroll
        for (int ai = 0; ai < 2; ++ai)
#pragma unroll
            for (int m = 0; m < 4; ++m) { bf16_t* rowp = P + (size_t)(row0 + ai * HALF + m * 16) * ldc + col0;
#pragma unroll
                for (int bj = 0; bj < 2; ++bj) { const f32x4 v0 = acc[ai][bj][m][0], v1 = acc[ai][bj][m][1];
                    u32x4 w; w.x = cvt_pk_bf16(v0[0], v0[1]); w.y = cvt_pk_bf16(v0[2], v0[3]); w.z = cvt_pk_bf16(v1[0], v1[1]); w.w = cvt_pk_bf16(v1[2], v1[3]);
                    *(u32x4*)(rowp + bj * HALF) = w; } }
    }
};
__device__ __forceinline__ f32x4 unpk4(unsigned a, unsigned b) { return (f32x4){__uint_as_float(a << 16), __uint_as_float(a & 0xffff0000u), __uint_as_float(b << 16), __uint_as_float(b & 0xffff0000u)}; }
struct SchedBranch {
    TileOrder o; const char* proj; const char* wbr;
    __device__ __forceinline__ bool next(int i, Unit& u) const { int aux; if (!o.tile(i, u.pm, u.pn, aux)) return false; u.aux = aux;
        const int acol = aux == 0 ? C_Q : (aux == 1 ? C_U : C_QM);
        u.A = proj + ((size_t)u.pm * 256 * NPROJ + acol) * 2; u.B = wbr + (size_t)aux * MiB + (size_t)u.pn * 256 * 512 * 2; return true; }
};
struct EpiBranch {
    static constexpr bool PERM = true;
    const bf16_t* proj; bf16_t* merged;
    __device__ __forceinline__ void operator()(const f32x4 (&acc)[2][2][4][2], const Unit& u, int wr, int wc, int fr, int fq) const {
        const int br = u.aux, row0 = u.pm * BM + wr * 64 + fr, col0 = u.pn * BM + wc * 32 + 8 * fq;
#pragma unroll
        for (int ai = 0; ai < 2; ++ai)
#pragma unroll
            for (int m = 0; m < 4; ++m) { const int row = row0 + ai * HALF + m * 16;
                const bf16_t* gp = proj + (size_t)row * NPROJ + C_G + br * 1024 + col0; bf16_t* mp = merged + (size_t)row * D + col0;
#pragma unroll
                for (int bj = 0; bj < 2; ++bj) { const u32x4 gw = *(const u32x4*)(gp + bj * HALF);
                    f32x4 v0 = acc[ai][bj][m][0] * unpk4(gw.x, gw.y), v1 = acc[ai][bj][m][1] * unpk4(gw.z, gw.w);
                    if (br > 0) { const u32x4 mw = *(const u32x4*)(mp + bj * HALF); v0 += unpk4(mw.x, mw.y); v1 += unpk4(mw.z, mw.w); }
                    u32x4 w; w.x = cvt_pk_bf16(v0[0], v0[1]); w.y = cvt_pk_bf16(v0[2], v0[3]); w.z = cvt_pk_bf16(v1[0], v1[1]); w.w = cvt_pk_bf16(v1[2], v1[3]);
                    *(u32x4*)(mp + bj * HALF) = w; } }
    }
};
struct EpiOut {
    static constexpr bool PERM = false;
    const float* xp; const float* xs; float* out; bf16_t* H2; float* ssq;
    __device__ __forceinline__ void operator()(const f32x4 (&acc)[2][2][4][2], const Unit& u, int wr, int wc, int fr, int fq) const {
        const int col0 = u.pn * BM + wc * 32 + 4 * fq;
#pragma unroll
        for (int ai = 0; ai < 2; ++ai)
#pragma unroll
            for (int m = 0; m < 4; ++m) { const int row = u.pm * BM + ai * HALF + wr * 64 + m * 16 + fr;
                const float* xr = (row < TP ? xp + (size_t)row * D : xs + (size_t)(row - TP) * D) + col0; const size_t ob = (size_t)row * D + col0; float s = 0.f;
#pragma unroll
                for (int bj = 0; bj < 2; ++bj)
#pragma unroll
                    for (int n = 0; n < 2; ++n) { const int off = bj * HALF + n * 16; const f32x4 x1 = *(const f32x4*)(xr + off) + acc[ai][bj][m][n];
                        *(f32x4*)(out + ob + off) = x1; s += (x1[0] * x1[0] + x1[1] * x1[1]) + (x1[2] * x1[2] + x1[3] * x1[3]);
                        const unsigned lo = cvt_pk_bf16(x1[0], x1[1]), hi = cvt_pk_bf16(x1[2], x1[3]);
                        *(unsigned long long*)(H2 + ob + off) = (unsigned long long)lo | ((unsigned long long)hi << 32); }
                s += __shfl_xor(s, 16); s += __shfl_xor(s, 32);
                if (fq == 0) ssq[(size_t)row * 16 + u.pn * 4 + wc] = s; }
    }
};
struct EpiDown {
    static constexpr bool PERM = false;
    float* out;
    __device__ __forceinline__ void operator()(const f32x4 (&acc)[2][2][4][2], const Unit& u, int wr, int wc, int fr, int fq) const {
        const int col0 = u.pn * BM + wc * 32 + 4 * fq;
#pragma unroll
        for (int ai = 0; ai < 2; ++ai)
#pragma unroll
            for (int m = 0; m < 4; ++m) { const int row = u.pm * BM + ai * HALF + wr * 64 + m * 16 + fr; float* op = out + (size_t)row * D + col0;
#pragma unroll
                for (int bj = 0; bj < 2; ++bj)
#pragma unroll
                    for (int n = 0; n < 2; ++n) { f32x4* o = (f32x4*)(op + bj * HALF + n * 16); *o = *o + acc[ai][bj][m][n]; } }
    }
};
struct EpiUpHalf {
    static constexpr bool PERM = true;
    bf16_t* P; const float* ssq;
    __device__ __forceinline__ void operator()(const f32x4 (&acc)[2][2][4][2], const Unit& u, int wr, int wc, int fr, int fq) const {
        const int row0 = u.pm * BM + wr * 64 + fr, col0 = u.pn * BM + wc * 32 + 8 * fq;
#pragma unroll
        for (int ai = 0; ai < 2; ++ai)
#pragma unroll
            for (int m = 0; m < 4; ++m) { const int row = row0 + ai * HALF + m * 16; bf16_t* rowp = P + (size_t)row * DFF + col0;
                const f32x4* sp = (const f32x4*)(ssq + (size_t)row * 16); const f32x4 s4 = (sp[0] + sp[1]) + (sp[2] + sp[3]);
                const float rstd = 1.0f / sqrtf(((s4[0] + s4[1]) + (s4[2] + s4[3])) * (1.0f / D) + EPS);
#pragma unroll
                for (int bj = 0; bj < 2; ++bj) { const f32x4 v0 = acc[ai][bj][m][0] * rstd, v1 = acc[ai][bj][m][1] * rstd;
                    u32x4 w; w.x = cvt_pk_bf16(v0[0], v0[1]); w.y = cvt_pk_bf16(v0[2], v0[3]); w.z = cvt_pk_bf16(v1[0], v1[1]); w.w = cvt_pk_bf16(v1[2], v1[3]);
                    *(u32x4*)(rowp + bj * HALF) = w; } }
    }
};
struct EpiUpConv {
    static constexpr bool PERM = true;
    bf16_t* G; const float* ssq; const float* cw; const float* cb; float* edge; LAS unsigned char* xch;
    __device__ __forceinline__ void operator()(f32x4 (&acc)[2][2][4][2], const Unit& u, int wr, int wc, int fr, int fq) const {
        const int lane = fq * 16 + fr;
        float rs[2];
#pragma unroll
        for (int ai = 0; ai < 2; ++ai) { const unsigned row = (unsigned)(u.pm * BM + ai * HALF + wr * 64 + lane);
            const f32x4* sp = (const f32x4*)(ssq + row * 16u); const f32x4 s4 = (sp[0] + sp[1]) + (sp[2] + sp[3]);
            rs[ai] = 1.0f / sqrtf(((s4[0] + s4[1]) + (s4[2] + s4[3])) * (1.0f / D) + EPS); }
#pragma unroll
        for (int ai = 0; ai < 2; ++ai)
#pragma unroll
            for (int m = 0; m < 4; ++m) { const float rstd = __shfl(rs[ai], 16 * m + fr);
#pragma unroll
                for (int bj = 0; bj < 2; ++bj)
#pragma unroll
                    for (int n = 0; n < 2; ++n) acc[ai][bj][m][n] = acc[ai][bj][m][n] * rstd; }
        asm volatile("" ::: "memory");
        const int colw = wc * 32 + 8 * fq;
#pragma unroll
        for (int ai = 0; ai < 2; ++ai) { const int blk = 2 * ai + wr;
            if (fr == 0) {
#pragma unroll
                for (int bj = 0; bj < 2; ++bj)
#pragma unroll
                    for (int n = 0; n < 2; ++n) *(LAS f32x4*)(xch + ((0 * 4 + blk) * 256 + bj * 128 + colw + 4 * n) * 4) = acc[ai][bj][0][n]; }
            if (fr == 15) {
#pragma unroll
                for (int bj = 0; bj < 2; ++bj)
#pragma unroll
                    for (int n = 0; n < 2; ++n) *(LAS f32x4*)(xch + ((1 * 4 + blk) * 256 + bj * 128 + colw + 4 * n) * 4) = acc[ai][bj][3][n]; } }
        { float* eb = edge + (size_t)(u.pm * 22 + u.pn) * 4 * 256 + colw;
          if (wr == 0 && fr < 2) {
#pragma unroll
              for (int bj = 0; bj < 2; ++bj)
#pragma unroll
                  for (int n = 0; n < 2; ++n) *(f32x4*)(eb + fr * 256 + bj * 128 + 4 * n) = acc[0][bj][0][n]; }
          if (wr == 1 && fr >= 14) {
#pragma unroll
              for (int bj = 0; bj < 2; ++bj)
#pragma unroll
                  for (int n = 0; n < 2; ++n) *(f32x4*)(eb + (fr - 12) * 256 + bj * 128 + 4 * n) = acc[1][bj][3][n]; } }
        asm volatile("s_waitcnt lgkmcnt(0)" ::: "memory"); __builtin_amdgcn_s_barrier(); asm volatile("" ::: "memory");
        const int srcP = (lane & 48) | ((fr + 15) & 15), srcN = (lane & 48) | ((fr + 1) & 15);
        const int ch0 = u.pn * 128 + colw;
#pragma unroll
        for (int n = 0; n < 2; ++n)
#pragma unroll
            for (int bj = 0; bj < 2; ++bj) {
                const float* cwp = cw + bj * DFF + ch0 + 4 * n;
                const f32x4 w0 = *(const f32x4*)cwp, w1 = *(const f32x4*)(cwp + NUP), w2 = *(const f32x4*)(cwp + 2 * NUP), wb = *(const f32x4*)(cb + bj * DFF + ch0 + 4 * n);
#pragma unroll
                for (int ai = 0; ai < 2; ++ai) { const int blk = 2 * ai + wr;
                    f32x4 po = blk > 0 ? *(const LAS f32x4*)(xch + ((1 * 4 + blk - 1) * 256 + bj * 128 + colw + 4 * n) * 4) : (f32x4){0.f, 0.f, 0.f, 0.f};
                    const f32x4 en = blk < 3 ? *(const LAS f32x4*)(xch + ((0 * 4 + blk + 1) * 256 + bj * 128 + colw + 4 * n) * 4) : (f32x4){0.f, 0.f, 0.f, 0.f};
#pragma unroll
                    for (int m = 0; m < 4; ++m) {
                        const f32x4 cur = acc[ai][bj][m][n], nm1 = m < 3 ? acc[ai][bj][m < 3 ? m + 1 : 3][n] : en;
                        f32x4 pv, nv;
#pragma unroll
                        for (int e = 0; e < 4; ++e) { pv[e] = __shfl(fr == 15 ? po[e] : cur[e], srcP); nv[e] = __shfl(fr == 0 ? nm1[e] : cur[e], srcN); }
                        acc[ai][bj][m][n] = pv * w0 + cur * w1 + nv * w2 + wb;
                        asm volatile("" : "+v"(acc[ai][bj][m][n]));
                        po = cur;
                    } }
                asm volatile("" ::: "memory");
            }
#pragma unroll
        for (int ai = 0; ai < 2; ++ai)
#pragma unroll
            for (int m = 0; m < 4; ++m) { const unsigned row = (unsigned)(u.pm * BM + ai * HALF + wr * 64 + m * 16 + fr);
                const f32x4 ga = acc[ai][0][m][0], gb = acc[ai][0][m][1], ua = acc[ai][1][m][0], ub = acc[ai][1][m][1];
                u32x4 w; w.x = cvt_pk_bf16(gelu_tanh(ga[0]) * ua[0], gelu_tanh(ga[1]) * ua[1]); w.y = cvt_pk_bf16(gelu_tanh(ga[2]) * ua[2], gelu_tanh(ga[3]) * ua[3]);
                w.z = cvt_pk_bf16(gelu_tanh(gb[0]) * ub[0], gelu_tanh(gb[1]) * ub[1]); w.w = cvt_pk_bf16(gelu_tanh(gb[2]) * ub[2], gelu_tanh(gb[3]) * ub[3]);
                *(u32x4*)(G + (row * (unsigned)DFF + (unsigned)ch0)) = w;
                if (m & 1) asm volatile("" ::: "memory"); }
    }
};
}

__device__ __forceinline__ bf16x8 pack8(f32x4 a, f32x4 b) {
    u32x4 w; w.x = pg8::cvt_pk_bf16(a[0], a[1]); w.y = pg8::cvt_pk_bf16(a[2], a[3]); w.z = pg8::cvt_pk_bf16(b[0], b[1]); w.w = pg8::cvt_pk_bf16(b[2], b[3]);
    return __builtin_bit_cast(bf16x8, w);
}
__device__ __forceinline__ float bflo(unsigned w) { return __uint_as_float(w << 16); }
__device__ __forceinline__ float bfhi(unsigned w) { return __uint_as_float(w & 0xffff0000u); }

constexpr int WA_K = 0, WA_KP = 144, WA_VT = 384 * 144, WA_VP = 784, WA_BIAS = WA_VT + 64 * 784;
__device__ __forceinline__ void wattn_unit(const Args& a, LAS unsigned char* lds, int blk, int kvh, int tid, int wave, int lane) {
    bf16_t* proj = (bf16_t*)(a.ws + WS_PROJ);
    const int R0 = blk * 128, s0 = R0 < TP ? (R0 & ~(SEQP - 1)) : TP, S = R0 < TP ? SEQP : TP, n = (R0 - s0) >> 7, nb = S >> 7;
    const bool has_l = n > 0, has_r = n < nb - 1;
#pragma unroll
    for (int i = 0; i < 6; ++i) { const int qd = tid + 512 * i, w = qd >> 3, ch = qd & 7; const bool ok = (w >= 128 || has_l) && (w < 256 || has_r);
        u32x4 v = (u32x4){0u, 0u, 0u, 0u};
        if (ok) v = *(const u32x4*)(proj + (size_t)(R0 - 128 + w) * NPROJ + C_K + kvh * 64 + ch * 8);
        *(LAS u32x4*)(lds + WA_K + w * WA_KP + ch * 16) = v; }
#pragma unroll
    for (int i = 0; i < 3; ++i) { const int p = tid + 512 * i, w = (p >> 3) * 2, ch = p & 7; const bool ok = (w >= 128 || has_l) && (w < 256 || has_r);
        u32x4 v0 = (u32x4){0u, 0u, 0u, 0u}, v1 = v0;
        if (ok) { const bf16_t* vp = proj + (size_t)(R0 - 128 + w) * NPROJ + C_V + kvh * 64 + ch * 8; v0 = *(const u32x4*)vp; v1 = *(const u32x4*)(vp + NPROJ); }
#pragma unroll
        for (int e = 0; e < 4; ++e) { const unsigned x0 = v0[e], x1 = v1[e]; const int d = ch * 8 + 2 * e;
            *(LAS unsigned*)(lds + WA_VT + d * WA_VP + w * 2) = (x0 & 0xffffu) | (x1 << 16);
            *(LAS unsigned*)(lds + WA_VT + (d + 1) * WA_VP + w * 2) = (x0 >> 16) | (x1 & 0xffff0000u); } }
    for (int i = tid; i < 4 * 257; i += 512) { const int hh = i / 257, r = i - hh * 257; ((LAS float*)(lds + WA_BIAS))[hh * 260 + r] = a.in[4][t5_bucket(r - 128) * 8 + 4 * kvh + hh] * LOG2E; }
    __syncthreads();
    const int q = lane & 15, g = lane >> 4, hh = wave & 3, h = 4 * kvh + hh;
    const float sink2 = a.in[7][h] * LOG2E;
    const LAS float* btab = (const LAS float*)(lds + WA_BIAS) + hh * 260;
    const LAS unsigned char* kbase = lds + WA_K + (8 * (q >> 2) + (q & 3)) * WA_KP + g * 16;
    const LAS unsigned char* vbase = lds + WA_VT + q * WA_VP + g * 16;
#pragma unroll 1
    for (int j = 0; j < 4; ++j) {
        const int i0 = 16 * ((wave >> 2) + 2 * j);
        bf16_t* qp = proj + (size_t)(R0 + i0 + q) * NPROJ + C_Q + h * 64 + 8 * g;
        const bf16x8 qf0 = *(const bf16x8*)qp, qf1 = *(const bf16x8*)(qp + 32);
        f32x4 sc[24];
#pragma unroll
        for (int t = 0; t < 24; ++t) {
            const bf16x8 k0 = *(const LAS bf16x8*)(kbase + (t >> 1) * 32 * WA_KP + (t & 1) * 4 * WA_KP), k1 = *(const LAS bf16x8*)(kbase + (t >> 1) * 32 * WA_KP + (t & 1) * 4 * WA_KP + 64);
            f32x4 z = (f32x4){0.f, 0.f, 0.f, 0.f};
            z = __builtin_amdgcn_mfma_f32_16x16x32_bf16(k0, qf0, z, 0, 0, 0); sc[t] = __builtin_amdgcn_mfma_f32_16x16x32_bf16(k1, qf1, z, 0, 0, 0); }
        const int iq = i0 + q; float mx = -1.0e30f;
        const int relb = 8 * g - 128 - iq;
#pragma unroll
        for (int t = 0; t < 24; ++t)
#pragma unroll
            for (int r = 0; r < 4; ++r) { const int wofs = 32 * (t >> 1) + 4 * (t & 1) + r, rel = relb + wofs, w = 8 * g + wofs;
                const bool ok = rel >= -128 && rel <= 128 && (w >= 128 || has_l) && (w < 256 || has_r);
                const int bi = min(max(rel + 128, 0), 256);
                const float v = ok ? sc[t][r] + btab[bi] : -1.0e30f; sc[t][r] = v; mx = fmaxf(mx, v); }
        mx = fmaxf(mx, __shfl_xor(mx, 16)); mx = fmaxf(mx, __shfl_xor(mx, 32)); mx = fmaxf(mx, sink2);
        float sum = 0.f;
#pragma unroll
        for (int t = 0; t < 24; ++t)
#pragma unroll
            for (int r = 0; r < 4; ++r) { const float p = __builtin_amdgcn_exp2f(sc[t][r] - mx); sc[t][r] = p; sum += p; }
        sum += __shfl_xor(sum, 16); sum += __shfl_xor(sum, 32);
        const float inv = 1.0f / (sum + __builtin_amdgcn_exp2f(sink2 - mx));
        f32x4 o[4];
#pragma unroll
        for (int dt = 0; dt < 4; ++dt) o[dt] = (f32x4){0.f, 0.f, 0.f, 0.f};
#pragma unroll
        for (int c = 0; c < 12; ++c) { const bf16x8 pf = pack8(sc[2 * c], sc[2 * c + 1]);
#pragma unroll
            for (int dt = 0; dt < 4; ++dt) { const bf16x8 vf = *(const LAS bf16x8*)(vbase + dt * 16 * WA_VP + c * 64);
                o[dt] = __builtin_amdgcn_mfma_f32_16x16x32_bf16(pf, vf, o[dt], 0, 0, 0); } }
#pragma unroll
        for (int r = 0; r < 4; ++r) { const float ir = __shfl(inv, 4 * g + r); bf16_t* op = proj + (size_t)(R0 + i0 + 4 * g + r) * NPROJ + C_Q + h * 64 + q;
#pragma unroll
            for (int dt = 0; dt < 4; ++dt) op[16 * dt] = (bf16_t)f2bf(o[dt][r] * ir); }
    }
    __syncthreads();
}

constexpr int MA_K = 0, MA_KP = 272, MA_VT = 256 * 272, MA_VP = 528;
__device__ __forceinline__ void mattn_unit(const Args& a, LAS unsigned char* lds, int tile, int hm, int tid, int wave, int lane) {
    bf16_t* proj = (bf16_t*)(a.ws + WS_PROJ); const bf16_t* mkv = (const bf16_t*)(a.ws + WS_MKV);
    const int R0 = tile * 512, b = R0 < TP ? R0 / SEQP : 8;
    const bf16_t* kb = mkv + (size_t)b * 256 * 1024 + hm * 128; const bf16_t* vb = kb + 512;
#pragma unroll
    for (int i = 0; i < 8; ++i) { const int qd = tid + 512 * i, w = qd >> 4, ch = qd & 15;
        *(LAS u32x4*)(lds + MA_K + w * MA_KP + ch * 16) = *(const u32x4*)(kb + (size_t)w * 1024 + ch * 8); }
#pragma unroll
    for (int i = 0; i < 4; ++i) { const int p = tid + 512 * i, w = (p >> 4) * 2, ch = p & 15;
        const u32x4 v0 = *(const u32x4*)(vb + (size_t)w * 1024 + ch * 8), v1 = *(const u32x4*)(vb + (size_t)(w + 1) * 1024 + ch * 8);
#pragma unroll
        for (int e = 0; e < 4; ++e) { const unsigned x0 = v0[e], x1 = v1[e]; const int d = ch * 8 + 2 * e;
            *(LAS unsigned*)(lds + MA_VT + d * MA_VP + w * 2) = (x0 & 0xffffu) | (x1 << 16);
            *(LAS unsigned*)(lds + MA_VT + (d + 1) * MA_VP + w * 2) = (x0 >> 16) | (x1 & 0xffff0000u); } }
    __syncthreads();
    const int q = lane & 15, g = lane >> 4;
    const LAS unsigned char* kbase = lds + MA_K + (8 * (q >> 2) + (q & 3)) * MA_KP + g * 16;
    const LAS unsigned char* vbase = lds + MA_VT + q * MA_VP + g * 16;
#pragma unroll 1
    for (int j = 0; j < 4; ++j) {
        const int i0 = 16 * (wave + 8 * j);
        bf16_t* qp = proj + (size_t)(R0 + i0 + q) * NPROJ + C_QM + hm * 128 + 8 * g;
        bf16x8 qf[4];
#pragma unroll
        for (int ks = 0; ks < 4; ++ks) qf[ks] = *(const bf16x8*)(qp + 32 * ks);
        f32x4 sc[16];
#pragma unroll
        for (int t = 0; t < 16; ++t) {
            f32x4 z = (f32x4){0.f, 0.f, 0.f, 0.f};
#pragma unroll
            for (int ks = 0; ks < 4; ++ks) { const bf16x8 kf = *(const LAS bf16x8*)(kbase + (t >> 1) * 32 * MA_KP + (t & 1) * 4 * MA_KP + ks * 64); z = __builtin_amdgcn_mfma_f32_16x16x32_bf16(kf, qf[ks], z, 0, 0, 0); }
            sc[t] = z; }
        float mx = -1.0e30f;
#pragma unroll
        for (int t = 0; t < 16; ++t)
#pragma unroll
            for (int r = 0; r < 4; ++r) mx = fmaxf(mx, sc[t][r]);
        mx = fmaxf(mx, __shfl_xor(mx, 16)); mx = fmaxf(mx, __shfl_xor(mx, 32));
        float sum = 0.f;
#pragma unroll
        for (int t = 0; t < 16; ++t)
#pragma unroll
            for (int r = 0; r < 4; ++r) { const float p = __builtin_amdgcn_exp2f(sc[t][r] - mx); sc[t][r] = p; sum += p; }
        sum += __shfl_xor(sum, 16); sum += __shfl_xor(sum, 32);
        const float inv = 1.0f / sum;
        f32x4 o[8];
#pragma unroll
        for (int dt = 0; dt < 8; ++dt) o[dt] = (f32x4){0.f, 0.f, 0.f, 0.f};
#pragma unroll
        for (int c = 0; c < 8; ++c) { const bf16x8 pf = pack8(sc[2 * c], sc[2 * c + 1]);
#pragma unroll
            for (int dt = 0; dt < 8; ++dt) { const bf16x8 vf = *(const LAS bf16x8*)(vbase + dt * 16 * MA_VP + c * 64);
                o[dt] = __builtin_amdgcn_mfma_f32_16x16x32_bf16(pf, vf, o[dt], 0, 0, 0); } }
#pragma unroll
        for (int r = 0; r < 4; ++r) { const float ir = __shfl(inv, 4 * g + r); bf16_t* op = proj + (size_t)(R0 + i0 + 4 * g + r) * NPROJ + C_QM + hm * 128 + q;
#pragma unroll
            for (int dt = 0; dt < 8; ++dt) op[16 * dt] = (bf16_t)f2bf(o[dt][r] * ir); }
    }
    __syncthreads();
}

constexpr int SG_P = 272;
__device__ __forceinline__ void sgu_unit(const Args& a, LAS unsigned char* lds, int chunk, int tid, int wave, int lane) {
    bf16_t* proj = (bf16_t*)(a.ws + WS_PROJ); const bf16_t* wsb = (const bf16_t*)(a.ws + WS_SGUW);
    const int R0 = chunk * 128;
    {
        const int tp = tid >> 3, part = tid & 7, t0 = 2 * tp;
        const bf16_t* v0p = proj + (size_t)(R0 + t0) * NPROJ + C_SV + part * 64; const bf16_t* v1p = v0p + NPROJ;
        u32x4 x0[8], x1[8]; float s0 = 0.f, s1 = 0.f;
#pragma unroll
        for (int i = 0; i < 8; ++i) { x0[i] = ((const u32x4*)v0p)[i]; x1[i] = ((const u32x4*)v1p)[i]; }
#pragma unroll
        for (int i = 0; i < 8; ++i)
#pragma unroll
            for (int e = 0; e < 4; ++e) { s0 += bflo(x0[i][e]) + bfhi(x0[i][e]); s1 += bflo(x1[i][e]) + bfhi(x1[i][e]); }
        s0 += __shfl_xor(s0, 1); s0 += __shfl_xor(s0, 2); s0 += __shfl_xor(s0, 4); s1 += __shfl_xor(s1, 1); s1 += __shfl_xor(s1, 2); s1 += __shfl_xor(s1, 4);
        const float mu0 = s0 * (1.0f / 512.0f), mu1 = s1 * (1.0f / 512.0f); float q0 = 0.f, q1 = 0.f;
#pragma unroll
        for (int i = 0; i < 8; ++i)
#pragma unroll
            for (int e = 0; e < 4; ++e) { float d;
                d = bflo(x0[i][e]) - mu0; q0 += d * d; d = bfhi(x0[i][e]) - mu0; q0 += d * d; d = bflo(x1[i][e]) - mu1; q1 += d * d; d = bfhi(x1[i][e]) - mu1; q1 += d * d; }
        q0 += __shfl_xor(q0, 1); q0 += __shfl_xor(q0, 2); q0 += __shfl_xor(q0, 4); q1 += __shfl_xor(q1, 1); q1 += __shfl_xor(q1, 2); q1 += __shfl_xor(q1, 4);
        const float r0 = 1.0f / sqrtf(q0 * (1.0f / 512.0f) + EPS), r1 = 1.0f / sqrtf(q1 * (1.0f / 512.0f) + EPS);
        const float* lng = a.in[10] + part * 64; const float* lnb = a.in[11] + part * 64;
        LAS unsigned char* wb0 = lds + (part * 64) * SG_P + t0 * 2;
#pragma unroll
        for (int i = 0; i < 8; ++i)
#pragma unroll
            for (int e = 0; e < 4; ++e) {
                const int cl = 8 * i + 2 * e;
                const float ga = lng[cl], ba = lnb[cl], gb = lng[cl + 1], bb = lnb[cl + 1];
                const unsigned wa = pg8::cvt_pk_bf16((bflo(x0[i][e]) - mu0) * r0 * ga + ba, (bflo(x1[i][e]) - mu1) * r1 * ga + ba);
                const unsigned wb = pg8::cvt_pk_bf16((bfhi(x0[i][e]) - mu0) * r0 * gb + bb, (bfhi(x1[i][e]) - mu1) * r1 * gb + bb);
                *(LAS unsigned*)(wb0 + cl * SG_P) = wa;
                *(LAS unsigned*)(wb0 + (cl + 1) * SG_P) = wb; }
    }
    __syncthreads();
    {
        const int cl = lane & 15, g4 = lane >> 4, grp = wave >> 1, cbase = grp * 128 + (wave & 1) * 64;
        const LAS unsigned char* abase = lds + (cbase + cl) * SG_P + g4 * 16;
        const float* bs = a.in[9] + grp * 128;
#pragma unroll 1
        for (int th = 0; th < 2; ++th) {
            const bf16_t* wbase = wsb + (size_t)(grp * 128 + 64 * th + cl) * 128 + 8 * g4;
            f32x4 acc[4][4];
#pragma unroll
            for (int ct = 0; ct < 4; ++ct)
#pragma unroll
                for (int it = 0; it < 4; ++it) acc[ct][it] = (f32x4){0.f, 0.f, 0.f, 0.f};
#pragma unroll
            for (int kc = 0; kc < 4; ++kc) {
                bf16x8 af[4], wf[4];
#pragma unroll
                for (int ct = 0; ct < 4; ++ct) af[ct] = *(const LAS bf16x8*)(abase + ct * 16 * SG_P + kc * 64);
#pragma unroll
                for (int it = 0; it < 4; ++it) wf[it] = *(const bf16x8*)(wbase + it * 16 * 128 + kc * 32);
#pragma unroll
                for (int ct = 0; ct < 4; ++ct)
#pragma unroll
                    for (int it = 0; it < 4; ++it) acc[ct][it] = __builtin_amdgcn_mfma_f32_16x16x32_bf16(af[ct], wf[it], acc[ct][it], 0, 0, 0);
            }
#pragma unroll
            for (int it = 0; it < 4; ++it) { const int i = 64 * th + 16 * it + cl; const float bi = bs[i];
#pragma unroll
                for (int ct = 0; ct < 4; ++ct) { bf16_t* up = proj + (size_t)(R0 + i) * NPROJ + C_U + cbase + 16 * ct + 4 * g4;
                    const unsigned long long uw = *(const unsigned long long*)up; const unsigned ulo = (unsigned)uw, uhi = (unsigned)(uw >> 32);
                    const f32x4 sv = acc[ct][it];
                    const unsigned lo = pg8::cvt_pk_bf16(bflo(ulo) * (sv[0] + bi), bfhi(ulo) * (sv[1] + bi)), hi = pg8::cvt_pk_bf16(bflo(uhi) * (sv[2] + bi), bfhi(uhi) * (sv[3] + bi));
                    *(unsigned long long*)up = (unsigned long long)lo | ((unsigned long long)hi << 32); } }
        }
    }
    __syncthreads();
}
__device__ __forceinline__ void mix_phase(const Args& a, LAS unsigned char* lds, int tid, int wave, int lane) {
    const int G = gridDim.x, bx = blockIdx.x, vcu = (G % 8 == 0) ? (bx % 8) * (G / 8) + bx / 8 : bx;
    for (int u = vcu; u < 256; u += G) { wattn_unit(a, lds, u, 0, tid, wave, lane); wattn_unit(a, lds, u, 1, tid, wave, lane); }
    for (int u = vcu; u < 256; u += G) mattn_unit(a, lds, u >> 2, u & 3, tid, wave, lane);
    for (int u = vcu; u < 256; u += G) sgu_unit(a, lds, u, tid, wave, lane);
}

__device__ __forceinline__ void ffn_edge_fix(const Args& a, int pm, int tid) {
    const float* edge = (const float*)(a.ws + WS_EDGE); bf16_t* G = (bf16_t*)(a.ws + WS_G); const float* cw = a.in[20]; const float* cb = a.in[21];
    const bool sstart = pm < 64 ? (pm & 7) == 0 : pm == 64, send = pm < 64 ? (pm & 7) == 7 : pm == 127;
    for (int idx = tid; idx < 2 * DFF; idx += NTHREADS) {
        const int bot = idx >= DFF, ch = bot ? idx - DFF : idx, j = ch >> 7, cl = ch & 127;
        const float* e0 = edge + (size_t)(pm * 22 + j) * 1024 + cl;
        float pg, pu, cg, cu, ng, nu;
        if (!bot) { cg = e0[0]; cu = e0[128]; ng = e0[256]; nu = e0[256 + 128];
            if (sstart) { pg = 0.f; pu = 0.f; } else { const float* ep = e0 - 22 * 1024 + 3 * 256; pg = ep[0]; pu = ep[128]; } }
        else { pg = e0[512]; pu = e0[512 + 128]; cg = e0[768]; cu = e0[768 + 128];
            if (send) { ng = 0.f; nu = 0.f; } else { const float* en = e0 + 22 * 1024; ng = en[0]; nu = en[128]; } }
        const float ga = pg * cw[ch] + cg * cw[NUP + ch] + ng * cw[2 * NUP + ch] + cb[ch];
        const float ua = pu * cw[DFF + ch] + cu * cw[NUP + DFF + ch] + nu * cw[2 * NUP + DFF + ch] + cb[DFF + ch];
        G[(size_t)(pm * 256 + (bot ? 255 : 0)) * DFF + ch] = (bf16_t)f2bf(gelu_tanh(ga) * ua);
    }
}

#define XB_TMO      128
#define XB_XCNT(j)  (256  + 64 * (j))
#define XB_XSUB(j)  (1280 + 64 * (j))
#define XB_XGEN(j)  (2304 + 64 * (j))
#define XB_TOP      3328
#define XB_TOPGEN   3392
#define XCD_BAR_WORDS 3456
#define XB_SPIN_CAP (1u << 20)
__device__ __forceinline__ unsigned xb_ld(unsigned* p)              { return __hip_atomic_load(p, __ATOMIC_RELAXED, __HIP_MEMORY_SCOPE_AGENT); }
__device__ __forceinline__ unsigned xb_add(unsigned* p, unsigned v) { return __hip_atomic_fetch_add(p, v, __ATOMIC_RELAXED, __HIP_MEMORY_SCOPE_AGENT); }
__device__ __forceinline__ unsigned xb_xcc_id() { return (unsigned)__builtin_amdgcn_s_getreg((3 << 11) | 20) & 0xFu; }
#define XB_SPIN(cond, bar) do { unsigned _sp = 0; while (cond) { __builtin_amdgcn_s_sleep(1); \
    if ((++_sp & 255u) == 0u) { if (xb_ld(&(bar)[XB_TMO])) break; if (_sp > XB_SPIN_CAP) { atomicAdd(&(bar)[XB_TMO], 1u); break; } } } } while (0)
struct XcdBarrier { unsigned* bar; unsigned x; volatile LAS unsigned* st; };
__device__ __forceinline__ XcdBarrier xcd_barrier_post(unsigned* bar, volatile LAS unsigned* st) {
    XcdBarrier b; b.bar = bar; b.x = xb_xcc_id(); b.st = st;
    if (threadIdx.x == 0) (void)xb_add(&bar[XB_XCNT(b.x)], 1u);
    return b;
}
__device__ __forceinline__ void xcd_barrier_complete(unsigned* bar, unsigned x, unsigned& nloc, unsigned& nx) {
    const unsigned G = gridDim.x * gridDim.y * gridDim.z;
    unsigned sum, cnt, mine, sp = 0u;
    for (;;) {
        sum = 0u; cnt = 0u; mine = 0u;
#pragma unroll
        for (unsigned j = 0; j < 16; ++j) { const unsigned c = xb_ld(&bar[XB_XCNT(j)]); sum += c; cnt += (c > 0u) ? 1u : 0u; mine = (j == x) ? c : mine; }
        if (sum == G) break;
        __builtin_amdgcn_s_sleep(1);
        if ((++sp & 255u) == 0u) { if (xb_ld(&bar[XB_TMO])) break; if (sp > XB_SPIN_CAP) { atomicAdd(&bar[XB_TMO], 1u); break; } }
    }
    nloc = mine > 0u ? mine : 1u; nx = cnt > 0u ? cnt : 1u;
}
__device__ __forceinline__ void xcd_barrier(const XcdBarrier& b) {
    asm volatile("s_waitcnt vmcnt(0)" ::: "memory");
    __syncthreads();
    if (threadIdx.x == 0) {
        unsigned* bar = b.bar;
        __builtin_amdgcn_s_waitcnt(0);
        unsigned nloc = b.st[0], nx = b.st[1];
        if (nloc == 0u) { xcd_barrier_complete(bar, b.x, nloc, nx); b.st[0] = nloc; b.st[1] = nx; }
        const unsigned old = xb_add(&bar[XB_XSUB(b.x)], 1u);
        const unsigned gen = old / nloc;
        if (old + 1u == (gen + 1u) * nloc) {
            __builtin_amdgcn_fence(__ATOMIC_RELEASE, "agent");
            asm volatile("s_waitcnt vmcnt(0)" ::: "memory");
            const unsigned og = xb_add(&bar[XB_TOP], 1u);
            const unsigned tg = og / nx;
            if (og + 1u == (tg + 1u) * nx) xb_add(&bar[XB_TOPGEN], 1u);
            else XB_SPIN(xb_ld(&bar[XB_TOPGEN]) == tg, bar);
            __builtin_amdgcn_fence(__ATOMIC_ACQUIRE, "agent");
            xb_add(&bar[XB_XGEN(b.x)], 1u);
            asm volatile("s_waitcnt vmcnt(0)" ::: "memory");
        } else {
            XB_SPIN(xb_ld(&bar[XB_XGEN(b.x)]) == gen, bar);
            __builtin_amdgcn_fence(__ATOMIC_ACQUIRE, "agent");
            asm volatile("s_waitcnt vmcnt(0)" ::: "memory");
        }
    }
    __syncthreads();
}

enum { PH_PRO = 0, PH_PROJ, PH_MIX, PH_MIX2, PH_SGU, PH_BR, PH_OUTP, PH_SSQ, PH_UP0, PH_CONV0, PH_UP1, PH_CONV1, PH_DOWN, PH_FINAL, PH_N };

__global__ void __launch_bounds__(NTHREADS, 2) fwd(Args a) {
    extern __shared__ __attribute__((aligned(16))) unsigned char lds_raw[];
    LAS unsigned char* lds = (LAS unsigned char*)lds_raw;
    cg::grid_group grid = cg::this_grid();
    Ctx c; c.tid = threadIdx.x; c.lane = c.tid & 63; c.wave = __builtin_amdgcn_readfirstlane(c.tid >> 6);
    c.gw = blockIdx.x * NWAVES + c.wave; c.ngw = gridDim.x * NWAVES; c.gtid = blockIdx.x * NTHREADS + c.tid; c.ngt = gridDim.x * NTHREADS;
    unsigned char* ws = a.ws;
    volatile LAS unsigned* misc = (volatile LAS unsigned*)(lds + MISC_OFF);
    if (c.tid < 64) misc[c.tid] = 0u;
    __syncthreads();
    const XcdBarrier xb = xcd_barrier_post((unsigned*)(ws + WS_CTL) + 1024, misc);
    if (a.coop_sync) grid.sync();
#define GRID_BAR() xcd_barrier(xb)
    p0_prologue(a, c, lds);
    GRID_BAR();
    {
        pg8::SchedPlain S; S.o.init(T / 256, NPROJ / 256, (int)gridDim.x, (int)blockIdx.x); S.A = (const char*)(ws + WS_H); S.B = (const char*)(ws + WS_WIN); S.strideA = (size_t)256 * D * 2; S.strideB = (size_t)256 * D * 2;
        pg8::EpiProj E{(bf16_t*)(ws + WS_PROJ)};
        pg8::gemm_phase(lds, D, D, S, E);
        pg8::SchedOne S2; S2.idx = ((int)blockIdx.x >= 128 && (int)blockIdx.x < 128 + 36) ? (int)blockIdx.x - 128 : -1; S2.nN = 4;
        S2.A = (const char*)(ws + WS_MEMN); S2.B = (const char*)(ws + WS_WMKV); S2.strideA = (size_t)256 * D * 2; S2.strideB = (size_t)256 * D * 2;
        pg8::EpiPlain E2{(bf16_t*)(ws + WS_MKV), 1024};
        pg8::gemm_phase(lds, D, D, S2, E2);
    }
    GRID_BAR();
    mix_phase(a, lds, c.tid, c.wave, c.lane);
    GRID_BAR();
    {
        pg8::SchedBranch S; S.o.init(T / 256, 4, (int)gridDim.x, (int)blockIdx.x, 3); S.proj = (const char*)(ws + WS_PROJ); S.wbr = (const char*)(ws + WS_WBR);
        pg8::EpiBranch E{(const bf16_t*)(ws + WS_PROJ), (bf16_t*)(ws + WS_H)};
        pg8::gemm_phase(lds, 512, NPROJ, S, E);
    }
    GRID_BAR();
    {
        pg8::SchedPlain S; S.o.init(T / 256, 4, (int)gridDim.x, (int)blockIdx.x); S.A = (const char*)(ws + WS_H); S.B = (const char*)(ws + WS_WOUT); S.strideA = (size_t)256 * D * 2; S.strideB = (size_t)256 * D * 2;
        pg8::EpiOut E{a.in[0], a.in[1], a.out, (bf16_t*)(ws + WS_H2), (float*)(ws + WS_SSQ1)};
        pg8::gemm_phase(lds, D, D, S, E);
    }
    GRID_BAR();
    {
        pg8::SchedPlain S; S.o.init(T / 256, 22, (int)gridDim.x, (int)blockIdx.x); S.A = (const char*)(ws + WS_H2); S.B = (const char*)(ws + WS_WUP); S.strideA = (size_t)256 * D * 2; S.strideB = (size_t)256 * D * 2;
        pg8::EpiUpConv E{(bf16_t*)(ws + WS_G), (const float*)(ws + WS_SSQ1), a.in[20], a.in[21], (float*)(ws + WS_EDGE), lds + 131072};
        pg8::gemm_phase(lds, D, D, S, E);
    }
    GRID_BAR();
    {
        pg8::SchedPlain S; S.o.init(T / 256, 4, (int)gridDim.x, (int)blockIdx.x); S.A = (const char*)(ws + WS_G); S.B = (const char*)(ws + WS_WDN); S.strideA = (size_t)256 * DFF * 2; S.strideB = (size_t)256 * DFF * 2;
        { int pm, pn, aux; for (int i = 0; S.o.tile(i, pm, pn, aux); ++i) ffn_edge_fix(a, pm, c.tid); }
        asm volatile("s_waitcnt vmcnt(0)" ::: "memory"); __syncthreads();
        pg8::EpiDown E{a.out};
        pg8::gemm_phase(lds, DFF, DFF, S, E);
    }
    GRID_BAR();
    final_norm(a, c);
}

extern "C" void kernel_launch(void* const* d_in, const int* in_sizes, int n_in, void* d_out, int out_size, void* d_ws, size_t ws_size, hipStream_t stream) {
    static int grid = 0;
    if (grid == 0) {
        if (n_in != 24 || out_size != T * D || ws_size < WS_END) { fprintf(stderr, "kernel_launch: unexpected shapes (n_in %d, out %d, ws %zu)\n", n_in, out_size, ws_size); grid = -1; return; }
        int dev = 0, cus = 0, per_cu = 0;
        (void)hipGetDevice(&dev); (void)hipDeviceGetAttribute(&cus, hipDeviceAttributeMultiprocessorCount, dev);
        (void)hipFuncSetAttribute((const void*)fwd, hipFuncAttributeMaxDynamicSharedMemorySize, LDS_BYTES);
        if (hipOccupancyMaxActiveBlocksPerMultiprocessor(&per_cu, (const void*)fwd, NTHREADS, LDS_BYTES) != hipSuccess || per_cu < 1) { fprintf(stderr, "kernel_launch: occupancy query says %d blocks/CU\n", per_cu); (void)hipGetLastError(); grid = -1; return; }
        grid = cus * 1;
    }
    if (grid < 0) return;
    if (hipMemsetAsync((char*)d_ws + WS_CTL, 0, 65536, stream) != hipSuccess) { fprintf(stderr, "kernel_launch: memset of the barrier words failed\n"); return; }
    Args a{};
    for (int i = 0; i < 24; ++i) a.in[i] = (const float*)d_in[i];
    a.out = (float*)d_out; a.ws = (unsigned char*)d_ws; a.coop_sync = 0; a.pad = 0;
    void* kargs[] = {&a};
    hipError_t e = hipLaunchCooperativeKernel((const void*)fwd, dim3(grid), dim3(NTHREADS), kargs, LDS_BYTES, stream);
    if (e != hipSuccess) fprintf(stderr, "cooperative launch failed: %s (grid %d)\n", hipGetErrorString(e), grid);
}
```

```cpp
#include <hip/hip_runtime.h>
#include <hip/hip_cooperative_groups.h>
namespace cg = cooperative_groups;
#include <cstdio>
#include <cstdint>

typedef unsigned short bf16_t;
typedef short bf16x8 __attribute__((ext_vector_type(8)));
typedef float f32x4 __attribute__((ext_vector_type(4)));
typedef unsigned u32x4 __attribute__((ext_vector_type(4)));
#define LAS __attribute__((address_space(3)))

constexpr int D = 1024, TP = 16384, T = 32768, SEQP = 2048;
constexpr int NPROJ = 5376, DFF = 2816, NUP = 5632, MEMROWS = 2304;
constexpr int C_Q = 0, C_K = 512, C_V = 640, C_U = 768, C_SV = 1280, C_QM = 1792, C_G = 2304;
constexpr float EPS = 1e-6f, LOG2E = 1.4426950408889634f;
constexpr float QSCALE = 0.125f * LOG2E, MSCALE = 0.08838834764831845f * LOG2E;
constexpr int NTHREADS = 512, NWAVES = 8;

constexpr size_t MiB = 1u << 20;
constexpr size_t WS_CTL = 0;
constexpr size_t WS_WIN = 2 * MiB;
constexpr size_t WS_WMKV = 13 * MiB;
constexpr size_t WS_WBR = 15 * MiB;
constexpr size_t WS_WOUT = 18 * MiB;
constexpr size_t WS_WUP = 20 * MiB;
constexpr size_t WS_WDN = 31 * MiB;
constexpr size_t WS_SGUW = 37 * MiB;
constexpr size_t WS_MEMN = 38 * MiB;
constexpr size_t WS_MKV = 43 * MiB;
constexpr size_t WS_SSQ1 = 48 * MiB;
constexpr size_t WS_STAT = 50 * MiB;
constexpr size_t WS_H = 52 * MiB;
constexpr size_t WS_PROJ = 116 * MiB;
constexpr size_t WS_AUP = 52 * MiB;
constexpr size_t WS_G = 228 * MiB;
constexpr size_t WS_EDGE = 404 * MiB;
constexpr size_t WS_H2 = 448 * MiB;
constexpr size_t WS_END = 512 * MiB;

constexpr int LDS_BYTES = 147456, MISC_OFF = 147456 - 256;

__device__ __forceinline__ float bf2f(bf16_t v) { return __uint_as_float((unsigned)v << 16); }
__device__ __forceinline__ unsigned f2bf(float f) { unsigned u = __float_as_uint(f); return (u + 0x7fffu + ((u >> 16) & 1u)) >> 16; }
__device__ __forceinline__ unsigned pk2(float lo, float hi) { return f2bf(lo) | (f2bf(hi) << 16); }
__device__ __forceinline__ float gelu_tanh(float x) {
    const float u = x * (1.0f + 0.044715f * x * x) * (2.0f * 0.7978845608028654f * LOG2E);
    return x * __builtin_amdgcn_rcpf(1.0f + __builtin_amdgcn_exp2f(-u));
}
__device__ __forceinline__ float sigmoid_f(float x) { return __builtin_amdgcn_rcpf(1.0f + __builtin_amdgcn_exp2f(-x * LOG2E)); }
__device__ __forceinline__ float wave_sum(float v) {
#pragma unroll
    for (int o = 1; o < 64; o <<= 1) v += __shfl_xor(v, o);
    return v;
}
__device__ __forceinline__ int t5_bucket(int rel) {
    const int n = rel < 0 ? -rel : rel; const int ret = rel > 0 ? 16 : 0;
    if (n < 8) return ret + n;
    int l = (31 - __builtin_clz((unsigned)(n * n))) + 2; if (l > 15) l = 15;
    return ret + l;
}

struct Args {
    const float* in[24];
    float* out; unsigned char* ws;
    int coop_sync, pad;
};

struct Ctx { int tid, lane, wave, gw, ngw, gtid, ngt; };

__device__ __forceinline__ const float* xrow(const Args& a, int r) { return r < TP ? a.in[0] + (size_t)r * D : a.in[1] + (size_t)(r - TP) * D; }
__device__ __forceinline__ const float* memrow(const Args& a, int r) { return r < 2048 ? a.in[2] + (size_t)r * D : a.in[3] + (size_t)(r - 2048) * D; }

__device__ __forceinline__ void tr_item(const float* W, int K, int N, bf16_t* WT, const float* ks, int upmap, LAS float* scr, int item, int lane) {
    const int nblk = N / 32, kb = item / nblk, nb = item % nblk, k0 = 64 * kb, n0 = 32 * nb;
#pragma unroll 8
    for (int i = 0; i < 32; ++i) { const int kk = 2 * i + (lane >> 5); float v = W[(size_t)(k0 + kk) * N + n0 + (lane & 31)]; if (ks) v *= ks[k0 + kk]; scr[kk * 33 + (lane & 31)] = v; }
    asm volatile("s_waitcnt lgkmcnt(0)" ::: "memory");
    int r0 = n0;
    if (upmap) { if (n0 < DFF) r0 = 256 * (n0 / 128) + (n0 % 128); else { const int m = n0 - DFF; r0 = 256 * (m / 128) + 128 + (m % 128); } }
    const int c = lane & 7;
#pragma unroll
    for (int j = 0; j < 4; ++j) { const int n = (lane >> 3) + 8 * j; const LAS float* s = scr + (8 * c) * 33 + n;
        u32x4 o; o.x = pk2(s[0 * 33], s[1 * 33]); o.y = pk2(s[2 * 33], s[3 * 33]); o.z = pk2(s[4 * 33], s[5 * 33]); o.w = pk2(s[6 * 33], s[7 * 33]);
        *(u32x4*)(WT + (size_t)(r0 + n) * K + k0 + 8 * c) = o; }
    asm volatile("s_waitcnt lgkmcnt(0)" ::: "memory");
}
__device__ __forceinline__ void rms_row_to_bf16(const float* xr, const float* g, bf16_t* orow, int lane) {
    f32x4 v[4]; float s = 0.f;
#pragma unroll
    for (int j = 0; j < 4; ++j) { v[j] = ((const f32x4*)xr)[lane + 64 * j]; s += (v[j].x * v[j].x + v[j].y * v[j].y) + (v[j].z * v[j].z + v[j].w * v[j].w); }
    const float rstd = 1.0f / sqrtf(wave_sum(s) * (1.0f / D) + EPS);
#pragma unroll
    for (int j = 0; j < 4; ++j) { const f32x4 gg = ((const f32x4*)g)[lane + 64 * j];
        const unsigned lo = pk2(v[j].x * rstd * gg.x, v[j].y * rstd * gg.y), hi = pk2(v[j].z * rstd * gg.z, v[j].w * rstd * gg.w);
        ((unsigned long long*)orow)[lane + 64 * j] = (unsigned long long)lo | ((unsigned long long)hi << 32); }
}
__device__ __forceinline__ void p0_prologue(const Args& a, const Ctx& c, LAS unsigned char* lds) {
    LAS float* scr = (LAS float*)(lds + c.wave * 16384);
    unsigned char* ws = a.ws;
    constexpr int I_IN = 16 * (NPROJ / 32), I_MKV = 16 * 32, I_BR = 8 * 32, I_OUT = 16 * 32, I_UP = 16 * (NUP / 32), I_DN = (DFF / 64) * 32;
    constexpr int NITEMS = I_IN + I_MKV + 3 * I_BR + I_OUT + I_UP + I_DN;
    for (int it = c.gw; it < NITEMS; it += c.ngw) {
        int r = it;
        if (r < I_IN) { tr_item(a.in[6], D, NPROJ, (bf16_t*)(ws + WS_WIN), nullptr, 0, scr, r, c.lane); continue; } r -= I_IN;
        if (r < I_MKV) { tr_item(a.in[13], D, 1024, (bf16_t*)(ws + WS_WMKV), nullptr, 0, scr, r, c.lane); continue; } r -= I_MKV;
        if (r < I_BR) { tr_item(a.in[14], 512, 1024, (bf16_t*)(ws + WS_WBR), nullptr, 0, scr, r, c.lane); continue; } r -= I_BR;
        if (r < I_BR) { tr_item(a.in[15], 512, 1024, (bf16_t*)(ws + WS_WBR + 1 * MiB), nullptr, 0, scr, r, c.lane); continue; } r -= I_BR;
        if (r < I_BR) { tr_item(a.in[16], 512, 1024, (bf16_t*)(ws + WS_WBR + 2 * MiB), nullptr, 0, scr, r, c.lane); continue; } r -= I_BR;
        if (r < I_OUT) { tr_item(a.in[17], D, 1024, (bf16_t*)(ws + WS_WOUT), nullptr, 0, scr, r, c.lane); continue; } r -= I_OUT;
        if (r < I_UP) { tr_item(a.in[19], D, NUP, (bf16_t*)(ws + WS_WUP), a.in[18], 1, scr, r, c.lane); continue; } r -= I_UP;
        tr_item(a.in[22], DFF, 1024, (bf16_t*)(ws + WS_WDN), nullptr, 0, scr, r, c.lane);
    }
    { bf16_t* o = (bf16_t*)(ws + WS_SGUW); const float* w = a.in[8];
      for (int i = c.gtid; i < 4 * 128 * 128 / 2; i += c.ngt) ((unsigned*)o)[i] = pk2(w[2 * i], w[2 * i + 1]); }
    for (int m = c.gw; m < T; m += c.ngw) rms_row_to_bf16(xrow(a, m), a.in[5], (bf16_t*)(ws + WS_H) + (size_t)m * D, c.lane);
    for (int m = c.gw; m < MEMROWS; m += c.ngw) rms_row_to_bf16(memrow(a, m), a.in[12], (bf16_t*)(ws + WS_MEMN) + (size_t)m * D, c.lane);
}

__device__ __forceinline__ void wt_mma(f32x4 (&acc)[4][4], const bf16_t* A, int lda, const bf16_t* B, int ldb, int K, int lane) {
    const bf16_t* a0 = A + (size_t)(lane & 15) * lda + 8 * (lane >> 4);
    const bf16_t* b0 = B + (size_t)(lane & 15) * ldb + 8 * (lane >> 4);
    for (int k = 0; k < K; k += 32) {
        bf16x8 af[4], bfr[4];
#pragma unroll
        for (int i = 0; i < 4; ++i) { af[i] = *(const bf16x8*)(a0 + (size_t)i * 16 * lda + k); bfr[i] = *(const bf16x8*)(b0 + (size_t)i * 16 * ldb + k); }
#pragma unroll
        for (int i = 0; i < 4; ++i)
#pragma unroll
            for (int j = 0; j < 4; ++j) acc[i][j] = __builtin_amdgcn_mfma_f32_16x16x32_bf16(af[i], bfr[j], acc[i][j], 0, 0, 0);
    }
}
__device__ __forceinline__ void zero_acc(f32x4 (&acc)[4][4]) {
#pragma unroll
    for (int i = 0; i < 4; ++i)
#pragma unroll
        for (int j = 0; j < 4; ++j) acc[i][j] = (f32x4){0.f, 0.f, 0.f, 0.f};
}
template <class Epi>
__device__ __forceinline__ void sgemm_phase(const bf16_t* A, int lda, const bf16_t* Bt, int ldb, int M, int N, int K, const Epi& epi, const Ctx& c) {
    const int nN = N / 64, ntask = (M / 64) * nN;
    for (int t = c.gw; t < ntask; t += c.ngw) {
        const int tm = t / nN, tn = t % nN;
        f32x4 acc[4][4]; zero_acc(acc);
        wt_mma(acc, A + (size_t)tm * 64 * lda, lda, Bt + (size_t)tn * 64 * ldb, ldb, K, c.lane);
#pragma unroll
        for (int i = 0; i < 4; ++i)
#pragma unroll
            for (int r = 0; r < 4; ++r) { const int row = tm * 64 + 16 * i + 4 * (c.lane >> 4) + r; const float rs = epi.rowpre(row);
#pragma unroll
                for (int j = 0; j < 4; ++j) epi(row, tn * 64 + 16 * j + (c.lane & 15), acc[i][j][r] * rs); }
    }
}

struct EpiProjN { bf16_t* P;
    __device__ __forceinline__ float rowpre(int) const { return 1.0f; }
    __device__ __forceinline__ void operator()(int r, int col, float v) const {
        float o;
        if (col < C_K) o = v * QSCALE; else if (col < C_U) o = v; else if (col < C_QM) o = gelu_tanh(v); else if (col < C_G) o = v * MSCALE; else o = sigmoid_f(v);
        P[(size_t)r * NPROJ + col] = (bf16_t)f2bf(o); } };
struct EpiBf16N { bf16_t* P; int ldc;
    __device__ __forceinline__ float rowpre(int) const { return 1.0f; }
    __device__ __forceinline__ void operator()(int r, int col, float v) const { P[(size_t)r * ldc + col] = (bf16_t)f2bf(v); } };
struct EpiOutN { const Args* a; bf16_t* H2;
    __device__ __forceinline__ float rowpre(int) const { return 1.0f; }
    __device__ __forceinline__ void operator()(int r, int col, float v) const { const float x1 = xrow(*a, r)[col] + v; a->out[(size_t)r * D + col] = x1; H2[(size_t)r * D + col] = (bf16_t)f2bf(x1); } };
struct EpiUpN { bf16_t* AUP; const float* ssq;
    __device__ __forceinline__ float rowpre(int r) const {
        float s = 0.f;
#pragma unroll
        for (int i = 0; i < 16; ++i) s += ssq[(size_t)r * 16 + i];
        return 1.0f / sqrtf(s * (1.0f / D) + EPS); }
    __device__ __forceinline__ void operator()(int r, int col, float v) const { AUP[(size_t)r * DFF + col] = (bf16_t)f2bf(v); } };
struct EpiDownN { float* out;
    __device__ __forceinline__ float rowpre(int) const { return 1.0f; }
    __device__ __forceinline__ void operator()(int r, int col, float v) const { out[(size_t)r * D + col] += v; } };

__device__ __forceinline__ float dot8(bf16x8 a, bf16x8 b) {
    float s = 0.f;
#pragma unroll
    for (int i = 0; i < 8; ++i) s += bf2f((bf16_t)a[i]) * bf2f((bf16_t)b[i]);
    return s;
}
__device__ __forceinline__ void naive_wattn(const Args& a, const Ctx& c) {
    bf16_t* proj = (bf16_t*)(a.ws + WS_PROJ);
    const float* relb = a.in[4]; const float* sink = a.in[7];
    for (int idx = c.gtid; idx < T * 8; idx += c.ngt) {
        const int h = idx & 7, row = idx >> 3, kvh = h >> 2;
        const int s0 = row < TP ? (row & ~(SEQP - 1)) : TP, S = row < TP ? SEQP : TP, pos = row - s0;
        bf16x8 q[8]; float o[64];
        bf16_t* qp = proj + (size_t)row * NPROJ + C_Q + h * 64;
#pragma unroll
        for (int d = 0; d < 8; ++d) q[d] = ((const bf16x8*)qp)[d];
#pragma unroll
        for (int d = 0; d < 64; ++d) o[d] = 0.f;
        float m = sink[h] * LOG2E, l = 1.0f;
        const int j0 = pos - 128 < 0 ? 0 : pos - 128, j1 = pos + 128 > S - 1 ? S - 1 : pos + 128;
        for (int j = j0; j <= j1; ++j) {
            const bf16x8* kp = (const bf16x8*)(proj + (size_t)(s0 + j) * NPROJ + C_K + kvh * 64);
            const bf16x8* vp = (const bf16x8*)(proj + (size_t)(s0 + j) * NPROJ + C_V + kvh * 64);
            float s = 0.f;
#pragma unroll
            for (int d = 0; d < 8; ++d) s += dot8(q[d], kp[d]);
            s += relb[t5_bucket(j - pos) * 8 + h] * LOG2E;
            if (s > m) { const float f = __builtin_amdgcn_exp2f(m - s); l *= f;
#pragma unroll
                for (int d = 0; d < 64; ++d) o[d] *= f;
                m = s; }
            const float p = __builtin_amdgcn_exp2f(s - m); l += p;
#pragma unroll
            for (int d = 0; d < 8; ++d) { const bf16x8 v = vp[d];
#pragma unroll
                for (int e = 0; e < 8; ++e) o[8 * d + e] += p * bf2f((bf16_t)v[e]); }
        }
        const float il = 1.0f / l;
#pragma unroll
        for (int d = 0; d < 64; ++d) qp[d] = (bf16_t)f2bf(o[d] * il);
    }
}
__device__ __forceinline__ void naive_mattn(const Args& a, const Ctx& c) {
    bf16_t* proj = (bf16_t*)(a.ws + WS_PROJ); const bf16_t* mkv = (const bf16_t*)(a.ws + WS_MKV);
    for (int idx = c.gtid; idx < T * 8; idx += c.ngt) {
        const int half = idx & 1, h = (idx >> 1) & 3, row = idx >> 3;
        const int b = row < TP ? row / SEQP : 8;
        bf16_t* qp = proj + (size_t)row * NPROJ + C_QM + h * 128;
        bf16x8 q[16]; float o[64];
#pragma unroll
        for (int d = 0; d < 16; ++d) q[d] = ((const bf16x8*)qp)[d];
#pragma unroll
        for (int d = 0; d < 64; ++d) o[d] = 0.f;
        float m = -3.0e38f, l = 0.f;
        for (int j = 0; j < 256; ++j) {
            const bf16x8* kp = (const bf16x8*)(mkv + (size_t)(b * 256 + j) * 1024 + h * 128);
            const bf16x8* vp = (const bf16x8*)(mkv + (size_t)(b * 256 + j) * 1024 + 512 + h * 128 + half * 64);
            float s = 0.f;
#pragma unroll
            for (int d = 0; d < 16; ++d) s += dot8(q[d], kp[d]);
            if (s > m) { const float f = __builtin_amdgcn_exp2f(m - s); l *= f;
#pragma unroll
                for (int d = 0; d < 64; ++d) o[d] *= f;
                m = s; }
            const float p = __builtin_amdgcn_exp2f(s - m); l += p;
#pragma unroll
            for (int d = 0; d < 8; ++d) { const bf16x8 v = vp[d];
#pragma unroll
                for (int e = 0; e < 8; ++e) o[8 * d + e] += p * bf2f((bf16_t)v[e]); }
        }
        const float il = 1.0f / l;
        asm volatile("" ::: "memory");
#pragma unroll
        for (int d = 0; d < 64; ++d) qp[half * 64 + d] = (bf16_t)f2bf(o[d] * il);
    }
}
__device__ __forceinline__ void naive_sgu_stats(const Args& a, const Ctx& c) {
    const bf16_t* proj = (const bf16_t*)(a.ws + WS_PROJ); float* stat = (float*)(a.ws + WS_STAT);
    for (int row = c.gw; row < T; row += c.ngw) {
        const bf16_t* vp = proj + (size_t)row * NPROJ + C_SV;
        float v[8]; float s = 0.f;
#pragma unroll
        for (int i = 0; i < 8; ++i) { v[i] = bf2f(vp[c.lane * 8 + i]); s += v[i]; }
        const float mu = wave_sum(s) * (1.0f / 512.0f); float q = 0.f;
#pragma unroll
        for (int i = 0; i < 8; ++i) { const float d = v[i] - mu; q += d * d; }
        const float rstd = 1.0f / sqrtf(wave_sum(q) * (1.0f / 512.0f) + EPS);
        if (c.lane == 0) { stat[2 * row] = mu; stat[2 * row + 1] = rstd; }
    }
}
__device__ __forceinline__ void naive_sgu(const Args& a, const Ctx& c) {
    bf16_t* proj = (bf16_t*)(a.ws + WS_PROJ); const float* stat = (const float*)(a.ws + WS_STAT);
    const float* w_s = a.in[8]; const float* b_s = a.in[9]; const float* lng = a.in[10]; const float* lnb = a.in[11];
    for (int idx = c.gtid; idx < T * 512; idx += c.ngt) {
        const int ch = idx & 511, row = idx >> 9, g = ch >> 7, i = row & 127, r0 = row & ~127;
        const float gg = lng[ch], bb = lnb[ch];
        float acc = 0.f;
        for (int j = 0; j < 128; ++j) {
            const float v = bf2f(proj[(size_t)(r0 + j) * NPROJ + C_SV + ch]);
            const float vn = (v - stat[2 * (r0 + j)]) * stat[2 * (r0 + j) + 1] * gg + bb;
            acc += w_s[(g * 128 + i) * 128 + j] * vn;
        }
        acc += b_s[g * 128 + i];
        bf16_t* up = proj + (size_t)row * NPROJ + C_U + ch;
        *up = (bf16_t)f2bf(bf2f(*up) * acc);
    }
}
__device__ __forceinline__ void naive_branch(const Args& a, const Ctx& c) {
    const bf16_t* proj = (const bf16_t*)(a.ws + WS_PROJ); bf16_t* merged = (bf16_t*)(a.ws + WS_H);
    const int nN = 1024 / 64, ntask = (T / 64) * nN;
    for (int t = c.gw; t < ntask; t += c.ngw) {
        const int tm = t / nN, tn = t % nN;
        f32x4 m[4][4]; zero_acc(m);
#pragma unroll 1
        for (int br = 0; br < 3; ++br) {
            const int acol = br == 0 ? C_Q : (br == 1 ? C_U : C_QM);
            f32x4 acc[4][4]; zero_acc(acc);
            wt_mma(acc, proj + (size_t)tm * 64 * NPROJ + acol, NPROJ, (const bf16_t*)(a.ws + WS_WBR + br * MiB) + (size_t)tn * 64 * 512, 512, 512, c.lane);
#pragma unroll
            for (int i = 0; i < 4; ++i)
#pragma unroll
                for (int j = 0; j < 4; ++j)
#pragma unroll
                    for (int r = 0; r < 4; ++r) { const int row = tm * 64 + 16 * i + 4 * (c.lane >> 4) + r, col = tn * 64 + 16 * j + (c.lane & 15);
                        m[i][j][r] += bf2f(proj[(size_t)row * NPROJ + C_G + br * 1024 + col]) * acc[i][j][r]; }
        }
#pragma unroll
        for (int i = 0; i < 4; ++i)
#pragma unroll
            for (int j = 0; j < 4; ++j)
#pragma unroll
                for (int r = 0; r < 4; ++r) { const int row = tm * 64 + 16 * i + 4 * (c.lane >> 4) + r, col = tn * 64 + 16 * j + (c.lane & 15);
                    merged[(size_t)row * D + col] = (bf16_t)f2bf(m[i][j][r]); }
    }
}
__device__ __forceinline__ void naive_ssq(const Args& a, const Ctx& c) {
    float* ssq = (float*)(a.ws + WS_SSQ1);
    for (int row = c.gw; row < T; row += c.ngw) {
        const f32x4* xr = (const f32x4*)(a.out + (size_t)row * D); float s = 0.f;
#pragma unroll
        for (int j = 0; j < 4; ++j) { const f32x4 v = xr[c.lane + 64 * j]; s += (v.x * v.x + v.y * v.y) + (v.z * v.z + v.w * v.w); }
        s = wave_sum(s);
        if (c.lane < 16) ssq[(size_t)row * 16 + c.lane] = c.lane == 0 ? s : 0.f;
    }
}
__device__ __forceinline__ void naive_conv(const Args& a, const Ctx& c, int half) {
    const bf16_t* aup = (const bf16_t*)(a.ws + WS_AUP); bf16_t* g = (bf16_t*)(a.ws + WS_G);
    const float* cw = a.in[20]; const float* cb = a.in[21];
    for (int idx = c.gtid; idx < T * 1408; idx += c.ngt) {
        const int row = idx / 1408, lc = idx % 1408, jj = lc >> 7, ii = lc & 127, ch = half * 1408 + lc;
        const int s0 = row < TP ? (row & ~(SEQP - 1)) : TP, S = row < TP ? SEQP : TP, pos = row - s0;
        const size_t o = (size_t)row * DFF + 256 * jj + ii;
        const float g1 = bf2f(aup[o]), u1 = bf2f(aup[o + 128]);
        const float g0 = pos > 0 ? bf2f(aup[o - DFF]) : 0.f, u0 = pos > 0 ? bf2f(aup[o - DFF + 128]) : 0.f;
        const float g2 = pos < S - 1 ? bf2f(aup[o + DFF]) : 0.f, u2 = pos < S - 1 ? bf2f(aup[o + DFF + 128]) : 0.f;
        const float ga = g0 * cw[ch] + g1 * cw[NUP + ch] + g2 * cw[2 * NUP + ch] + cb[ch];
        const float ua = u0 * cw[DFF + ch] + u1 * cw[NUP + DFF + ch] + u2 * cw[2 * NUP + DFF + ch] + cb[DFF + ch];
        g[(size_t)row * DFF + ch] = (bf16_t)f2bf(gelu_tanh(ga) * ua);
    }
}
__device__ __forceinline__ void final_norm(const Args& a, const Ctx& c) {
    const float* gf = a.in[23];
    for (int row = c.gw; row < T; row += c.ngw) {
        f32x4* xr = (f32x4*)(a.out + (size_t)row * D); f32x4 v[4]; float s = 0.f;
#pragma unroll
        for (int j = 0; j < 4; ++j) { v[j] = xr[c.lane + 64 * j]; s += (v[j].x * v[j].x + v[j].y * v[j].y) + (v[j].z * v[j].z + v[j].w * v[j].w); }
        const float rstd = 1.0f / sqrtf(wave_sum(s) * (1.0f / D) + EPS);
#pragma unroll
        for (int j = 0; j < 4; ++j) { const f32x4 gg = ((const f32x4*)gf)[c.lane + 64 * j]; xr[c.lane + 64 * j] = (f32x4){v[j].x * rstd * gg.x, v[j].y * rstd * gg.y, v[j].z * rstd * gg.z, v[j].w * rstd * gg.w}; }
    }
}

namespace pg8 {
constexpr int BM = 256, BK = 64, HALF = 128, HTB = HALF * BK * 2, STAGE_BYTES = 8 * HTB, NXCD = 8, WGM = 8;
__host__ __device__ __forceinline__ int lds_byte(int r, int c) { const int st = (r >> 4) * 2 + (c >> 5), rr = r & 15, cc = c & 31, ob = rr * 64 + cc * 2; return st * 1024 + (ob ^ (((ob >> 9) & 1) << 5)); }
__host__ __device__ __forceinline__ void stage_rc(int b, int& R, int& C) { const int st = b / 1024, sb = b % 1024, swz = sb ^ (((sb >> 9) & 1) << 5); R = (st >> 1) * 16 + swz / 64; C = (st & 1) * 32 + (swz % 64) / 2; }
__host__ __device__ __forceinline__ int perm32(int rho) { const int n = rho >> 4, i = rho & 15; return 8 * (i >> 2) + 4 * n + (i & 3); }

struct Unit { const char* A; const char* B; int pm, pn, aux; };

struct TileOrder {
    int nM, nN, nwg, G, c, rep;
    __device__ __forceinline__ void init(int nM_, int nN_, int G_, int c_, int rep_ = 1) { nM = nM_; nN = nN_; nwg = nM * nN; G = G_; c = c_; rep = rep_; }
    __device__ __forceinline__ bool tile(int i, int& pm, int& pn, int& aux) const {
        const int ti = i / rep; aux = i - ti * rep;
        const long L = (long)ti * G + c; if (L >= nwg) return false;
        int wgid = (int)L; { const int q = nwg / NXCD, r = nwg % NXCD, xcd = wgid % NXCD, off = wgid / NXCD; wgid = (xcd < r ? xcd * (q + 1) : r * (q + 1) + (xcd - r) * q) + off; }
        const int nig = WGM * nN, gid = wgid / nig, fm = gid * WGM, gsz = (nM - fm) < WGM ? (nM - fm) : WGM;
        pm = fm + ((wgid % nig) % gsz); pn = (wgid % nig) / gsz; return true;
    }
};
__device__ __forceinline__ unsigned cvt_pk_bf16(float lo, float hi) { unsigned r; asm volatile("v_cvt_pk_bf16_f32 %0, %1, %2" : "=v"(r) : "v"(lo), "v"(hi)); return r; }

template <class Epi, class Sched, bool ALIGN_EPI = true, bool SP2 = true>
__device__ __forceinline__ void gemm_phase(LAS unsigned char* lds, const int K, const int lda, const Sched& S, const Epi& E) {
    const int tid = threadIdx.x, wid = __builtin_amdgcn_readfirstlane(tid >> 6), lane = tid & 63, wr = wid >> 2, wc = wid & 3, fr = lane & 15, fq = lane >> 4;
    const int nt = K / BK;
    unsigned voffA[2], voffB[2];
#pragma unroll
    for (int i = 0; i < 2; ++i) { int R, C; stage_rc(tid * 16 + i * 8192, R, C); const int Rb = Epi::PERM ? ((R & ~31) + perm32(R & 31)) : R;
        voffA[i] = (unsigned)(R * lda + C) * 2u; voffB[i] = (unsigned)(Rb * K + C) * 2u; }
    const size_t kstep = (size_t)(BK * 2);
    const size_t hstepA = (size_t)HALF * lda * 2, hstepB = (size_t)HALF * K * 2;
    const unsigned ldsw = (unsigned)wid * 1024u;
    const int aoff = lds_byte(wr * 64 + fr, fq * 8), boff = lds_byte(wc * 32 + fr, fq * 8);
#define PG8_SA(b, h) (((b) * 2 + (h)) * HTB)
#define PG8_SB(b, h) ((4 + (b) * 2 + (h)) * HTB)
#define PG8_STAGE(bufoff, gbase, voff) do { _Pragma("unroll") for (int _i = 0; _i < 2; ++_i) \
        __builtin_amdgcn_global_load_lds((const unsigned*)((const char*)(gbase) + (voff)[_i]), (LAS unsigned*)(lds + (bufoff) + ldsw + _i * 8192), 16, 0, 0); } while (0)
#define PG8_LDA(dst, b, h) do { _Pragma("unroll") for (int m = 0; m < 4; ++m) _Pragma("unroll") for (int k = 0; k < 2; ++k) dst[m][k] = *(const LAS bf16x8*)(lds + PG8_SA(b, h) + aoff + m * 2048 + k * 1024); } while (0)
#define PG8_LDB(dst, b, h) do { _Pragma("unroll") for (int n = 0; n < 2; ++n) _Pragma("unroll") for (int k = 0; k < 2; ++k) dst[n][k] = *(const LAS bf16x8*)(lds + PG8_SB(b, h) + boff + n * 2048 + k * 1024); } while (0)
#define PG8_MMA(ai, bj, At, Bt) do { __builtin_amdgcn_s_setprio(1); _Pragma("unroll") for (int m = 0; m < 4; ++m) _Pragma("unroll") for (int n = 0; n < 2; ++n) _Pragma("unroll") for (int k = 0; k < 2; ++k) \
        acc[ai][bj][m][n] = __builtin_amdgcn_mfma_f32_16x16x32_bf16(Bt[n][k], At[m][k], acc[ai][bj][m][n], 0, 0, 0); __builtin_amdgcn_s_setprio(0); } while (0)
#define PG8_WAIT_V(n) asm volatile("s_waitcnt vmcnt(" #n ")" ::: "memory")
#define PG8_WAIT_L(n) asm volatile("s_waitcnt lgkmcnt(" #n ")" ::: "memory")
#define PG8_BAR __builtin_amdgcn_s_barrier()
#define PG8_SCHED __builtin_amdgcn_sched_barrier(0)
    Unit cur, nxt; int ui = 0;
    if (!S.next(0, cur)) return;
    f32x4 acc[2][2][4][2];
#pragma unroll
    for (int a = 0; a < 2; ++a)
#pragma unroll
        for (int b = 0; b < 2; ++b)
#pragma unroll
            for (int m = 0; m < 4; ++m)
#pragma unroll
                for (int n = 0; n < 2; ++n) acc[a][b][m][n] = (f32x4){0.f, 0.f, 0.f, 0.f};
    bf16x8 At[4][2], B0[2][2], B1[2][2];
    const char* cA = cur.A; const char* cB = cur.B;
    if constexpr (SP2) {
        PG8_STAGE(PG8_SB(0, 0), cB, voffB); PG8_STAGE(PG8_SB(0, 1), cB + hstepB, voffB); PG8_STAGE(PG8_SA(0, 0), cA, voffA); PG8_STAGE(PG8_SA(0, 1), cA + hstepA, voffA);
        if (wr == 1) PG8_BAR;
        PG8_WAIT_V(2); PG8_BAR;
        PG8_STAGE(PG8_SB(1, 0), cB + kstep, voffB); PG8_STAGE(PG8_SA(1, 0), cA + kstep, voffA); PG8_STAGE(PG8_SB(1, 1), cB + hstepB + kstep, voffB);
        PG8_WAIT_V(6); PG8_BAR;
    } else {
        PG8_STAGE(PG8_SB(0, 0), cB, voffB); PG8_STAGE(PG8_SA(0, 0), cA, voffA); PG8_STAGE(PG8_SB(0, 1), cB + hstepB, voffB); PG8_STAGE(PG8_SA(0, 1), cA + hstepA, voffA);
        if (wr == 1) PG8_BAR;
        PG8_WAIT_V(4); PG8_BAR;
        PG8_STAGE(PG8_SB(1, 0), cB + kstep, voffB); PG8_STAGE(PG8_SA(1, 0), cA + kstep, voffA); PG8_STAGE(PG8_SB(1, 1), cB + hstepB + kstep, voffB);
        PG8_WAIT_V(6); PG8_BAR;
    }
    for (;;) {
        const bool has_next = S.next(ui + 1, nxt);
        const char* nA = has_next ? nxt.A : cA; const char* nB = has_next ? nxt.B : cB;
        for (int t = 0; t < nt; t += 2) {
            const bool last = (t == nt - 2);
            const char* a1 = cA + (size_t)(t + 1) * kstep;
            const char* a2 = last ? nA : cA + (size_t)(t + 2) * kstep; const char* b2 = last ? nB : cB + (size_t)(t + 2) * kstep;
            const char* a3 = a2 + kstep; const char* b3 = b2 + kstep;
            if constexpr (SP2) {
            PG8_LDB(B0, 0, 0); PG8_LDB(B1, 0, 1); PG8_SCHED; PG8_LDA(At, 0, 0); PG8_STAGE(PG8_SA(1, 1), a1 + hstepA, voffA);
            PG8_WAIT_V(8); PG8_WAIT_L(0); PG8_BAR; PG8_MMA(0, 0, At, B0); PG8_MMA(0, 1, At, B1); PG8_BAR; PG8_SCHED;
            PG8_LDA(At, 0, 1); PG8_STAGE(PG8_SB(0, 0), b2, voffB); PG8_STAGE(PG8_SB(0, 1), b2 + hstepB, voffB); PG8_STAGE(PG8_SA(0, 0), a2, voffA);
            PG8_WAIT_V(8); PG8_WAIT_L(0); PG8_BAR; PG8_MMA(1, 0, At, B0); PG8_MMA(1, 1, At, B1); PG8_BAR; PG8_SCHED;
            PG8_LDB(B0, 1, 0); PG8_LDB(B1, 1, 1); PG8_SCHED; PG8_LDA(At, 1, 0); PG8_STAGE(PG8_SA(0, 1), a2 + hstepA, voffA);
            PG8_WAIT_V(8); PG8_WAIT_L(0); PG8_BAR; PG8_MMA(0, 0, At, B0); PG8_MMA(0, 1, At, B1); PG8_BAR; PG8_SCHED;
            PG8_LDA(At, 1, 1); PG8_STAGE(PG8_SB(1, 0), b3, voffB); PG8_STAGE(PG8_SB(1, 1), b3 + hstepB, voffB); PG8_STAGE(PG8_SA(1, 0), a3, voffA);
            PG8_WAIT_V(8); PG8_WAIT_L(0); PG8_BAR; PG8_MMA(1, 0, At, B0); PG8_MMA(1, 1, At, B1); PG8_BAR; PG8_SCHED;
            } else {
            PG8_LDB(B0, 0, 0); PG8_SCHED; PG8_LDA(At, 0, 0); PG8_STAGE(PG8_SA(1, 1), a1 + hstepA, voffA);
            PG8_WAIT_L(8); PG8_BAR; PG8_WAIT_L(0); PG8_MMA(0, 0, At, B0); PG8_BAR; PG8_SCHED;
            PG8_LDB(B1, 0, 1); PG8_STAGE(PG8_SB(0, 0), b2, voffB);
            PG8_BAR; PG8_WAIT_L(0); PG8_MMA(0, 1, At, B1); PG8_BAR;
            PG8_LDA(At, 0, 1); PG8_STAGE(PG8_SA(0, 0), a2, voffA);
            PG8_BAR; PG8_WAIT_L(0); PG8_MMA(1, 0, At, B0); PG8_BAR; PG8_SCHED;
            PG8_STAGE(PG8_SB(0, 1), b2 + hstepB, voffB);
            PG8_WAIT_V(6); PG8_BAR; PG8_MMA(1, 1, At, B1); PG8_BAR;
            PG8_LDB(B0, 1, 0); PG8_SCHED; PG8_LDA(At, 1, 0); PG8_STAGE(PG8_SA(0, 1), a2 + hstepA, voffA);
            PG8_WAIT_L(8); PG8_BAR; PG8_WAIT_L(0); PG8_MMA(0, 0, At, B0); PG8_BAR; PG8_SCHED;
            PG8_LDB(B1, 1, 1); PG8_STAGE(PG8_SB(1, 0), b3, voffB);
            PG8_BAR; PG8_WAIT_L(0); PG8_MMA(0, 1, At, B1); PG8_BAR;
            PG8_LDA(At, 1, 1); PG8_STAGE(PG8_SA(1, 0), a3, voffA);
            PG8_BAR; PG8_WAIT_L(0); PG8_MMA(1, 0, At, B0); PG8_BAR; PG8_SCHED;
            PG8_STAGE(PG8_SB(1, 1), b3 + hstepB, voffB);
            PG8_WAIT_V(6); PG8_BAR; PG8_MMA(1, 1, At, B1); PG8_BAR;
            }
        }
        if constexpr (ALIGN_EPI) { if (wr == 0) PG8_BAR; }
        E(acc, cur, wr, wc, fr, fq);
        if (!has_next) break;
#pragma unroll
        for (int a = 0; a < 2; ++a)
#pragma unroll
            for (int b = 0; b < 2; ++b)
#pragma unroll
                for (int m = 0; m < 4; ++m)
#pragma unroll
                    for (int n = 0; n < 2; ++n) acc[a][b][m][n] = (f32x4){0.f, 0.f, 0.f, 0.f};
        cur = nxt; cA = nA; cB = nB; ++ui;
        if constexpr (ALIGN_EPI) { if (wr == 1) PG8_BAR; }
    }
    PG8_WAIT_V(0);
    if constexpr (!ALIGN_EPI) { if (wr == 0) PG8_BAR; }
    PG8_BAR;
#undef PG8_SA
#undef PG8_SB
#undef PG8_STAGE
#undef PG8_LDA
#undef PG8_LDB
#undef PG8_MMA
#undef PG8_WAIT_V
#undef PG8_WAIT_L
#undef PG8_BAR
#undef PG8_SCHED
}

struct SchedPlain {
    TileOrder o; const char* A; const char* B; size_t strideA, strideB;
    __device__ __forceinline__ bool next(int i, Unit& u) const { int aux; if (!o.tile(i, u.pm, u.pn, aux)) return false; u.aux = aux; u.A = A + (size_t)u.pm * strideA; u.B = B + (size_t)u.pn * strideB; return true; }
};
struct SchedOne {
    int idx, nN; const char* A; const char* B; size_t strideA, strideB;
    __device__ __forceinline__ bool next(int i, Unit& u) const { if (i > 0 || idx < 0) return false; u.pm = idx / nN; u.pn = idx % nN; u.aux = 0; u.A = A + (size_t)u.pm * strideA; u.B = B + (size_t)u.pn * strideB; return true; }
};

__device__ __forceinline__ f32x4 act4(f32x4 v, int mode) {
    if (mode == 1) return v * QSCALE;
    if (mode == 3) return v * MSCALE;
    if (mode == 2) return (f32x4){gelu_tanh(v[0]), gelu_tanh(v[1]), gelu_tanh(v[2]), gelu_tanh(v[3])};
    if (mode == 4) return (f32x4){sigmoid_f(v[0]), sigmoid_f(v[1]), sigmoid_f(v[2]), sigmoid_f(v[3])};
    return v;
}
struct EpiProj {
    static constexpr bool PERM = true;
    bf16_t* P;
    __device__ __forceinline__ void operator()(const f32x4 (&acc)[2][2][4][2], const Unit& u, int wr, int wc, int fr, int fq) const {
        const int pn = u.pn, mode = pn < 2 ? 1 : (pn == 2 ? 0 : (pn < 7 ? 2 : (pn < 9 ? 3 : 4)));
        const int row0 = u.pm * BM + wr * 64 + fr, col0 = pn * BM + wc * 32 + 8 * fq;
#pragma unroll
        for (int ai = 0; ai < 2; ++ai)
#pragma unroll
            for (int m = 0; m < 4; ++m) { bf16_t* rowp = P + (size_t)(row0 + ai * HALF + m * 16) * NPROJ + col0;
#pragma unroll
                for (int bj = 0; bj < 2; ++bj) { const f32x4 v0 = act4(acc[ai][bj][m][0], mode), v1 = act4(acc[ai][bj][m][1], mode);
                    u32x4 w; w.x = cvt_pk_bf16(v0[0], v0[1]); w.y = cvt_pk_bf16(v0[2], v0[3]); w.z = cvt_pk_bf16(v1[0], v1[1]); w.w = cvt_pk_bf16(v1[2], v1[3]);
                    *(u32x4*)(rowp + bj * HALF) = w; } }
    }
};
struct EpiPlain {
    static constexpr bool PERM = true;
    bf16_t* P; int ldc;
    __device__ __forceinline__ void operator()(const f32x4 (&acc)[2][2][4][2], const Unit& u, int wr, int wc, int fr, int fq) const {
        const int row0 = u.pm * BM + wr * 64 + fr, col0 = u.pn * BM + wc * 32 + 8 * fq;
#pragma unroll
        for (int ai = 0; ai < 2; ++ai)
#pragma unroll
            for (int m = 0; m < 4; ++m) { bf16_t* rowp = P + (size_t)(row0 + ai * HALF + m * 16) * ldc + col0;
#pragma unroll
                for (int bj = 0; bj < 2; ++bj) { const f32x4 v0 = acc[ai][bj][m][0], v1 = acc[ai][bj][m][1];
                    u32x4 w; w.x = cvt_pk_bf16(v0[0], v0[1]); w.y = cvt_pk_bf16(v0[2], v0[3]); w.z = cvt_pk_bf16(v1[0], v1[1]); w.w = cvt_pk_bf16(v1[2], v1[3]);
                    *(u32x4*)(rowp + bj * HALF) = w; } }
    }
};
__device__ __forceinline__ f32x4 unpk4(unsigned a, unsigned b) { return (f32x4){__uint_as_float(a << 16), __uint_as_float(a & 0xffff0000u), __uint_as_float(b << 16), __uint_as_float(b & 0xffff0000u)}; }
struct SchedBranch {
    TileOrder o; const char* proj; const char* wbr;
    __device__ __forceinline__ bool next(int i, Unit& u) const { int aux; if (!o.tile(i, u.pm, u.pn, aux)) return false; u.aux = aux;
        const int acol = aux == 0 ? C_Q : (aux == 1 ? C_U : C_QM);
        u.A = proj + ((size_t)u.pm * 256 * NPROJ + acol) * 2; u.B = wbr + (size_t)aux * MiB + (size_t)u.pn * 256 * 512 * 2; return true; }
};
struct EpiBranch {
    static constexpr bool PERM = true;
    const bf16_t* proj; bf16_t* merged;
    __device__ __forceinline__ void operator()(const f32x4 (&acc)[2][2][4][2], const Unit& u, int wr, int wc, int fr, int fq) const {
        const int br = u.aux, row0 = u.pm * BM + wr * 64 + fr, col0 = u.pn * BM + wc * 32 + 8 * fq;
#pragma unroll
        for (int ai = 0; ai < 2; ++ai)
#pragma unroll
            for (int m = 0; m < 4; ++m) { const int row = row0 + ai * HALF + m * 16;
                const bf16_t* gp = proj + (size_t)row * NPROJ + C_G + br * 1024 + col0; bf16_t* mp = merged + (size_t)row * D + col0;
#pragma unroll
                for (int bj = 0; bj < 2; ++bj) { const u32x4 gw = *(const u32x4*)(gp + bj * HALF);
                    f32x4 v0 = acc[ai][bj][m][0] * unpk4(gw.x, gw.y), v1 = acc[ai][bj][m][1] * unpk4(gw.z, gw.w);
                    if (br > 0) { const u32x4 mw = *(const u32x4*)(mp + bj * HALF); v0 += unpk4(mw.x, mw.y); v1 += unpk4(mw.z, mw.w); }
                    u32x4 w; w.x = cvt_pk_bf16(v0[0], v0[1]); w.y = cvt_pk_bf16(v0[2], v0[3]); w.z = cvt_pk_bf16(v1[0], v1[1]); w.w = cvt_pk_bf16(v1[2], v1[3]);
                    *(u32x4*)(mp + bj * HALF) = w; } }
    }
};
struct EpiOut {
    static constexpr bool PERM = false;
    const float* xp; const float* xs; float* out; bf16_t* H2; float* ssq;
    __device__ __forceinline__ void operator()(const f32x4 (&acc)[2][2][4][2], const Unit& u, int wr, int wc, int fr, int fq) const {
        const int col0 = u.pn * BM + wc * 32 + 4 * fq;
#pragma unroll
        for (int ai = 0; ai < 2; ++ai)
#pragma unroll
            for (int m = 0; m < 4; ++m) { const int row = u.pm * BM + ai * HALF + wr * 64 + m * 16 + fr;
                const float* xr = (row < TP ? xp + (size_t)row * D : xs + (size_t)(row - TP) * D) + col0; const size_t ob = (size_t)row * D + col0; float s = 0.f;
#pragma unroll
                for (int bj = 0; bj < 2; ++bj)
#pragma unroll
                    for (int n = 0; n < 2; ++n) { const int off = bj * HALF + n * 16; const f32x4 x1 = *(const f32x4*)(xr + off) + acc[ai][bj][m][n];
                        *(f32x4*)(out + ob + off) = x1; s += (x1[0] * x1[0] + x1[1] * x1[1]) + (x1[2] * x1[2] + x1[3] * x1[3]);
                        const unsigned lo = cvt_pk_bf16(x1[0], x1[1]), hi = cvt_pk_bf16(x1[2], x1[3]);
                        *(unsigned long long*)(H2 + ob + off) = (unsigned long long)lo | ((unsigned long long)hi << 32); }
                s += __shfl_xor(s, 16); s += __shfl_xor(s, 32);
                if (fq == 0) ssq[(size_t)row * 16 + u.pn * 4 + wc] = s; }
    }
};
struct EpiDown {
    static constexpr bool PERM = false;
    float* out;
    __device__ __forceinline__ void operator()(const f32x4 (&acc)[2][2][4][2], const Unit& u, int wr, int wc, int fr, int fq) const {
        const int col0 = u.pn * BM + wc * 32 + 4 * fq;
#pragma unroll
        for (int ai = 0; ai < 2; ++ai)
#pragma unroll
            for (int m = 0; m < 4; ++m) { const int row = u.pm * BM + ai * HALF + wr * 64 + m * 16 + fr; float* op = out + (size_t)row * D + col0;
#pragma unroll
                for (int bj = 0; bj < 2; ++bj)
#pragma unroll
                    for (int n = 0; n < 2; ++n) { f32x4* o = (f32x4*)(op + bj * HALF + n * 16); *o = *o + acc[ai][bj][m][n]; } }
    }
};
struct EpiUpHalf {
    static constexpr bool PERM = true;
    bf16_t* P; const float* ssq;
    __device__ __forceinline__ void operator()(const f32x4 (&acc)[2][2][4][2], const Unit& u, int wr, int wc, int fr, int fq) const {
        const int row0 = u.pm * BM + wr * 64 + fr, col0 = u.pn * BM + wc * 32 + 8 * fq;
#pragma unroll
        for (int ai = 0; ai < 2; ++ai)
#pragma unroll
            for (int m = 0; m < 4; ++m) { const int row = row0 + ai * HALF + m * 16; bf16_t* rowp = P + (size_t)row * DFF + col0;
                const f32x4* sp = (const f32x4*)(ssq + (size_t)row * 16); const f32x4 s4 = (sp[0] + sp[1]) + (sp[2] + sp[3]);
                const float rstd = 1.0f / sqrtf(((s4[0] + s4[1]) + (s4[2] + s4[3])) * (1.0f / D) + EPS);
#pragma unroll
                for (int bj = 0; bj < 2; ++bj) { const f32x4 v0 = acc[ai][bj][m][0] * rstd, v1 = acc[ai][bj][m][1] * rstd;
                    u32x4 w; w.x = cvt_pk_bf16(v0[0], v0[1]); w.y = cvt_pk_bf16(v0[2], v0[3]); w.z = cvt_pk_bf16(v1[0], v1[1]); w.w = cvt_pk_bf16(v1[2], v1[3]);
                    *(u32x4*)(rowp + bj * HALF) = w; } }
    }
};
struct EpiUpConv {
    static constexpr bool PERM = true;
    bf16_t* G; const float* ssq; const float* cw; const float* cb; float* edge; LAS unsigned char* xch;
    __device__ __forceinline__ void operator()(f32x4 (&acc)[2][2][4][2], const Unit& u, int wr, int wc, int fr, int fq) const {
        const int lane = fq * 16 + fr;
        float rs[2];
#pragma unroll
        for (int ai = 0; ai < 2; ++ai) { const unsigned row = (unsigned)(u.pm * BM + ai * HALF + wr * 64 + lane);
            const f32x4* sp = (const f32x4*)(ssq + row * 16u); const f32x4 s4 = (sp[0] + sp[1]) + (sp[2] + sp[3]);
            rs[ai] = 1.0f / sqrtf(((s4[0] + s4[1]) + (s4[2] + s4[3])) * (1.0f / D) + EPS); }
#pragma unroll
        for (int ai = 0; ai < 2; ++ai)
#pragma unroll
            for (int m = 0; m < 4; ++m) { const float rstd = __shfl(rs[ai], 16 * m + fr);
#pragma unroll
                for (int bj = 0; bj < 2; ++bj)
#pragma unroll
                    for (int n = 0; n < 2; ++n) acc[ai][bj][m][n] = acc[ai][bj][m][n] * rstd; }
        asm volatile("" ::: "memory");
        const int colw = wc * 32 + 8 * fq;
#pragma unroll
        for (int ai = 0; ai < 2; ++ai) { const int blk = 2 * ai + wr;
            if (fr == 0) {
#pragma unroll
                for (int bj = 0; bj < 2; ++bj)
#pragma unroll
                    for (int n = 0; n < 2; ++n) *(LAS f32x4*)(xch + ((0 * 4 + blk) * 256 + bj * 128 + colw + 4 * n) * 4) = acc[ai][bj][0][n]; }
            if (fr == 15) {
#pragma unroll
                for (int bj = 0; bj < 2; ++bj)
#pragma unroll
                    for (int n = 0; n < 2; ++n) *(LAS f32x4*)(xch + ((1 * 4 + blk) * 256 + bj * 128 + colw + 4 * n) * 4) = acc[ai][bj][3][n]; } }
        { float* eb = edge + (size_t)(u.pm * 22 + u.pn) * 4 * 256 + colw;
          if (wr == 0 && fr < 2) {
#pragma unroll
              for (int bj = 0; bj < 2; ++bj)
#pragma unroll
                  for (int n = 0; n < 2; ++n) *(f32x4*)(eb + fr * 256 + bj * 128 + 4 * n) = acc[0][bj][0][n]; }
          if (wr == 1 && fr >= 14) {
#pragma unroll
              for (int bj = 0; bj < 2; ++bj)
#pragma unroll
                  for (int n = 0; n < 2; ++n) *(f32x4*)(eb + (fr - 12) * 256 + bj * 128 + 4 * n) = acc[1][bj][3][n]; } }
        asm volatile("s_waitcnt lgkmcnt(0)" ::: "memory"); __builtin_amdgcn_s_barrier(); asm volatile("" ::: "memory");
        const int srcP = (lane & 48) | ((fr + 15) & 15), srcN = (lane & 48) | ((fr + 1) & 15);
        const int ch0 = u.pn * 128 + colw;
#pragma unroll
        for (int n = 0; n < 2; ++n)
#pragma unroll
            for (int bj = 0; bj < 2; ++bj) {
                const float* cwp = cw + bj * DFF + ch0 + 4 * n;
                const f32x4 w0 = *(const f32x4*)cwp, w1 = *(const f32x4*)(cwp + NUP), w2 = *(const f32x4*)(cwp + 2 * NUP), wb = *(const f32x4*)(cb + bj * DFF + ch0 + 4 * n);
#pragma unroll
                for (int ai = 0; ai < 2; ++ai) { const int blk = 2 * ai + wr;
                    f32x4 po = blk > 0 ? *(const LAS f32x4*)(xch + ((1 * 4 + blk - 1) * 256 + bj * 128 + colw + 4 * n) * 4) : (f32x4){0.f, 0.f, 0.f, 0.f};
                    const f32x4 en = blk < 3 ? *(const LAS f32x4*)(xch + ((0 * 4 + blk + 1) * 256 + bj * 128 + colw + 4 * n) * 4) : (f32x4){0.f, 0.f, 0.f, 0.f};
#pragma unroll
                    for (int m = 0; m < 4; ++m) {
                        const f32x4 cur = acc[ai][bj][m][n], nm1 = m < 3 ? acc[ai][bj][m < 3 ? m + 1 : 3][n] : en;
                        f32x4 pv, nv;
#pragma unroll
                        for (int e = 0; e < 4; ++e) { pv[e] = __shfl(fr == 15 ? po[e] : cur[e], srcP); nv[e] = __shfl(fr == 0 ? nm1[e] : cur[e], srcN); }
                        acc[ai][bj][m][n] = pv * w0 + cur * w1 + nv * w2 + wb;
                        asm volatile("" : "+v"(acc[ai][bj][m][n]));
                        po = cur;
                    } }
                asm volatile("" ::: "memory");
            }
#pragma unroll
        for (int ai = 0; ai < 2; ++ai)
#pragma unroll
            for (int m = 0; m < 4; ++m) { const unsigned row = (unsigned)(u.pm * BM + ai * HALF + wr * 64 + m * 16 + fr);
                const f32x4 ga = acc[ai][0][m][0], gb = acc[ai][0][m][1], ua = acc[ai][1][m][0], ub = acc[ai][1][m][1];
                u32x4 w; w.x = cvt_pk_bf16(gelu_tanh(ga[0]) * ua[0], gelu_tanh(ga[1]) * ua[1]); w.y = cvt_pk_bf16(gelu_tanh(ga[2]) * ua[2], gelu_tanh(ga[3]) * ua[3]);
                w.z = cvt_pk_bf16(gelu_tanh(gb[0]) * ub[0], gelu_tanh(gb[1]) * ub[1]); w.w = cvt_pk_bf16(gelu_tanh(gb[2]) * ub[2], gelu_tanh(gb[3]) * ub[3]);
                *(u32x4*)(G + (row * (unsigned)DFF + (unsigned)ch0)) = w;
                if (m & 1) asm volatile("" ::: "memory"); }
    }
};
}

__device__ __forceinline__ bf16x8 pack8(f32x4 a, f32x4 b) {
    u32x4 w; w.x = pg8::cvt_pk_bf16(a[0], a[1]); w.y = pg8::cvt_pk_bf16(a[2], a[3]); w.z = pg8::cvt_pk_bf16(b[0], b[1]); w.w = pg8::cvt_pk_bf16(b[2], b[3]);
    return __builtin_bit_cast(bf16x8, w);
}
__device__ __forceinline__ float bflo(unsigned w) { return __uint_as_float(w << 16); }
__device__ __forceinline__ float bfhi(unsigned w) { return __uint_as_float(w & 0xffff0000u); }

constexpr int WA_K = 0, WA_KP = 144, WA_VT = 384 * 144, WA_VP = 784, WA_BT = WA_VT + 64 * 784, WA_BTC = 516;
__device__ __forceinline__ void wattn_table(const Args& a, LAS unsigned char* lds, int kvh, int tid) {
    for (int i = tid; i < 16 * WA_BTC; i += 512) { const int cp = i / WA_BTC, jp = i - cp * WA_BTC, hh = cp >> 2, s = cp & 3, rel = jp - s - 256;
        const int rc = min(max(rel, -128), 128); const float bv = a.in[4][t5_bucket(rc) * 8 + 4 * kvh + hh] * LOG2E;
        ((LAS float*)(lds + WA_BT))[i] = (rel == rc) ? bv : -1.0e30f; }
}
__device__ __forceinline__ void wattn_unit(const Args& a, LAS unsigned char* lds, int blk, int kvh, int tid, int wave, int lane, bf16_t* ob, int opitch) {
    bf16_t* proj = (bf16_t*)(a.ws + WS_PROJ);
    const int R0 = blk * 128, s0 = R0 < TP ? (R0 & ~(SEQP - 1)) : TP, S = R0 < TP ? SEQP : TP, n = (R0 - s0) >> 7, nb = S >> 7;
    const bool has_l = n > 0, has_r = n < nb - 1;
#pragma unroll
    for (int i = 0; i < 6; ++i) { const int qd = tid + 512 * i, w = qd >> 3, ch = qd & 7; const bool ok = (w >= 128 || has_l) && (w < 256 || has_r);
        const int row = min(max(R0 - 128 + w, 0), T - 1);
        u32x4 v = *(const u32x4*)(proj + (size_t)row * NPROJ + C_K + kvh * 64 + ch * 8);
        if (!ok) v = (u32x4){0u, 0u, 0u, 0u};
        *(LAS u32x4*)(lds + WA_K + w * WA_KP + ch * 16) = v; }
#pragma unroll
    for (int i = 0; i < 3; ++i) { const int p = tid + 512 * i, w = (p >> 3) * 2, ch = p & 7; const bool ok = (w >= 128 || has_l) && (w < 256 || has_r);
        const int row = min(max(R0 - 128 + w, 0), T - 2);
        const bf16_t* vp = proj + (size_t)row * NPROJ + C_V + kvh * 64 + ch * 8; u32x4 v0 = *(const u32x4*)vp, v1 = *(const u32x4*)(vp + NPROJ);
        if (!ok) { v0 = (u32x4){0u, 0u, 0u, 0u}; v1 = v0; }
#pragma unroll
        for (int e = 0; e < 4; ++e) { const unsigned x0 = v0[e], x1 = v1[e]; const int d = ch * 8 + 2 * e;
            *(LAS unsigned*)(lds + WA_VT + d * WA_VP + w * 2) = (x0 & 0xffffu) | (x1 << 16);
            *(LAS unsigned*)(lds + WA_VT + (d + 1) * WA_VP + w * 2) = (x0 >> 16) | (x1 & 0xffff0000u); } }
    __syncthreads();
    const int q = lane & 15, g = lane >> 4, hh = wave & 3, h = 4 * kvh + hh;
    const float sink2 = a.in[7][h] * LOG2E;
    const LAS unsigned char* kbase = lds + WA_K + (8 * (q >> 2) + (q & 3)) * WA_KP + g * 16;
    const LAS unsigned char* vbase = lds + WA_VT + q * WA_VP + g * 16;
#pragma unroll 1
    for (int j = 0; j < 4; ++j) {
        const int i0 = 16 * ((wave >> 2) + 2 * j), c0 = i0 >> 5, iq = i0 + q;
        bf16_t* qp = proj + (size_t)(R0 + iq) * NPROJ + C_Q + h * 64 + 8 * g;
        const bf16x8 qf0 = *(const bf16x8*)qp, qf1 = *(const bf16x8*)(qp + 32);
        const LAS unsigned char* kb = kbase + c0 * 32 * WA_KP; const LAS unsigned char* vb = vbase + c0 * 64;
        const LAS unsigned char* bb = lds + WA_BT + ((hh * 4 + (q & 3)) * WA_BTC + (8 * g + 128 - iq + (q & 3)) + 32 * c0) * 4;
        f32x4 sc[18];
#pragma unroll
        for (int t = 0; t < 18; ++t) {
            const bf16x8 k0 = *(const LAS bf16x8*)(kb + (t >> 1) * 32 * WA_KP + (t & 1) * 4 * WA_KP), k1 = *(const LAS bf16x8*)(kb + (t >> 1) * 32 * WA_KP + (t & 1) * 4 * WA_KP + 64);
            f32x4 z = *(const LAS f32x4*)(bb + (32 * (t >> 1) + 4 * (t & 1)) * 4);
            z = __builtin_amdgcn_mfma_f32_16x16x32_bf16(k0, qf0, z, 0, 0, 0); sc[t] = __builtin_amdgcn_mfma_f32_16x16x32_bf16(k1, qf1, z, 0, 0, 0); }
        if (!(has_l && has_r)) {
#pragma unroll
            for (int t = 0; t < 18; ++t)
#pragma unroll
                for (int r = 0; r < 4; ++r) { const int w = 32 * (c0 + (t >> 1)) + 8 * g + 4 * (t & 1) + r; if ((w < 128 && !has_l) || (w >= 256 && !has_r)) sc[t][r] = -1.0e30f; }
        }
        float mx = sink2;
#pragma unroll
        for (int t = 0; t < 18; ++t) mx = fmaxf(fmaxf(mx, fmaxf(sc[t][0], sc[t][1])), fmaxf(sc[t][2], sc[t][3]));
        mx = fmaxf(mx, __shfl_xor(mx, 16)); mx = fmaxf(mx, __shfl_xor(mx, 32));
        float sum = 0.f;
#pragma unroll
        for (int t = 0; t < 18; ++t)
#pragma unroll
            for (int r = 0; r < 4; ++r) { const float p = __builtin_amdgcn_exp2f(sc[t][r] - mx); sc[t][r] = p; sum += p; }
        sum += __shfl_xor(sum, 16); sum += __shfl_xor(sum, 32);
        const float inv = __builtin_amdgcn_rcpf(sum + __builtin_amdgcn_exp2f(sink2 - mx));
        f32x4 o[4];
#pragma unroll
        for (int dt = 0; dt < 4; ++dt) o[dt] = (f32x4){0.f, 0.f, 0.f, 0.f};
#pragma unroll
        for (int c = 0; c < 9; ++c) { const bf16x8 pf = pack8(sc[2 * c], sc[2 * c + 1]);
#pragma unroll
            for (int dt = 0; dt < 4; ++dt) { const bf16x8 vf = *(const LAS bf16x8*)(vb + dt * 16 * WA_VP + c * 64);
                o[dt] = __builtin_amdgcn_mfma_f32_16x16x32_bf16(pf, vf, o[dt], 0, 0, 0); } }
#pragma unroll
        for (int r = 0; r < 4; ++r) { const float ir = __shfl(inv, 4 * g + r); bf16_t* op = ob + (size_t)(R0 + i0 + 4 * g + r) * opitch + h * 64 + q;
#pragma unroll
            for (int dt = 0; dt < 4; ++dt) op[16 * dt] = (bf16_t)f2bf(o[dt][r] * ir); }
    }
    __syncthreads();
}

constexpr int MA_K = 0, MA_KP = 272, MA_VT = 256 * 272, MA_VP = 528;
__device__ __forceinline__ void mattn_unit(const Args& a, LAS unsigned char* lds, int tile, int hm, int tid, int wave, int lane, bf16_t* ob, int opitch) {
    bf16_t* proj = (bf16_t*)(a.ws + WS_PROJ); const bf16_t* mkv = (const bf16_t*)(a.ws + WS_MKV);
    const int R0 = tile * 512, b = R0 < TP ? R0 / SEQP : 8;
    const bf16_t* kb = mkv + (size_t)b * 256 * 1024 + hm * 128; const bf16_t* vb = kb + 512;
#pragma unroll
    for (int i = 0; i < 8; ++i) { const int qd = tid + 512 * i, w = qd >> 4, ch = qd & 15;
        *(LAS u32x4*)(lds + MA_K + w * MA_KP + ch * 16) = *(const u32x4*)(kb + (size_t)w * 1024 + ch * 8); }
#pragma unroll
    for (int i = 0; i < 4; ++i) { const int p = tid + 512 * i, w = (p >> 4) * 2, ch = p & 15;
        const u32x4 v0 = *(const u32x4*)(vb + (size_t)w * 1024 + ch * 8), v1 = *(const u32x4*)(vb + (size_t)(w + 1) * 1024 + ch * 8);
#pragma unroll
        for (int e = 0; e < 4; ++e) { const unsigned x0 = v0[e], x1 = v1[e]; const int d = ch * 8 + 2 * e;
            *(LAS unsigned*)(lds + MA_VT + d * MA_VP + w * 2) = (x0 & 0xffffu) | (x1 << 16);
            *(LAS unsigned*)(lds + MA_VT + (d + 1) * MA_VP + w * 2) = (x0 >> 16) | (x1 & 0xffff0000u); } }
    __syncthreads();
    const int q = lane & 15, g = lane >> 4;
    const LAS unsigned char* kbase = lds + MA_K + (8 * (q >> 2) + (q & 3)) * MA_KP + g * 16;
    const LAS unsigned char* vbase = lds + MA_VT + q * MA_VP + g * 16;
#pragma unroll 1
    for (int j = 0; j < 4; ++j) {
        const int i0 = 16 * (wave + 8 * j);
        bf16_t* qp = proj + (size_t)(R0 + i0 + q) * NPROJ + C_QM + hm * 128 + 8 * g;
        bf16x8 qf[4];
#pragma unroll
        for (int ks = 0; ks < 4; ++ks) qf[ks] = *(const bf16x8*)(qp + 32 * ks);
        f32x4 sc[16];
#pragma unroll
        for (int t = 0; t < 16; ++t) {
            f32x4 z = (f32x4){0.f, 0.f, 0.f, 0.f};
#pragma unroll
            for (int ks = 0; ks < 4; ++ks) { const bf16x8 kf = *(const LAS bf16x8*)(kbase + (t >> 1) * 32 * MA_KP + (t & 1) * 4 * MA_KP + ks * 64); z = __builtin_amdgcn_mfma_f32_16x16x32_bf16(kf, qf[ks], z, 0, 0, 0); }
            sc[t] = z; }
        float mx = -1.0e30f;
#pragma unroll
        for (int t = 0; t < 16; ++t)
#pragma unroll
            for (int r = 0; r < 4; ++r) mx = fmaxf(mx, sc[t][r]);
        mx = fmaxf(mx, __shfl_xor(mx, 16)); mx = fmaxf(mx, __shfl_xor(mx, 32));
        float sum = 0.f;
#pragma unroll
        for (int t = 0; t < 16; ++t)
#pragma unroll
            for (int r = 0; r < 4; ++r) { const float p = __builtin_amdgcn_exp2f(sc[t][r] - mx); sc[t][r] = p; sum += p; }
        sum += __shfl_xor(sum, 16); sum += __shfl_xor(sum, 32);
        const float inv = 1.0f / sum;
        f32x4 o[8];
#pragma unroll
        for (int dt = 0; dt < 8; ++dt) o[dt] = (f32x4){0.f, 0.f, 0.f, 0.f};
#pragma unroll
        for (int c = 0; c < 8; ++c) { const bf16x8 pf = pack8(sc[2 * c], sc[2 * c + 1]);
#pragma unroll
            for (int dt = 0; dt < 8; ++dt) { const bf16x8 vf = *(const LAS bf16x8*)(vbase + dt * 16 * MA_VP + c * 64);
                o[dt] = __builtin_amdgcn_mfma_f32_16x16x32_bf16(pf, vf, o[dt], 0, 0, 0); } }
#pragma unroll
        for (int r = 0; r < 4; ++r) { const float ir = __shfl(inv, 4 * g + r); bf16_t* op = ob + (size_t)(R0 + i0 + 4 * g + r) * opitch + hm * 128 + q;
#pragma unroll
            for (int dt = 0; dt < 8; ++dt) op[16 * dt] = (bf16_t)f2bf(o[dt][r] * ir); }
    }
    __syncthreads();
}

constexpr int SG_P = 272;
__device__ __forceinline__ void sgu_unit(const Args& a, LAS unsigned char* lds, int chunk, int tid, int wave, int lane, bf16_t* ob, int opitch) {
    bf16_t* proj = (bf16_t*)(a.ws + WS_PROJ); const bf16_t* wsb = (const bf16_t*)(a.ws + WS_SGUW);
    const int R0 = chunk * 128;
    {
        const int tp = tid >> 3, part = tid & 7, t0 = 2 * tp;
        const bf16_t* v0p = proj + (size_t)(R0 + t0) * NPROJ + C_SV + part * 64; const bf16_t* v1p = v0p + NPROJ;
        u32x4 x0[8], x1[8]; float s0 = 0.f, s1 = 0.f;
#pragma unroll
        for (int i = 0; i < 8; ++i) { x0[i] = ((const u32x4*)v0p)[i]; x1[i] = ((const u32x4*)v1p)[i]; }
#pragma unroll
        for (int i = 0; i < 8; ++i)
#pragma unroll
            for (int e = 0; e < 4; ++e) { s0 += bflo(x0[i][e]) + bfhi(x0[i][e]); s1 += bflo(x1[i][e]) + bfhi(x1[i][e]); }
        s0 += __shfl_xor(s0, 1); s0 += __shfl_xor(s0, 2); s0 += __shfl_xor(s0, 4); s1 += __shfl_xor(s1, 1); s1 += __shfl_xor(s1, 2); s1 += __shfl_xor(s1, 4);
        const float mu0 = s0 * (1.0f / 512.0f), mu1 = s1 * (1.0f / 512.0f); float q0 = 0.f, q1 = 0.f;
#pragma unroll
        for (int i = 0; i < 8; ++i)
#pragma unroll
            for (int e = 0; e < 4; ++e) { float d;
                d = bflo(x0[i][e]) - mu0; q0 += d * d; d = bfhi(x0[i][e]) - mu0; q0 += d * d; d = bflo(x1[i][e]) - mu1; q1 += d * d; d = bfhi(x1[i][e]) - mu1; q1 += d * d; }
        q0 += __shfl_xor(q0, 1); q0 += __shfl_xor(q0, 2); q0 += __shfl_xor(q0, 4); q1 += __shfl_xor(q1, 1); q1 += __shfl_xor(q1, 2); q1 += __shfl_xor(q1, 4);
        const float r0 = 1.0f / sqrtf(q0 * (1.0f / 512.0f) + EPS), r1 = 1.0f / sqrtf(q1 * (1.0f / 512.0f) + EPS);
        const float* lng = a.in[10] + part * 64; const float* lnb = a.in[11] + part * 64;
        LAS unsigned char* wb0 = lds + (part * 64) * SG_P + t0 * 2;
#pragma unroll
        for (int i = 0; i < 8; ++i)
#pragma unroll
            for (int e = 0; e < 4; ++e) {
                const int cl = 8 * i + 2 * e;
                const float ga = lng[cl], ba = lnb[cl], gb = lng[cl + 1], bb = lnb[cl + 1];
                const unsigned wa = pg8::cvt_pk_bf16((bflo(x0[i][e]) - mu0) * r0 * ga + ba, (bflo(x1[i][e]) - mu1) * r1 * ga + ba);
                const unsigned wb = pg8::cvt_pk_bf16((bfhi(x0[i][e]) - mu0) * r0 * gb + bb, (bfhi(x1[i][e]) - mu1) * r1 * gb + bb);
                *(LAS unsigned*)(wb0 + cl * SG_P) = wa;
                *(LAS unsigned*)(wb0 + (cl + 1) * SG_P) = wb; }
    }
    __syncthreads();
    {
        const int cl = lane & 15, g4 = lane >> 4, grp = wave >> 1, cbase = grp * 128 + (wave & 1) * 64;
        const LAS unsigned char* abase = lds + (cbase + cl) * SG_P + g4 * 16;
        const float* bs = a.in[9] + grp * 128;
#pragma unroll 1
        for (int th = 0; th < 2; ++th) {
            const bf16_t* wbase = wsb + (size_t)(grp * 128 + 64 * th + cl) * 128 + 8 * g4;
            f32x4 acc[4][4];
#pragma unroll
            for (int ct = 0; ct < 4; ++ct)
#pragma unroll
                for (int it = 0; it < 4; ++it) acc[ct][it] = (f32x4){0.f, 0.f, 0.f, 0.f};
#pragma unroll
            for (int kc = 0; kc < 4; ++kc) {
                bf16x8 af[4], wf[4];
#pragma unroll
                for (int ct = 0; ct < 4; ++ct) af[ct] = *(const LAS bf16x8*)(abase + ct * 16 * SG_P + kc * 64);
#pragma unroll
                for (int it = 0; it < 4; ++it) wf[it] = *(const bf16x8*)(wbase + it * 16 * 128 + kc * 32);
#pragma unroll
                for (int ct = 0; ct < 4; ++ct)
#pragma unroll
                    for (int it = 0; it < 4; ++it) acc[ct][it] = __builtin_amdgcn_mfma_f32_16x16x32_bf16(af[ct], wf[it], acc[ct][it], 0, 0, 0);
            }
#pragma unroll
            for (int it = 0; it < 4; ++it) { const int i = 64 * th + 16 * it + cl; const float bi = bs[i];
#pragma unroll
                for (int ct = 0; ct < 4; ++ct) { bf16_t* up = proj + (size_t)(R0 + i) * NPROJ + C_U + cbase + 16 * ct + 4 * g4;
                    const unsigned long long uw = *(const unsigned long long*)up; const unsigned ulo = (unsigned)uw, uhi = (unsigned)(uw >> 32);
                    const f32x4 sv = acc[ct][it];
                    const unsigned lo = pg8::cvt_pk_bf16(bflo(ulo) * (sv[0] + bi), bfhi(ulo) * (sv[1] + bi)), hi = pg8::cvt_pk_bf16(bflo(uhi) * (sv[2] + bi), bfhi(uhi) * (sv[3] + bi));
                    *(unsigned long long*)(ob + (size_t)(R0 + i) * opitch + cbase + 16 * ct + 4 * g4) = (unsigned long long)lo | ((unsigned long long)hi << 32); } }
        }
    }
    __syncthreads();
}
template <int PROBE> __device__ __forceinline__ void mix_phase(const Args& a, LAS unsigned char* lds, int tid, int wave, int lane) {
    const int G = gridDim.x, bx = blockIdx.x, vcu = (G % 8 == 0) ? (bx % 8) * (G / 8) + bx / 8 : bx;
    bf16_t* proj = (bf16_t*)(a.ws + WS_PROJ); bf16_t* dummy = (bf16_t*)(a.ws + WS_H);
    if (PROBE == 1) for (int u = vcu; u < 256; u += G) { const int kvh = u & 1, b0 = u & ~1; wattn_table(a, lds, kvh, tid); wattn_unit(a, lds, b0, kvh, tid, wave, lane, dummy, 512); wattn_unit(a, lds, b0 + 1, kvh, tid, wave, lane, dummy, 512); }
    if (PROBE == 2) for (int u = vcu; u < 256; u += G) mattn_unit(a, lds, u >> 2, u & 3, tid, wave, lane, dummy, 512);
    if (PROBE == 3) for (int u = vcu; u < 256; u += G) sgu_unit(a, lds, u, tid, wave, lane, dummy, 512);
    if (PROBE == 0) {
    for (int u = vcu; u < 256; u += G) { const int kvh = u & 1, b0 = u & ~1;
        wattn_table(a, lds, kvh, tid); wattn_unit(a, lds, b0, kvh, tid, wave, lane, proj + C_Q, NPROJ); wattn_unit(a, lds, b0 + 1, kvh, tid, wave, lane, proj + C_Q, NPROJ); }
    for (int u = vcu; u < 256; u += G) mattn_unit(a, lds, u >> 2, u & 3, tid, wave, lane, proj + C_QM, NPROJ);
    for (int u = vcu; u < 256; u += G) sgu_unit(a, lds, u, tid, wave, lane, proj + C_U, NPROJ);
    }
}

__device__ __forceinline__ void ffn_edge_fix(const Args& a, int pm, int tid) {
    const float* edge = (const float*)(a.ws + WS_EDGE); bf16_t* G = (bf16_t*)(a.ws + WS_G); const float* cw = a.in[20]; const float* cb = a.in[21];
    const bool sstart = pm < 64 ? (pm & 7) == 0 : pm == 64, send = pm < 64 ? (pm & 7) == 7 : pm == 127;
    for (int idx = tid; idx < 2 * DFF; idx += NTHREADS) {
        const int bot = idx >= DFF, ch = bot ? idx - DFF : idx, j = ch >> 7, cl = ch & 127;
        const float* e0 = edge + (size_t)(pm * 22 + j) * 1024 + cl;
        float pg, pu, cg, cu, ng, nu;
        if (!bot) { cg = e0[0]; cu = e0[128]; ng = e0[256]; nu = e0[256 + 128];
            if (sstart) { pg = 0.f; pu = 0.f; } else { const float* ep = e0 - 22 * 1024 + 3 * 256; pg = ep[0]; pu = ep[128]; } }
        else { pg = e0[512]; pu = e0[512 + 128]; cg = e0[768]; cu = e0[768 + 128];
            if (send) { ng = 0.f; nu = 0.f; } else { const float* en = e0 + 22 * 1024; ng = en[0]; nu = en[128]; } }
        const float ga = pg * cw[ch] + cg * cw[NUP + ch] + ng * cw[2 * NUP + ch] + cb[ch];
        const float ua = pu * cw[DFF + ch] + cu * cw[NUP + DFF + ch] + nu * cw[2 * NUP + DFF + ch] + cb[DFF + ch];
        G[(size_t)(pm * 256 + (bot ? 255 : 0)) * DFF + ch] = (bf16_t)f2bf(gelu_tanh(ga) * ua);
    }
}

#define XB_TMO      128
#define XB_XCNT(j)  (256  + 64 * (j))
#define XB_XSUB(j)  (1280 + 64 * (j))
#define XB_XGEN(j)  (2304 + 64 * (j))
#define XB_TOP      3328
#define XB_TOPGEN   3392
#define XCD_BAR_WORDS 3456
#define XB_SPIN_CAP (1u << 20)
__device__ __forceinline__ unsigned xb_ld(unsigned* p)              { return __hip_atomic_load(p, __ATOMIC_RELAXED, __HIP_MEMORY_SCOPE_AGENT); }
__device__ __forceinline__ unsigned xb_add(unsigned* p, unsigned v) { return __hip_atomic_fetch_add(p, v, __ATOMIC_RELAXED, __HIP_MEMORY_SCOPE_AGENT); }
__device__ __forceinline__ unsigned xb_xcc_id() { return (unsigned)__builtin_amdgcn_s_getreg((3 << 11) | 20) & 0xFu; }
#define XB_SPIN(cond, bar) do { unsigned _sp = 0; while (cond) { __builtin_amdgcn_s_sleep(1); \
    if ((++_sp & 255u) == 0u) { if (xb_ld(&(bar)[XB_TMO])) break; if (_sp > XB_SPIN_CAP) { atomicAdd(&(bar)[XB_TMO], 1u); break; } } } } while (0)
struct XcdBarrier { unsigned* bar; unsigned x; volatile LAS unsigned* st; };
__device__ __forceinline__ XcdBarrier xcd_barrier_post(unsigned* bar, volatile LAS unsigned* st) {
    XcdBarrier b; b.bar = bar; b.x = xb_xcc_id(); b.st = st;
    if (threadIdx.x == 0) (void)xb_add(&bar[XB_XCNT(b.x)], 1u);
    return b;
}
__device__ __forceinline__ void xcd_barrier_complete(unsigned* bar, unsigned x, unsigned& nloc, unsigned& nx) {
    const unsigned G = gridDim.x * gridDim.y * gridDim.z;
    unsigned sum, cnt, mine, sp = 0u;
    for (;;) {
        sum = 0u; cnt = 0u; mine = 0u;
#pragma unroll
        for (unsigned j = 0; j < 16; ++j) { const unsigned c = xb_ld(&bar[XB_XCNT(j)]); sum += c; cnt += (c > 0u) ? 1u : 0u; mine = (j == x) ? c : mine; }
        if (sum == G) break;
        __builtin_amdgcn_s_sleep(1);
        if ((++sp & 255u) == 0u) { if (xb_ld(&bar[XB_TMO])) break; if (sp > XB_SPIN_CAP) { atomicAdd(&bar[XB_TMO], 1u); break; } }
    }
    nloc = mine > 0u ? mine : 1u; nx = cnt > 0u ? cnt : 1u;
}
__device__ __forceinline__ void xcd_barrier(const XcdBarrier& b) {
    asm volatile("s_waitcnt vmcnt(0)" ::: "memory");
    __syncthreads();
    if (threadIdx.x == 0) {
        unsigned* bar = b.bar;
        __builtin_amdgcn_s_waitcnt(0);
        unsigned nloc = b.st[0], nx = b.st[1];
        if (nloc == 0u) { xcd_barrier_complete(bar, b.x, nloc, nx); b.st[0] = nloc; b.st[1] = nx; }
        const unsigned old = xb_add(&bar[XB_XSUB(b.x)], 1u);
        const unsigned gen = old / nloc;
        if (old + 1u == (gen + 1u) * nloc) {
            __builtin_amdgcn_fence(__ATOMIC_RELEASE, "agent");
            asm volatile("s_waitcnt vmcnt(0)" ::: "memory");
            const unsigned og = xb_add(&bar[XB_TOP], 1u);
            const unsigned tg = og / nx;
            if (og + 1u == (tg + 1u) * nx) xb_add(&bar[XB_TOPGEN], 1u);
            else XB_SPIN(xb_ld(&bar[XB_TOPGEN]) == tg, bar);
            __builtin_amdgcn_fence(__ATOMIC_ACQUIRE, "agent");
            xb_add(&bar[XB_XGEN(b.x)], 1u);
            asm volatile("s_waitcnt vmcnt(0)" ::: "memory");
        } else {
            XB_SPIN(xb_ld(&bar[XB_XGEN(b.x)]) == gen, bar);
            __builtin_amdgcn_fence(__ATOMIC_ACQUIRE, "agent");
            asm volatile("s_waitcnt vmcnt(0)" ::: "memory");
        }
    }
    __syncthreads();
}

enum { PH_PRO = 0, PH_PROJ, PH_MIX, PH_MIX2, PH_SGU, PH_BR, PH_OUTP, PH_SSQ, PH_UP0, PH_CONV0, PH_UP1, PH_CONV1, PH_DOWN, PH_FINAL, PH_N };

__global__ void __launch_bounds__(NTHREADS, 2) fwd(Args a) {
    extern __shared__ __attribute__((aligned(16))) unsigned char lds_raw[];
    LAS unsigned char* lds = (LAS unsigned char*)lds_raw;
    cg::grid_group grid = cg::this_grid();
    Ctx c; c.tid = threadIdx.x; c.lane = c.tid & 63; c.wave = __builtin_amdgcn_readfirstlane(c.tid >> 6);
    c.gw = blockIdx.x * NWAVES + c.wave; c.ngw = gridDim.x * NWAVES; c.gtid = blockIdx.x * NTHREADS + c.tid; c.ngt = gridDim.x * NTHREADS;
    unsigned char* ws = a.ws;
    volatile LAS unsigned* misc = (volatile LAS unsigned*)(lds + MISC_OFF);
    if (c.tid < 64) misc[c.tid] = 0u;
    __syncthreads();
    const XcdBarrier xb = xcd_barrier_post((unsigned*)(ws + WS_CTL) + 1024, misc);
    if (a.coop_sync) grid.sync();
#define GRID_BAR() xcd_barrier(xb)
    p0_prologue(a, c, lds);
    GRID_BAR();
    {
        pg8::SchedPlain S; S.o.init(T / 256, NPROJ / 256, (int)gridDim.x, (int)blockIdx.x); S.A = (const char*)(ws + WS_H); S.B = (const char*)(ws + WS_WIN); S.strideA = (size_t)256 * D * 2; S.strideB = (size_t)256 * D * 2;
        pg8::EpiProj E{(bf16_t*)(ws + WS_PROJ)};
        pg8::gemm_phase(lds, D, D, S, E);
        pg8::SchedOne S2; S2.idx = ((int)blockIdx.x >= 128 && (int)blockIdx.x < 128 + 36) ? (int)blockIdx.x - 128 : -1; S2.nN = 4;
        S2.A = (const char*)(ws + WS_MEMN); S2.B = (const char*)(ws + WS_WMKV); S2.strideA = (size_t)256 * D * 2; S2.strideB = (size_t)256 * D * 2;
        pg8::EpiPlain E2{(bf16_t*)(ws + WS_MKV), 1024};
        pg8::gemm_phase(lds, D, D, S2, E2);
    }
    GRID_BAR();
    mix_phase<0>(a, lds, c.tid, c.wave, c.lane);
    GRID_BAR();
    {
        pg8::SchedBranch S; S.o.init(T / 256, 4, (int)gridDim.x, (int)blockIdx.x, 3); S.proj = (const char*)(ws + WS_PROJ); S.wbr = (const char*)(ws + WS_WBR);
        pg8::EpiBranch E{(const bf16_t*)(ws + WS_PROJ), (bf16_t*)(ws + WS_H)};
        pg8::gemm_phase(lds, 512, NPROJ, S, E);
    }
    GRID_BAR();
    {
        pg8::SchedPlain S; S.o.init(T / 256, 4, (int)gridDim.x, (int)blockIdx.x); S.A = (const char*)(ws + WS_H); S.B = (const char*)(ws + WS_WOUT); S.strideA = (size_t)256 * D * 2; S.strideB = (size_t)256 * D * 2;
        pg8::EpiOut E{a.in[0], a.in[1], a.out, (bf16_t*)(ws + WS_H2), (float*)(ws + WS_SSQ1)};
        pg8::gemm_phase(lds, D, D, S, E);
    }
    GRID_BAR();
    {
        pg8::SchedPlain S; S.o.init(T / 256, 22, (int)gridDim.x, (int)blockIdx.x); S.A = (const char*)(ws + WS_H2); S.B = (const char*)(ws + WS_WUP); S.strideA = (size_t)256 * D * 2; S.strideB = (size_t)256 * D * 2;
        pg8::EpiUpConv E{(bf16_t*)(ws + WS_G), (const float*)(ws + WS_SSQ1), a.in[20], a.in[21], (float*)(ws + WS_EDGE), lds + 131072};
        pg8::gemm_phase(lds, D, D, S, E);
    }
    GRID_BAR();
    {
        pg8::SchedPlain S; S.o.init(T / 256, 4, (int)gridDim.x, (int)blockIdx.x); S.A = (const char*)(ws + WS_G); S.B = (const char*)(ws + WS_WDN); S.strideA = (size_t)256 * DFF * 2; S.strideB = (size_t)256 * DFF * 2;
        { int pm, pn, aux; for (int i = 0; S.o.tile(i, pm, pn, aux); ++i) ffn_edge_fix(a, pm, c.tid); }
        asm volatile("s_waitcnt vmcnt(0)" ::: "memory"); __syncthreads();
        pg8::EpiDown E{a.out};
        pg8::gemm_phase(lds, DFF, DFF, S, E);
    }
    GRID_BAR();
    final_norm(a, c);
}

extern "C" void kernel_launch(void* const* d_in, const int* in_sizes, int n_in, void* d_out, int out_size, void* d_ws, size_t ws_size, hipStream_t stream) {
    static int grid = 0;
    if (grid == 0) {
        if (n_in != 24 || out_size != T * D || ws_size < WS_END) { fprintf(stderr, "kernel_launch: unexpected shapes (n_in %d, out %d, ws %zu)\n", n_in, out_size, ws_size); grid = -1; return; }
        int dev = 0, cus = 0, per_cu = 0;
        (void)hipGetDevice(&dev); (void)hipDeviceGetAttribute(&cus, hipDeviceAttributeMultiprocessorCount, dev);
        (void)hipFuncSetAttribute((const void*)fwd, hipFuncAttributeMaxDynamicSharedMemorySize, LDS_BYTES);
        if (hipOccupancyMaxActiveBlocksPerMultiprocessor(&per_cu, (const void*)fwd, NTHREADS, LDS_BYTES) != hipSuccess || per_cu < 1) { fprintf(stderr, "kernel_launch: occupancy query says %d blocks/CU\n", per_cu); (void)hipGetLastError(); grid = -1; return; }
        grid = cus * 1;
    }
    if (grid < 0) return;
    if (hipMemsetAsync((char*)d_ws + WS_CTL, 0, 65536, stream) != hipSuccess) { fprintf(stderr, "kernel_launch: memset of the barrier words failed\n"); return; }
    Args a{};
    for (int i = 0; i < 24; ++i) a.in[i] = (const float*)d_in[i];
    a.out = (float*)d_out; a.ws = (unsigned char*)d_ws; a.coop_sync = 0; a.pad = 0;
    void* kargs[] = {&a};
    hipError_t e = hipLaunchCooperativeKernel((const void*)fwd, dim3(grid), dim3(NTHREADS), kargs, LDS_BYTES, stream);
    if (e != hipSuccess) fprintf(stderr, "cooperative launch failed: %s (grid %d)\n", hipGetErrorString(e), grid);
}
```
